# Optimizing an MI355X kernel written in HIP

```python
import math
import jax, jax.numpy as jnp
from jax import lax
import numpy as np

D_MODEL = 1024
BATCH = 2
SEQ = 8192
DEPTH = 4

HEAD_DIM = 64
ROT_DIM = HEAD_DIM // 4
ROPE_THETA = 500000.0
NORM_EPS = 1e-6
N_MIXERS = 3
DILATED_GROUPS = ((128, 1), (512, 4), (2048, 16))
A_HEADS = 16
A_BLOCK = 64
B_HEADS = D_MODEL // (2 * HEAD_DIM)
B_QUERY_BLOCK = 128
SUBLN_EPS = 1e-5
C_Q_HEADS = 16
C_KV_HEADS = 2
C_HALF_WINDOW = 128
C_BLOCK = 128
D_FF = 2816
N_EXPERTS = 8
TOP_K = 2
D_FF_EXPERT = 3584
MOE_BLOCK = 512

A_W_IN = len(DILATED_GROUPS) * 3 * A_HEADS * HEAD_DIM
B_W_IN = 3 * B_HEADS * 2 * HEAD_DIM
C_W_IN = (C_Q_HEADS + 2 * C_KV_HEADS) * HEAD_DIM

kernel_name = "hybrid_dilated_diff_swa_moe_encoder"


def rmsnorm(x, g, eps=NORM_EPS):
    xf = x.astype(jnp.float32)
    y = xf * lax.rsqrt(jnp.mean(xf * xf, axis=-1, keepdims=True) + eps) * g.astype(jnp.float32)
    return y.astype(x.dtype)


def rope_tables(positions):
    inv_freq = ROPE_THETA ** (-(jnp.arange(0, ROT_DIM, 2, dtype=jnp.float32) / ROT_DIM))
    ang = positions.astype(jnp.float32)[..., None] * inv_freq
    return jnp.cos(ang)[:, :, None, :], jnp.sin(ang)[:, :, None, :]


def rope(t, cos, sin):
    half = ROT_DIM // 2
    rot = t[..., :ROT_DIM].astype(jnp.float32)
    x1, x2 = rot[..., :half], rot[..., half:]
    rotated = jnp.concatenate([x1 * cos - x2 * sin, x2 * cos + x1 * sin], axis=-1)
    return jnp.concatenate([rotated.astype(t.dtype), t[..., ROT_DIM:]], axis=-1)


def banded_attention(q, k, v, half_window, blk, sink=None):
    B, L, H, Dh = q.shape
    G = k.shape[2]
    rep = H // G
    nb = -(-L // blk)
    pad = nb * blk - L
    qb = jnp.pad(q, ((0, 0), (0, pad), (0, 0), (0, 0))).reshape(B, nb, blk, G, rep, Dh)

    def windows(t):
        tp = jnp.pad(t, ((0, 0), (blk, pad + blk), (0, 0), (0, 0))).reshape(B, nb + 2, blk, G, Dh)
        return jnp.concatenate([tp[:, :-2], tp[:, 1:-1], tp[:, 2:]], axis=2)

    kw, vw = windows(k), windows(v)
    q_pos = jnp.arange(nb * blk).reshape(nb, blk)
    k_pos = (jnp.arange(nb)[:, None] - 1) * blk + jnp.arange(3 * blk)[None, :]
    kp = k_pos[:, None, :]
    mask = (jnp.abs(q_pos[:, :, None] - kp) <= half_window) & (kp >= 0) & (kp < L)
    s = jnp.einsum('bnqgrd,bnkgd->bngrqk', qb, kw).astype(jnp.float32) * (Dh ** -0.5)
    s = jnp.where(mask[None, :, None, None], s, -jnp.inf)
    m = jnp.max(s, axis=-1, keepdims=True)
    if sink is not None:
        sk = sink.astype(jnp.float32).reshape(1, 1, G, rep, 1, 1)
        m = jnp.maximum(m, sk)
    m = jnp.where(jnp.isfinite(m), m, 0.0)
    p = jnp.exp(s - m)
    denom = jnp.sum(p, axis=-1, keepdims=True)
    if sink is not None:
        denom = denom + jnp.exp(sk - m)
    o = jnp.einsum('bngrqk,bnkgd->bnqgrd', (p / denom).astype(v.dtype), vw)
    o = o.reshape(B, nb * blk, H, Dh)[:, :L]
    lse = (m + jnp.log(denom))[..., 0]
    lse = lse.transpose(0, 1, 4, 2, 3).reshape(B, nb * blk, H)[:, :L]
    return o, lse


def to_strided(t, d):
    B, S = t.shape[:2]
    rest = t.shape[2:]
    return jnp.swapaxes(t.reshape((B, S // d, d) + rest), 1, 2).reshape((B * d, S // d) + rest)


def from_strided(t, d, B):
    L = t.shape[1]
    rest = t.shape[2:]
    return jnp.swapaxes(t.reshape((B, d, L) + rest), 1, 2).reshape((B, L * d) + rest)


def dilated_mixer(h, cos, sin, w_in, w_out):
    B, S, _ = h.shape
    proj = (h @ w_in).reshape(B, S, len(DILATED_GROUPS), 3, A_HEADS, HEAD_DIM)
    outs, lses = [], []
    for gi, (window, dil) in enumerate(DILATED_GROUPS):
        q = rope(proj[:, :, gi, 0], cos, sin)
        k = rope(proj[:, :, gi, 1], cos, sin)
        v = proj[:, :, gi, 2]
        half = (window // 2) // dil
        o, l = banded_attention(to_strided(q, dil), to_strided(k, dil), to_strided(v, dil), half, A_BLOCK)
        outs.append(from_strided(o, dil, B))
        lses.append(from_strided(l, dil, B))
    alpha = jax.nn.softmax(jnp.stack(lses, axis=0), axis=0)
    o = jnp.einsum('gbsh,gbshd->bshd', alpha, jnp.stack(outs, axis=0).astype(jnp.float32))
    return o.astype(h.dtype).reshape(B, S, A_HEADS * HEAD_DIM) @ w_out


def diff_mixer(h, cos, sin, w_in, lq1, lk1, lq2, lk2, subln, w_out, lambda_init):
    B, S, _ = h.shape
    q, k, v = jnp.split(h @ w_in, 3, axis=-1)
    q = rope(q.reshape(B, S, 2 * B_HEADS, HEAD_DIM), cos, sin).reshape(B, S, B_HEADS, 2, HEAD_DIM)
    k = rope(k.reshape(B, S, 2 * B_HEADS, HEAD_DIM), cos, sin).reshape(B, S, B_HEADS, 2, HEAD_DIM)
    v = v.reshape(B, S, B_HEADS, 2 * HEAD_DIM)
    lam = (jnp.exp(jnp.sum(lq1.astype(jnp.float32) * lk1.astype(jnp.float32)))
           - jnp.exp(jnp.sum(lq2.astype(jnp.float32) * lk2.astype(jnp.float32))) + lambda_init)
    kh = k.transpose(0, 2, 3, 1, 4)
    vh = v.transpose(0, 2, 1, 3)
    nqb = S // B_QUERY_BLOCK
    qb = q.reshape(B, nqb, B_QUERY_BLOCK, B_HEADS, 2, HEAD_DIM).transpose(1, 0, 3, 4, 2, 5)
    scale = HEAD_DIM ** -0.5

    def block(qblk):
        s = jnp.einsum('bhcqd,bhckd->bhcqk', qblk, kh).astype(jnp.float32) * scale
        a = jax.nn.softmax(s, axis=-1)
        attn = a[:, :, 0] - lam * a[:, :, 1]
        return jnp.einsum('bhqk,bhkd->bhqd', attn.astype(vh.dtype), vh)

    o = lax.map(block, qb)
    o = o.transpose(1, 0, 3, 2, 4).reshape(B, S, B_HEADS, 2 * HEAD_DIM).astype(jnp.float32)
    o = o * lax.rsqrt(jnp.mean(o * o, axis=-1, keepdims=True) + SUBLN_EPS) * subln.astype(jnp.float32)
    o = o * (1.0 - lambda_init)
    return o.astype(h.dtype).reshape(B, S, B_HEADS * 2 * HEAD_DIM) @ w_out


def swa_sink_mixer(h, cos, sin, w_in, sink, w_out):
    B, S, _ = h.shape
    proj = h @ w_in
    nq, nk = C_Q_HEADS * HEAD_DIM, C_KV_HEADS * HEAD_DIM
    q = rope(proj[..., :nq].reshape(B, S, C_Q_HEADS, HEAD_DIM), cos, sin)
    k = rope(proj[..., nq:nq + nk].reshape(B, S, C_KV_HEADS, HEAD_DIM), cos, sin)
    v = proj[..., nq + nk:].reshape(B, S, C_KV_HEADS, HEAD_DIM)
    o, _ = banded_attention(q, k, v, C_HALF_WINDOW, C_BLOCK, sink)
    return o.reshape(B, S, C_Q_HEADS * HEAD_DIM) @ w_out


def dense_swiglu(h, w1, w3, w2):
    return (jax.nn.silu(h @ w1) * (h @ w3)) @ w2


def moe_swiglu(h, router, w1, w3, w2):
    B, S, D = h.shape
    T = B * S
    xt = h.reshape(T, D)
    logits = (xt @ router).astype(jnp.float32)
    top_vals, top_idx = lax.top_k(logits, TOP_K)
    gates = jax.nn.softmax(top_vals, axis=-1)
    n = T * TOP_K
    expert = top_idx.reshape(n)
    token = jnp.repeat(jnp.arange(T, dtype=jnp.int32), TOP_K)
    gate = gates.reshape(n)
    order = jnp.argsort(expert)
    e_sorted, t_sorted, g_sorted = expert[order], token[order], gate[order]
    counts = jnp.zeros((N_EXPERTS,), jnp.int32).at[expert].add(1)
    padded = ((counts + MOE_BLOCK - 1) // MOE_BLOCK) * MOE_BLOCK
    start = jnp.cumsum(counts) - counts
    pend = jnp.cumsum(padded)
    pstart = pend - padded
    dest = pstart[e_sorted] + (jnp.arange(n, dtype=jnp.int32) - start[e_sorted])
    n_blocks = -(-(n + N_EXPERTS * (MOE_BLOCK - 1)) // MOE_BLOCK)
    buf = jnp.zeros((n_blocks * MOE_BLOCK, D), h.dtype).at[dest].set(xt[t_sorted])
    block_start = jnp.arange(n_blocks, dtype=jnp.int32) * MOE_BLOCK
    block_expert = jnp.minimum(jnp.searchsorted(pend, block_start, side='right'), N_EXPERTS - 1)

    def expert_block(args):
        xb, e = args
        return (jax.nn.silu(xb @ w1[e]) * (xb @ w3[e])) @ w2[e]

    ybuf = lax.map(expert_block, (buf.reshape(n_blocks, MOE_BLOCK, D), block_expert)).reshape(-1, D)
    y = jnp.zeros((T, D), h.dtype).at[t_sorted].add(ybuf[dest] * g_sorted[:, None].astype(h.dtype))
    return y.reshape(B, S, D)


def setup_inputs(seed: int = 0) -> dict:
    key = jax.random.key(seed)
    keys = jax.random.split(key, 48)
    ctr = [0]

    def nk():
        k = keys[ctr[0]]
        ctr[0] += 1
        return k

    def w(shape, fan_in, scale=1.0):
        return jax.random.normal(nk(), shape, jnp.float32) * (scale * fan_in ** -0.5)

    def gain(n=D_MODEL):
        return 1.0 + 0.02 * jax.random.normal(nk(), (n,), jnp.float32)

    inp = {}
    inp['x'] = jax.random.normal(nk(), (BATCH, SEQ, D_MODEL), jnp.float32)
    start = jax.random.randint(nk(), (BATCH, 1), 0, 4096, dtype=jnp.int32)
    inp['positions'] = start + jnp.arange(SEQ, dtype=jnp.int32)[None, :]
    inp['l0_norm_mix'] = gain()
    inp['l0_a_w_in'] = w((D_MODEL, A_W_IN), D_MODEL)
    inp['l0_a_w_out'] = w((A_HEADS * HEAD_DIM, D_MODEL), A_HEADS * HEAD_DIM)
    inp['l0_norm_ffn'] = gain()
    inp['l0_ffn_w1'] = w((D_MODEL, D_FF), D_MODEL)
    inp['l0_ffn_w3'] = w((D_MODEL, D_FF), D_MODEL)
    inp['l0_ffn_w2'] = w((D_FF, D_MODEL), D_FF)
    inp['l1_norm_mix'] = gain()
    inp['l1_b_w_in'] = w((D_MODEL, B_W_IN), D_MODEL)
    inp['l1_b_lambda_q1'] = 0.1 * jax.random.normal(nk(), (HEAD_DIM,), jnp.float32)
    inp['l1_b_lambda_k1'] = 0.1 * jax.random.normal(nk(), (HEAD_DIM,), jnp.float32)
    inp['l1_b_lambda_q2'] = 0.1 * jax.random.normal(nk(), (HEAD_DIM,), jnp.float32)
    inp['l1_b_lambda_k2'] = 0.1 * jax.random.normal(nk(), (HEAD_DIM,), jnp.float32)
    inp['l1_b_subln'] = gain(2 * HEAD_DIM)
    inp['l1_b_w_out'] = w((B_HEADS * 2 * HEAD_DIM, D_MODEL), B_HEADS * 2 * HEAD_DIM)
    inp['l1_norm_ffn'] = gain()
    inp['l1_moe_router'] = w((D_MODEL, N_EXPERTS), D_MODEL)
    inp['l1_moe_w1'] = w((N_EXPERTS, D_MODEL, D_FF_EXPERT), D_MODEL)
    inp['l1_moe_w3'] = w((N_EXPERTS, D_MODEL, D_FF_EXPERT), D_MODEL)
    inp['l1_moe_w2'] = w((N_EXPERTS, D_FF_EXPERT, D_MODEL), D_FF_EXPERT)
    inp['l2_norm_mix'] = gain()
    inp['l2_c_w_in'] = w((D_MODEL, C_W_IN), D_MODEL)
    inp['l2_c_sink'] = 0.5 * jax.random.normal(nk(), (C_Q_HEADS,), jnp.float32)
    inp['l2_c_w_out'] = w((C_Q_HEADS * HEAD_DIM, D_MODEL), C_Q_HEADS * HEAD_DIM)
    inp['l2_norm_ffn'] = gain()
    inp['l2_ffn_w1'] = w((D_MODEL, D_FF), D_MODEL)
    inp['l2_ffn_w3'] = w((D_MODEL, D_FF), D_MODEL)
    inp['l2_ffn_w2'] = w((D_FF, D_MODEL), D_FF)
    inp['l3_norm_mix'] = gain()
    inp['l3_a_w_in'] = w((D_MODEL, A_W_IN), D_MODEL)
    inp['l3_a_w_out'] = w((A_HEADS * HEAD_DIM, D_MODEL), A_HEADS * HEAD_DIM)
    inp['l3_norm_ffn'] = gain()
    inp['l3_moe_router'] = w((D_MODEL, N_EXPERTS), D_MODEL)
    inp['l3_moe_w1'] = w((N_EXPERTS, D_MODEL, D_FF_EXPERT), D_MODEL)
    inp['l3_moe_w3'] = w((N_EXPERTS, D_MODEL, D_FF_EXPERT), D_MODEL)
    inp['l3_moe_w2'] = w((N_EXPERTS, D_FF_EXPERT, D_MODEL), D_FF_EXPERT)
    inp['final_norm'] = gain()
    return inp


def reference(x, positions,
              l0_norm_mix, l0_a_w_in, l0_a_w_out, l0_norm_ffn, l0_ffn_w1, l0_ffn_w3, l0_ffn_w2,
              l1_norm_mix, l1_b_w_in, l1_b_lambda_q1, l1_b_lambda_k1, l1_b_lambda_q2, l1_b_lambda_k2,
              l1_b_subln, l1_b_w_out, l1_norm_ffn, l1_moe_router, l1_moe_w1, l1_moe_w3, l1_moe_w2,
              l2_norm_mix, l2_c_w_in, l2_c_sink, l2_c_w_out, l2_norm_ffn, l2_ffn_w1, l2_ffn_w3, l2_ffn_w2,
              l3_norm_mix, l3_a_w_in, l3_a_w_out, l3_norm_ffn, l3_moe_router, l3_moe_w1, l3_moe_w3, l3_moe_w2,
              final_norm):
    cos, sin = rope_tables(positions)
    mixers = [
        (l0_norm_mix, (l0_a_w_in, l0_a_w_out)),
        (l1_norm_mix, (l1_b_w_in, l1_b_lambda_q1, l1_b_lambda_k1, l1_b_lambda_q2, l1_b_lambda_k2,
                       l1_b_subln, l1_b_w_out)),
        (l2_norm_mix, (l2_c_w_in, l2_c_sink, l2_c_w_out)),
        (l3_norm_mix, (l3_a_w_in, l3_a_w_out)),
    ]
    ffns = [
        (l0_norm_ffn, (l0_ffn_w1, l0_ffn_w3, l0_ffn_w2)),
        (l1_norm_ffn, (l1_moe_router, l1_moe_w1, l1_moe_w3, l1_moe_w2)),
        (l2_norm_ffn, (l2_ffn_w1, l2_ffn_w3, l2_ffn_w2)),
        (l3_norm_ffn, (l3_moe_router, l3_moe_w1, l3_moe_w3, l3_moe_w2)),
    ]
    for i in range(DEPTH):
        g_mix, p_mix = mixers[i]
        h = rmsnorm(x, g_mix)
        kind = i % N_MIXERS
        if kind == 0:
            y = dilated_mixer(h, cos, sin, *p_mix)
        elif kind == 1:
            lambda_init = 0.8 - 0.6 * math.exp(-0.3 * i)
            y = diff_mixer(h, cos, sin, *p_mix, lambda_init)
        else:
            y = swa_sink_mixer(h, cos, sin, *p_mix)
        x = x + y
        g_ffn, p_ffn = ffns[i]
        h = rmsnorm(x, g_ffn)
        y = dense_swiglu(h, *p_ffn) if i % 2 == 0 else moe_swiglu(h, *p_ffn)
        x = x + y
    return rmsnorm(x, final_norm)
```

```cpp
#include <hip/hip_runtime.h>
#include <cstdio>
#include <cstdint>
#include <cmath>

#ifndef MK_SINGLE
#define MK_SINGLE 1
#endif
#ifndef PROBE_PHASE
#define PROBE_PHASE -1
#endif

#define LAS __attribute__((address_space(3)))
#define GAS __attribute__((address_space(1)))
typedef unsigned short bf16_t;
typedef short bf16x8 __attribute__((ext_vector_type(8)));
typedef float f32x4 __attribute__((ext_vector_type(4)));
typedef float f32x2 __attribute__((ext_vector_type(2)));
typedef unsigned u32x4 __attribute__((ext_vector_type(4)));
typedef unsigned u32x2 __attribute__((ext_vector_type(2)));

constexpr int NTOK = 16384, SEQ = 8192, DM = 1024;
constexpr int NQKV_A = 9216, NQKV_B = 3072, NQKV_C = 1280;
constexpr int FF = 2816, FFE = 3584, NEXP = 8;
constexpr int MOE_ROWS = 32768 + 2048;
constexpr float LOG2E = 1.4426950408889634f;
constexpr float C2 = 0.125f * 1.4426950408889634f;
constexpr float NORM_EPS = 1e-6f, SUBLN_EPS = 1e-5f;
constexpr float LAMBDA_INIT = 0.35550906759096926f;

constexpr size_t MiB = 1u << 20;
constexpr size_t WS_CTL = 0, CTL_ZERO_BYTES = 1 * MiB;
constexpr size_t WS_ROPE = 1 * MiB;
constexpr size_t WS_SSQ = 2 * MiB;
constexpr size_t WS_TOK = 3 * MiB;
constexpr size_t WS_LSE = 4 * MiB;
constexpr size_t WS_WQKV0 = 8 * MiB, WS_WO0 = 26 * MiB, WS_W13_0 = 28 * MiB, WS_W2_0 = 39 * MiB;
constexpr size_t WS_WQKV1 = 45 * MiB, WS_WO1 = 51 * MiB;
constexpr size_t WS_WQKV2 = 53 * MiB, WS_WO2 = 56 * MiB, WS_W13_2 = 58 * MiB, WS_W2_2 = 69 * MiB;
constexpr size_t WS_WQKV3 = 75 * MiB, WS_WO3 = 93 * MiB;
constexpr size_t WS_WM13 = 96 * MiB, WS_WM2 = 208 * MiB;
constexpr size_t WS_X = 264 * MiB, WS_XB = 328 * MiB, WS_O = 360 * MiB, WS_BIG = 392 * MiB, WS_END = 776 * MiB;
constexpr size_t WS_VT8 = WS_X + 16 * MiB;
constexpr size_t WS_X8 = WS_X;
constexpr size_t BIG_QKV = 0, BIG_OG = 288 * MiB, BIG_H = 0, BIG_XBUF = 0, BIG_YBUF = 68 * MiB, BIG_HBUF = 136 * MiB;
constexpr size_t TOK_E = 0, TOK_G0 = 64 * 1024, TOK_G1 = 128 * 1024, TOK_RANK = 192 * 1024, TOK_D0 = 256 * 1024, TOK_D1 = 320 * 1024, TOK_HIST = 512 * 1024, TOK_PEND = 600 * 1024;
constexpr int CW_BAR = 4096;

constexpr int RING_BYTES = 131072;
constexpr int MISC_OFF = RING_BYTES + 320;
constexpr int LDS_BYTES = 147456;

__device__ __forceinline__ unsigned f2bf(float f) { unsigned u = __builtin_bit_cast(unsigned, f); return (u + 0x7fffu + ((u >> 16) & 1u)) >> 16; }
__device__ __forceinline__ unsigned pk2(float lo, float hi) { return f2bf(lo) | (f2bf(hi) << 16); }
__device__ __forceinline__ float bf2f(unsigned short b) { return __builtin_bit_cast(float, (unsigned)b << 16); }
__device__ __forceinline__ float bflo(unsigned w) { return __builtin_bit_cast(float, w << 16); }
__device__ __forceinline__ float bfhi(unsigned w) { return __builtin_bit_cast(float, w & 0xffff0000u); }
__device__ __forceinline__ float wave_sum(float v) {
#pragma unroll
    for (int o = 1; o < 64; o <<= 1) v += __shfl_xor(v, o);
    return v;
}
__device__ __forceinline__ float wave_max(float v) {
#pragma unroll
    for (int o = 1; o < 64; o <<= 1) v = fmaxf(v, __shfl_xor(v, o));
    return v;
}
#define LDS_WAIT() asm volatile("s_waitcnt lgkmcnt(0)" ::: "memory")
__device__ __forceinline__ unsigned pk_fp8x4(float a, float b, float c, float d) {
    a = fminf(fmaxf(a, -448.f), 448.f); b = fminf(fmaxf(b, -448.f), 448.f); c = fminf(fmaxf(c, -448.f), 448.f); d = fminf(fmaxf(d, -448.f), 448.f);
    int p = __builtin_bit_cast(int, a); p = __builtin_amdgcn_cvt_pk_fp8_f32(a, b, p, false); p = __builtin_amdgcn_cvt_pk_fp8_f32(c, d, p, true); return (unsigned)p;
}
__device__ __forceinline__ unsigned pk_fp8x4_nc(float a, float b, float c, float d) {
    int p; asm volatile("" : "=v"(p));
    p = __builtin_amdgcn_cvt_pk_fp8_f32(a, b, p, false); p = __builtin_amdgcn_cvt_pk_fp8_f32(c, d, p, true); return (unsigned)p;
}
constexpr float W8_SCALE = 64.0f, H8_SCALE = 8.0f;
constexpr int SC_ONE = 0x7f7f7f7f, SC_W8 = 0x79797979, SC_H8 = 0x7c7c7c7c;

namespace pg8 {
#define PG8_LAS __attribute__((address_space(3)))
constexpr int BM = 256, BK = 64, HALF = 128, HTB = HALF * BK * 2, STAGE_BYTES = 8 * HTB, NXCD = 8, WGM = 8;

__host__ __device__ __forceinline__ int lds_byte(int r, int c) { const int st = (r >> 4) * 2 + (c >> 5), rr = r & 15, cc = c & 31, ob = rr * 64 + cc * 2; return st * 1024 + (ob ^ (((ob >> 9) & 1) << 5)); }
__host__ __device__ __forceinline__ void stage_rc(int b, int& R, int& C) { const int st = b / 1024, sb = b % 1024, swz = sb ^ (((sb >> 9) & 1) << 5); R = (st >> 1) * 16 + swz / 64; C = (st & 1) * 32 + (swz % 64) / 2; }
__host__ __device__ __forceinline__ int perm32(int rho) { const int n = rho >> 4, i = rho & 15; return 8 * (i >> 2) + 4 * n + (i & 3); }

__device__ __forceinline__ void glds16s(unsigned voff, unsigned long long sbase, unsigned lds_dst) { unsigned keep;
    asm volatile("s_mov_b32 %0, m0\n\ts_mov_b32 m0, %2\n\ts_nop 0\n\tglobal_load_lds_dwordx4 %1, %3\n\ts_mov_b32 m0, %0" : "=&s"(keep) : "v"(voff), "s"(lds_dst), "s"(sbase) : "memory"); }
struct Unit { int pm, pn, pc, koff, nt, mode; };
struct Gemm { const bf16_t* A; const bf16_t* Bt; int M, N, K, ld, sw, sx; };

struct StaticOrder {
    int nM, nN, nwg, G, c;
    __host__ __device__ void init(int M, int N, int G_, int c_) { nM = M / BM; nN = N / BM; nwg = nM * nN; G = G_; c = c_; }
    __host__ __device__ bool next(int i, Unit& u) const {
        const long L = (long)i * G + c; if (L >= nwg) return false;
        int wgid = (int)L; { const int q = nwg / NXCD, r = nwg % NXCD, xcd = wgid % NXCD, off = wgid / NXCD; wgid = (xcd < r ? xcd * (q + 1) : r * (q + 1) + (xcd - r) * q) + off; }
        const int nig = WGM * nN, gid = wgid / nig, fm = gid * WGM, gsz = (nM - fm) < WGM ? (nM - fm) : WGM;
        u.pm = fm + ((wgid % nig) % gsz); u.pn = (wgid % nig) / gsz; u.pc = u.pn; u.koff = 0; u.nt = 0; u.mode = 0; return true;
    }
};
struct GroupedOrder {
    int RT, NC, G, c; int pend[8];
    __device__ bool next(int i, Unit& u) const {
        const long L = (G % 8 == 0) ? ((long)(i * 8 + (c & 7)) * (G >> 3) + (c >> 3)) : ((long)i * G + c);
        if (L >= (long)RT * NC) return false;
        const int per = 8 * NC, blk = (int)(L / per), rem = (int)(L % per), rows = (RT - 8 * blk) < 8 ? (RT - 8 * blk) : 8;
        const int ct = rem / rows, rt = 8 * blk + rem % rows;
        int e = 0;
#pragma unroll
        for (int k = 0; k < 7; ++k) e += (rt * 256 >= pend[k]) ? 1 : 0;
        u.pm = rt; u.pn = e * NC + ct; u.pc = ct; u.koff = 0; u.nt = 0; u.mode = 0; return true;
    }
};
struct GroupedOrderK {
    int RT, NC, G, c, NSL, SNT; int pend[8];
    __device__ bool next(int i, Unit& u) const {
        const long L = (long)(i * 8 + (c & 7)) * (G >> 3) + (c >> 3);
        const int full = 2 * G / NC, RTF = RT < full ? RT : full;
        int rt, ct; u.koff = 0; u.nt = 0; u.mode = 0;
        if (L < (long)RTF * NC) {
            const int per = 8 * NC, blk = (int)(L / per), rem = (int)(L % per), rows = (RTF - 8 * blk) < 8 ? (RTF - 8 * blk) : 8;
            ct = rem / rows; rt = 8 * blk + rem % rows;
        } else {
            const long idx = L - (long)RTF * NC; if (idx >= (long)(RT - RTF) * NC * NSL) return false;
            const int su = (int)(idx / NSL), ks = (int)(idx % NSL);
            rt = RTF + su / NC; ct = su % NC; u.koff = ks * SNT * BK * 2; u.nt = SNT; u.mode = 1 + ks;
        }
        int e = 0;
#pragma unroll
        for (int k = 0; k < 7; ++k) e += (rt * 256 >= pend[k]) ? 1 : 0;
        u.pm = rt; u.pn = e * NC + ct; u.pc = ct; return true;
    }
};

typedef __bf16 bf16x2v __attribute__((ext_vector_type(2)));
__device__ __forceinline__ unsigned cvt_pk_bf16(float lo, float hi) { f32x2 v = {lo, hi}; bf16x2v b = __builtin_convertvector(v, bf16x2v); return __builtin_bit_cast(unsigned, b); }

__device__ __forceinline__ float row_rstd(const float* ssq, int row) {
    const f32x4* sp = (const f32x4*)(ssq + (size_t)row * 16);
    const f32x4 a = sp[0], b = sp[1], c = sp[2], d = sp[3];
    const float s = ((a[0] + a[1]) + (a[2] + a[3])) + ((b[0] + b[1]) + (b[2] + b[3])) + ((c[0] + c[1]) + (c[2] + c[3])) + ((d[0] + d[1]) + (d[2] + d[3]));
    return 1.0f / sqrtf(s * (1.0f / 1024.0f) + 1e-6f);
}
struct EpiQKV {
    static constexpr bool PERM = true;
    bf16_t* O; int ldc; const PG8_LAS float* rtab; const float* rope; int ropeMod, ropeLim; unsigned char* vt8; unsigned char* o8; int hm;
    __device__ __forceinline__ void operator()(const f32x4 (&acc)[2][2][4][2], const Unit& u, int ui, int wr, int wc, int fr, int fq) const {
        const int row0 = u.pm * BM + wr * 64 + fr;
        const int colh = wc * 32 + 8 * fq;
        const bool ropelane = ((wc & 1) == 0) && (fq < 2);
        const PG8_LAS float* rt = rtab + ui * 256 + wr * 64 + fr;
#pragma unroll
        for (int ai = 0; ai < 2; ++ai) {
            f32x4 cs[4], sn[4]; float rs[4];
#pragma unroll
            for (int m = 0; m < 4; ++m) {
                rs[m] = rt[ai * HALF + m * 16];
                cs[m] = (f32x4){1.f, 1.f, 1.f, 1.f}; sn[m] = (f32x4){0.f, 0.f, 0.f, 0.f};
                if (ropelane) { const float* rp = rope + (size_t)(row0 + ai * HALF + m * 16) * 16 + 4 * fq; cs[m] = *(const f32x4*)rp; sn[m] = *(const f32x4*)(rp + 8); }
            }
#pragma unroll
            for (int m = 0; m < 4; ++m) {
                const int row = row0 + ai * HALF + m * 16;
                const float r_ = rs[m]; const f32x4 c_ = cs[m], s_ = sn[m];
#pragma unroll
                for (int bj = 0; bj < 2; ++bj) {
                    const int colbase = u.pc * BM + bj * HALF;
                    f32x4 v0 = acc[ai][bj][m][0] * r_, v1 = acc[ai][bj][m][1] * r_;
                    if (ropelane && (colbase % ropeMod) < ropeLim) {
                        f32x4 w0, w1;
                        w0[0] = v0[0] * c_[0] - v0[1] * s_[0]; w0[1] = v0[1] * c_[0] + v0[0] * s_[0];
                        w0[2] = v0[2] * c_[1] - v0[3] * s_[1]; w0[3] = v0[3] * c_[1] + v0[2] * s_[1];
                        w1[0] = v1[0] * c_[2] - v1[1] * s_[2]; w1[1] = v1[1] * c_[2] + v1[0] * s_[2];
                        w1[2] = v1[2] * c_[3] - v1[3] * s_[3]; w1[3] = v1[3] * c_[3] + v1[2] * s_[3];
                        v0 = w0; v1 = w1;
                    }
                    if (o8) {
                        const float qs = ((colbase % 3072) < 1024) ? 4.0f : (((colbase % ropeMod) < ropeLim) ? 0.25f : 1.0f);
                        u32x2 w8; w8.x = pk_fp8x4(v0[0] * qs, v0[1] * qs, v0[2] * qs, v0[3] * qs); w8.y = pk_fp8x4(v1[0] * qs, v1[1] * qs, v1[2] * qs, v1[3] * qs);
                        size_t off = (size_t)row * ldc + colbase + colh;
                        if (hm) { const int col = colbase + colh, blk = col >> 10, sh = 2 * ((blk * 11) >> 5), head = (col & 1023) >> 6, bb = row >> 13, t = row & (SEQ - 1);
                            off = (size_t)blk * ((size_t)NTOK * 1024) + (size_t)((bb * 16 + head) * SEQ + ((t & ((1 << sh) - 1)) << (13 - sh)) + (t >> sh)) * 64 + (col & 63); }
                        *(u32x2*)(o8 + off) = w8;
                    } else if (vt8 && colbase >= 2048) {
                        u32x2 w8; w8.x = pk_fp8x4(v0[0], v0[1], v0[2], v0[3]); w8.y = pk_fp8x4(v1[0], v1[1], v1[2], v1[3]);
                        *(u32x2*)(vt8 + (size_t)row * 1024 + (colbase - 2048) + colh) = w8;
                    } else {
                    u32x4 w; w.x = cvt_pk_bf16(v0[0], v0[1]); w.y = cvt_pk_bf16(v0[2], v0[3]); w.z = cvt_pk_bf16(v1[0], v1[1]); w.w = cvt_pk_bf16(v1[2], v1[3]);
                    *(u32x4*)(O + (size_t)row * ldc + colbase + colh) = w;
                    }
                }
            }
        }
    }
};
struct EpiSwiGLU {
    static constexpr bool PERM = true;
    bf16_t* O; int ldc; const PG8_LAS float* rtab;
    __device__ __forceinline__ void operator()(const f32x4 (&acc)[2][2][4][2], const Unit& u, int ui, int wr, int wc, int fr, int fq) const {
        const int row0 = u.pm * BM + wr * 64 + fr;
        const int col = u.pc * HALF + wc * 32 + 8 * fq;
#pragma unroll
        for (int ai = 0; ai < 2; ++ai)
#pragma unroll
            for (int m = 0; m < 4; ++m) {
                const int row = row0 + ai * HALF + m * 16;
                const float rs = rtab ? rtab[ui * 256 + wr * 64 + fr + ai * HALF + m * 16] : 1.0f;
                float h[8];
#pragma unroll
                for (int n = 0; n < 2; ++n)
#pragma unroll
                    for (int i = 0; i < 4; ++i) {
                        const float a = acc[ai][0][m][n][i] * rs, b = acc[ai][1][m][n][i] * rs;
                        h[n * 4 + i] = a * __builtin_amdgcn_rcpf(1.0f + __expf(-a)) * b;
                    }
                u32x4 w; w.x = cvt_pk_bf16(h[0], h[1]); w.y = cvt_pk_bf16(h[2], h[3]); w.z = cvt_pk_bf16(h[4], h[5]); w.w = cvt_pk_bf16(h[6], h[7]);
                *(u32x4*)(O + (size_t)row * ldc + col) = w;
            }
    }
};
struct EpiSwiGLU8 {
    static constexpr bool PERM = true;
    unsigned char* O; int ldc;
    __device__ __forceinline__ void operator()(const f32x4 (&acc)[2][2][4][2], const Unit& u, int ui, int wr, int wc, int fr, int fq) const {
        const int row0 = u.pm * BM + wr * 64 + fr;
        const int col = u.pc * HALF + wc * 32 + 8 * fq;
#pragma unroll
        for (int ai = 0; ai < 2; ++ai)
#pragma unroll
            for (int m = 0; m < 4; ++m) {
                const int row = row0 + ai * HALF + m * 16;
                float h[8];
#pragma unroll
                for (int n = 0; n < 2; ++n)
#pragma unroll
                    for (int i = 0; i < 4; ++i) { const float a = acc[ai][0][m][n][i], b = acc[ai][1][m][n][i];
                        h[n * 4 + i] = (a * b) * (__builtin_amdgcn_rcpf(1.0f + __builtin_amdgcn_exp2f(a * (-LOG2E / W8_SCALE))) * (H8_SCALE / (W8_SCALE * W8_SCALE))); }
                u32x2 w; w.x = pk_fp8x4(h[0], h[1], h[2], h[3]); w.y = pk_fp8x4(h[4], h[5], h[6], h[7]);
                *(u32x2*)(O + (size_t)row * ldc + col) = w;
            }
    }
};
struct EpiRes {
    static constexpr bool PERM = false;
    bf16_t* XB; float* ssq; int ldc; unsigned char* X8;
    __device__ __forceinline__ void operator()(const f32x4 (&acc)[2][2][4][2], const Unit& u, int ui, int wr, int wc, int fr, int fq) const {
        const int row0 = u.pm * BM + wr * 64 + fr;
        const int col0 = u.pc * BM + wc * 32 + 4 * fq;
#pragma unroll
        for (int ai = 0; ai < 2; ++ai) {
            u32x2 rv[4][2][2];
#pragma unroll
            for (int m = 0; m < 4; ++m)
#pragma unroll
                for (int bj = 0; bj < 2; ++bj)
#pragma unroll
                    for (int n = 0; n < 2; ++n) rv[m][bj][n] = *(const u32x2*)(XB + (size_t)(row0 + ai * HALF + m * 16) * ldc + col0 + bj * HALF + n * 16);
#pragma unroll
            for (int m = 0; m < 4; ++m) {
                const int row = row0 + ai * HALF + m * 16;
                float q = 0.f;
#pragma unroll
                for (int bj = 0; bj < 2; ++bj)
#pragma unroll
                    for (int n = 0; n < 2; ++n) {
                        const size_t off = (size_t)row * ldc + col0 + bj * HALF + n * 16;
                        const u32x2 rr = rv[m][bj][n]; const f32x4 a = acc[ai][bj][m][n];
                        const float v0 = bflo(rr.x) + a[0], v1 = bfhi(rr.x) + a[1], v2 = bflo(rr.y) + a[2], v3 = bfhi(rr.y) + a[3];
                        q += (v0 * v0 + v1 * v1) + (v2 * v2 + v3 * v3);
                        u32x2 w; w.x = cvt_pk_bf16(v0, v1); w.y = cvt_pk_bf16(v2, v3); *(u32x2*)(XB + off) = w;
                        if (X8) *(unsigned*)(X8 + off) = pk_fp8x4(v0, v1, v2, v3);
                    }
                q += __shfl_xor(q, 16); q += __shfl_xor(q, 32);
                if (fq == 0) ssq[(size_t)row * 16 + u.pc * 4 + wc] = q;
            }
        }
    }
};
struct EpiPlain {
    static constexpr bool PERM = true;
    bf16_t* O; int ldc;
    __device__ __forceinline__ void operator()(const f32x4 (&acc)[2][2][4][2], const Unit& u, int ui, int wr, int wc, int fr, int fq) const {
        const int row0 = u.pm * BM + wr * 64 + fr;
        const int col0 = u.pc * BM + wc * 32 + 8 * fq;
#pragma unroll
        for (int ai = 0; ai < 2; ++ai)
#pragma unroll
            for (int m = 0; m < 4; ++m) {
                bf16_t* rowp = O + (size_t)(row0 + ai * HALF + m * 16) * ldc + col0;
#pragma unroll
                for (int bj = 0; bj < 2; ++bj) {
                    const f32x4 v0 = acc[ai][bj][m][0], v1 = acc[ai][bj][m][1];
                    u32x4 w; w.x = cvt_pk_bf16(v0[0], v0[1]); w.y = cvt_pk_bf16(v0[2], v0[3]); w.z = cvt_pk_bf16(v1[0], v1[1]); w.w = cvt_pk_bf16(v1[2], v1[3]);
                    *(u32x4*)(rowp + bj * HALF) = w;
                }
            }
    }
};

struct EpiPlainK {
    static constexpr bool PERM = true;
    bf16_t* O; int ldc; float* part; int rtf, nsl;
    __device__ __forceinline__ void operator()(const f32x4 (&acc)[2][2][4][2], const Unit& u, int ui, int wr, int wc, int fr, int fq) const {
        if (u.mode == 0) {
            const int row0 = u.pm * BM + wr * 64 + fr; const int col0 = u.pc * BM + wc * 32 + 8 * fq;
#pragma unroll
            for (int ai = 0; ai < 2; ++ai)
#pragma unroll
                for (int m = 0; m < 4; ++m) {
                    bf16_t* rowp = O + (size_t)(row0 + ai * HALF + m * 16) * ldc + col0;
#pragma unroll
                    for (int bj = 0; bj < 2; ++bj) {
                        const f32x4 v0 = acc[ai][bj][m][0], v1 = acc[ai][bj][m][1];
                        u32x4 w; w.x = cvt_pk_bf16(v0[0], v0[1]); w.y = cvt_pk_bf16(v0[2], v0[3]); w.z = cvt_pk_bf16(v1[0], v1[1]); w.w = cvt_pk_bf16(v1[2], v1[3]);
                        *(u32x4*)(rowp + bj * HALF) = w;
                    }
                }
        } else {
            float* pb = part + (size_t)(((u.pm - rtf) * 4 + u.pc) * nsl + (u.mode - 1)) * 65536 + (size_t)(wr * 64 + fr) * 256 + wc * 32 + 8 * fq;
#pragma unroll
            for (int ai = 0; ai < 2; ++ai)
#pragma unroll
                for (int m = 0; m < 4; ++m)
#pragma unroll
                    for (int bj = 0; bj < 2; ++bj) { float* p = pb + (size_t)(ai * HALF + m * 16) * 256 + bj * HALF; *(f32x4*)p = acc[ai][bj][m][0]; *(f32x4*)(p + 4) = acc[ai][bj][m][1]; }
        }
    }
};

typedef int v8i_t __attribute__((ext_vector_type(8)));
typedef int v4i_t __attribute__((ext_vector_type(4)));
__device__ __forceinline__ v8i_t cat32(bf16x8 lo, bf16x8 hi) { const v4i_t a = __builtin_bit_cast(v4i_t, lo), b = __builtin_bit_cast(v4i_t, hi); return __builtin_shufflevector(a, b, 0, 1, 2, 3, 4, 5, 6, 7); }
template <class Epi, class Sched, bool FP8 = false>
__device__ __forceinline__ void gemm_phase(PG8_LAS unsigned char* lds, const Gemm g, const Sched& S, const Epi& E) {
    const int tid = threadIdx.x, wid = __builtin_amdgcn_readfirstlane(tid >> 6), lane = tid & 63, wr = wid >> 2, wc = wid & 3, fr = lane & 15, fq = lane >> 4;
    const int K = g.ld ? g.ld : g.K, ntd = g.K / BK;
    unsigned voffA[2], voffB[2];
#pragma unroll
    for (int i = 0; i < 2; ++i) { int R, C; stage_rc(tid * 16 + i * 8192, R, C); const int Rb = Epi::PERM ? ((R & ~31) + perm32(R & 31)) : R;
        voffA[i] = (unsigned)(R * K + C) * 2u; voffB[i] = (unsigned)(Rb * K + C) * 2u; }
    const size_t kstep = (size_t)(BK * 2);
    const size_t hstep = (size_t)HALF * K * 2;
    const size_t tstep = 2 * hstep;
    const unsigned ldsw = (unsigned)wid * 1024u; const unsigned ldsb = (unsigned)(uintptr_t)lds;
    const int aoff = lds_byte(wr * 64 + fr, fq * 8), boff = lds_byte(wc * 32 + fr, fq * 8);
#define PG8_SA(b, h) (((b) * 2 + (h)) * HTB)
#define PG8_SB(b, h) ((4 + (b) * 2 + (h)) * HTB)
#define PG8_STAGE(bufoff, gbase, voff) do { _Pragma("unroll") for (int _i = 0; _i < 2; ++_i) { \
        if constexpr (FP8) glds16s((voff)[_i], (unsigned long long)(gbase), (unsigned)__builtin_amdgcn_readfirstlane((int)(ldsb + (bufoff) + ldsw + _i * 8192))); \
        else __builtin_amdgcn_global_load_lds((const unsigned*)((const char*)(gbase) + (voff)[_i]), (PG8_LAS unsigned*)(lds + (bufoff) + ldsw + _i * 8192), 16, 0, 0); } } while (0)
#define PG8_LDA(dst, b, h) do { if constexpr (FP8) { _Pragma("unroll") for (int m = 0; m < 4; ++m) dst##8[m] = __builtin_shufflevector(*(const PG8_LAS v4i_t*)(lds + PG8_SA(b, h) + aoff + m * 2048), *(const PG8_LAS v4i_t*)(lds + PG8_SA(b, h) + aoff + m * 2048 + 1024), 0, 1, 2, 3, 4, 5, 6, 7); } \
        else { _Pragma("unroll") for (int m = 0; m < 4; ++m) _Pragma("unroll") for (int k = 0; k < 2; ++k) dst[m][k] = *(const PG8_LAS bf16x8*)(lds + PG8_SA(b, h) + aoff + m * 2048 + k * 1024); } } while (0)
#define PG8_LDB(dst, b, h) do { if constexpr (FP8) { _Pragma("unroll") for (int n = 0; n < 2; ++n) dst##8[n] = __builtin_shufflevector(*(const PG8_LAS v4i_t*)(lds + PG8_SB(b, h) + boff + n * 2048), *(const PG8_LAS v4i_t*)(lds + PG8_SB(b, h) + boff + n * 2048 + 1024), 0, 1, 2, 3, 4, 5, 6, 7); } \
        else { _Pragma("unroll") for (int n = 0; n < 2; ++n) _Pragma("unroll") for (int k = 0; k < 2; ++k) dst[n][k] = *(const PG8_LAS bf16x8*)(lds + PG8_SB(b, h) + boff + n * 2048 + k * 1024); } } while (0)
#define PG8_MMA(ai, bj, At, Bt) do { __builtin_amdgcn_s_setprio(1); \
        if constexpr (FP8) { _Pragma("unroll") for (int m = 0; m < 4; ++m) _Pragma("unroll") for (int n = 0; n < 2; ++n) \
            asm volatile("v_mfma_f32_16x16x128_f8f6f4 %0, %1, %2, %0" : "+v"(acc[ai][bj][m][n]) : "v"(Bt##8[n]), "v"(At##8[m])); }   \
        else { _Pragma("unroll") for (int m = 0; m < 4; ++m) _Pragma("unroll") for (int n = 0; n < 2; ++n) _Pragma("unroll") for (int k = 0; k < 2; ++k) acc[ai][bj][m][n] = __builtin_amdgcn_mfma_f32_16x16x32_bf16(Bt[n][k], At[m][k], acc[ai][bj][m][n], 0, 0, 0); } \
        __builtin_amdgcn_s_setprio(0); } while (0)
#define PG8_WAIT_V(n) asm volatile("s_waitcnt vmcnt(" #n ")" ::: "memory")
#define PG8_WAIT_L(n) asm volatile("s_waitcnt lgkmcnt(" #n ")" ::: "memory")
#define PG8_BAR __builtin_amdgcn_s_barrier()
#define PG8_SCHED __builtin_amdgcn_sched_barrier(0)
    Unit cur, nxt; int ui = 0;
    if (!S.next(0, cur)) return;
    f32x4 acc[2][2][4][2];
#pragma unroll
    for (int a = 0; a < 2; ++a)
#pragma unroll
        for (int b = 0; b < 2; ++b)
#pragma unroll
            for (int m = 0; m < 4; ++m)
#pragma unroll
                for (int n = 0; n < 2; ++n) acc[a][b][m][n] = (f32x4){0.f, 0.f, 0.f, 0.f};
    bf16x8 At[4][2], B0[2][2], B1[2][2]; v8i_t At8[4], B08[2], B18[2];
    const char* cA = (const char*)g.A + (size_t)cur.pm * tstep + cur.koff; const char* cB = (const char*)g.Bt + (size_t)cur.pn * tstep + cur.koff;
    PG8_STAGE(PG8_SB(0, 0), cB, voffB); PG8_STAGE(PG8_SB(0, 1), cB + hstep, voffB); PG8_STAGE(PG8_SA(0, 0), cA, voffA); PG8_STAGE(PG8_SA(0, 1), cA + hstep, voffA);
    if (wr == 1) PG8_BAR;
    PG8_WAIT_V(2); PG8_BAR;
    PG8_STAGE(PG8_SB(1, 0), cB + kstep, voffB); PG8_STAGE(PG8_SA(1, 0), cA + kstep, voffA); PG8_STAGE(PG8_SB(1, 1), cB + hstep + kstep, voffB);
    PG8_WAIT_V(6); PG8_BAR;
    for (;;) {
        const bool has_next = S.next(ui + 1, nxt);
        const char* nA = has_next ? (const char*)g.A + (size_t)nxt.pm * tstep + nxt.koff : cA; const char* nB = has_next ? (const char*)g.Bt + (size_t)nxt.pn * tstep + nxt.koff : cB;
        const int nt = cur.nt ? cur.nt : ntd;
#pragma nounroll
        for (int t = 0; t < nt; t += 2) {
            const bool last = (t == nt - 2);
            const char* a1 = cA + (size_t)(t + 1) * kstep;
            const char* a2 = last ? nA : cA + (size_t)(t + 2) * kstep; const char* b2 = last ? nB : cB + (size_t)(t + 2) * kstep;
            const char* a3 = a2 + kstep; const char* b3 = b2 + kstep;
            PG8_LDB(B0, 0, 0); PG8_LDB(B1, 0, 1); PG8_SCHED; PG8_LDA(At, 0, 0); PG8_STAGE(PG8_SA(1, 1), a1 + hstep, voffA);
            PG8_WAIT_V(8); PG8_WAIT_L(0); PG8_BAR; PG8_MMA(0, 0, At, B0); PG8_MMA(0, 1, At, B1); PG8_BAR; PG8_SCHED;
            PG8_LDA(At, 0, 1); PG8_STAGE(PG8_SB(0, 0), b2, voffB); PG8_STAGE(PG8_SB(0, 1), b2 + hstep, voffB); PG8_STAGE(PG8_SA(0, 0), a2, voffA);
            PG8_WAIT_V(8); PG8_WAIT_L(0); PG8_BAR; PG8_MMA(1, 0, At, B0); PG8_MMA(1, 1, At, B1); PG8_BAR; PG8_SCHED;
            PG8_LDB(B0, 1, 0); PG8_LDB(B1, 1, 1); PG8_SCHED; PG8_LDA(At, 1, 0); PG8_STAGE(PG8_SA(0, 1), a2 + hstep, voffA);
            PG8_WAIT_V(8); PG8_WAIT_L(0); PG8_BAR; PG8_MMA(0, 0, At, B0); PG8_MMA(0, 1, At, B1); PG8_BAR; PG8_SCHED;
            PG8_LDA(At, 1, 1); PG8_STAGE(PG8_SB(1, 0), b3, voffB); PG8_STAGE(PG8_SB(1, 1), b3 + hstep, voffB); PG8_STAGE(PG8_SA(1, 0), a3, voffA);
            PG8_WAIT_V(8); PG8_WAIT_L(0); PG8_BAR; PG8_MMA(1, 0, At, B0); PG8_MMA(1, 1, At, B1); PG8_BAR; PG8_SCHED;
        }
        if (wr == 0) PG8_BAR;
        if constexpr (FP8) asm volatile("s_nop 15\n\ts_nop 15" ::: "memory");
        { int le_ = lane; asm volatile("" : "+v"(le_)); E(acc, cur, ui, wr, wc, le_ & 15, le_ >> 4); }
        if (!has_next) break;
#pragma unroll
        for (int a = 0; a < 2; ++a)
#pragma unroll
            for (int b = 0; b < 2; ++b)
#pragma unroll
                for (int m = 0; m < 4; ++m)
#pragma unroll
                    for (int n = 0; n < 2; ++n) acc[a][b][m][n] = (f32x4){0.f, 0.f, 0.f, 0.f};
        cur = nxt; cA = nA; cB = nB; ++ui;
        if (wr == 1) PG8_BAR;
    }
    PG8_WAIT_V(0);
    PG8_BAR;
#undef PG8_SA
#undef PG8_SB
#undef PG8_STAGE
#undef PG8_LDA
#undef PG8_LDB
#undef PG8_MMA
#undef PG8_WAIT_V
#undef PG8_WAIT_L
#undef PG8_BAR
#undef PG8_SCHED
}
}

#define XB_TMO      128
#define XB_XCNT(j)  (256  + 64 * (j))
#define XB_XSUB(j)  (1280 + 64 * (j))
#define XB_XGEN(j)  (2304 + 64 * (j))
#define XB_TOP      3328
#define XB_TOPGEN   3392
#define XCD_BAR_WORDS 3456
#define XB_SPIN_CAP (1u << 24)

__device__ __forceinline__ unsigned xb_ld(unsigned* p)              { return __hip_atomic_load(p, __ATOMIC_RELAXED, __HIP_MEMORY_SCOPE_AGENT); }
__device__ __forceinline__ unsigned xb_add(unsigned* p, unsigned v) { return __hip_atomic_fetch_add(p, v, __ATOMIC_RELAXED, __HIP_MEMORY_SCOPE_AGENT); }
__device__ __forceinline__ unsigned xb_xcc_id() { return (unsigned)__builtin_amdgcn_s_getreg((3 << 11) | 20) & 0xFu; }
#define XB_SPIN(cond, bar) do { unsigned _sp = 0; while (cond) { __builtin_amdgcn_s_sleep(1); \
    if ((++_sp & 255u) == 0u) { if (xb_ld(&(bar)[XB_TMO])) break; if (_sp > XB_SPIN_CAP) { atomicAdd(&(bar)[XB_TMO], 1u); break; } } } } while (0)

struct XcdBarrier { unsigned* bar; unsigned x; volatile LAS unsigned* st; };

__device__ __forceinline__ XcdBarrier xcd_barrier_post(unsigned* bar, volatile LAS unsigned* st) {
    XcdBarrier b; b.bar = bar; b.x = xb_xcc_id(); b.st = st;
    if (threadIdx.x == 0) (void)xb_add(&bar[XB_XCNT(b.x)], 1u);
    return b;
}
__device__ __forceinline__ void xcd_barrier_complete(unsigned* bar, unsigned x, unsigned& nloc, unsigned& nx) {
    const unsigned G = gridDim.x * gridDim.y * gridDim.z;
    unsigned sum, cnt, mine, sp = 0u;
    for (;;) {
        sum = 0u; cnt = 0u; mine = 0u;
#pragma unroll
        for (unsigned j = 0; j < 16; ++j) { const unsigned c = xb_ld(&bar[XB_XCNT(j)]); sum += c; cnt += (c > 0u) ? 1u : 0u; mine = (j == x) ? c : mine; }
        if (sum == G) break;
        __builtin_amdgcn_s_sleep(1);
        if ((++sp & 255u) == 0u) { if (xb_ld(&bar[XB_TMO])) break; if (sp > XB_SPIN_CAP) { atomicAdd(&bar[XB_TMO], 1u); break; } }
    }
    nloc = mine > 0u ? mine : 1u; nx = cnt > 0u ? cnt : 1u;
}
__device__ __forceinline__ void xcd_barrier(const XcdBarrier& b) {
    asm volatile("s_waitcnt vmcnt(0)" ::: "memory");
    __syncthreads();
    if (threadIdx.x == 0) {
        unsigned* bar = b.bar;
        __builtin_amdgcn_s_waitcnt(0);
        unsigned nloc = b.st[0], nx = b.st[1];
        if (nloc == 0u) { xcd_barrier_complete(bar, b.x, nloc, nx); b.st[0] = nloc; b.st[1] = nx; }
        const unsigned old = xb_add(&bar[XB_XSUB(b.x)], 1u);
        const unsigned gen = old / nloc;
        if (old + 1u == (gen + 1u) * nloc) {
            __builtin_amdgcn_fence(__ATOMIC_RELEASE, "agent");
            asm volatile("s_waitcnt vmcnt(0)" ::: "memory");
            const unsigned og = xb_add(&bar[XB_TOP], 1u);
            const unsigned tg = og / nx;
            if (og + 1u == (tg + 1u) * nx) xb_add(&bar[XB_TOPGEN], 1u);
            else XB_SPIN(xb_ld(&bar[XB_TOPGEN]) == tg, bar);
            __builtin_amdgcn_fence(__ATOMIC_ACQUIRE, "agent");
            xb_add(&bar[XB_XGEN(b.x)], 1u);
            asm volatile("s_waitcnt vmcnt(0)" ::: "memory");
        } else {
            XB_SPIN(xb_ld(&bar[XB_XGEN(b.x)]) == gen, bar);
            __builtin_amdgcn_fence(__ATOMIC_ACQUIRE, "agent");
            asm volatile("s_waitcnt vmcnt(0)" ::: "memory");
        }
    }
    __syncthreads();
}

struct Ctx {
    LAS unsigned char* lds;
    unsigned char* ws;
    const void* const* in;
    float* out;
    int tid, lane, wave, G, bid;
};
#define IN_F(i) ((const float*)C.in[i])
#define WSP(T, off) ((T*)(C.ws + (off)))

struct WJob { const float* W0; const float* W1; bf16_t* WT; const float* gain; int K, ldw, Nout, kind, nE, fp8; size_t sW, sWT; };
__device__ __forceinline__ int permsrc(int j) { return j < 16 ? ((j >> 1) + 8 * (j & 1)) : j; }
__device__ __forceinline__ void map_col(int kind, int np, int& src, int& which, float& scale) {
    which = 0; scale = 1.f; src = np;
    if (kind == 1) { const int blk = (np >> 10) % 3; const int hd = np & 63; if (blk < 2) src = np - hd + permsrc(hd); if (blk == 0) scale = C2; }
    else if (kind == 3) { const int hd = np & 63; if (np < 1152) src = np - hd + permsrc(hd); if (np < 1024) scale = C2; }
    else if (kind == 4) { const int tile = np >> 8, w = np & 255; src = tile * 128 + (w & 127); which = w >> 7; }
}
struct TItem { const float* src; float scale; int e, k0, n0; };
__device__ __forceinline__ TItem titem(const WJob& J, int item, int lane) {
    TItem T; const int nblk = J.Nout / 32, per = (J.K / 64) * nblk;
    T.e = item / per; const int r = item % per, kb = r / nblk, nb = r % nblk; T.k0 = 64 * kb; T.n0 = 32 * nb;
    int src, which; map_col(J.kind, T.n0 + (lane & 31), src, which, T.scale);
    const unsigned long long a0_ = (unsigned long long)J.W0, a1_ = (unsigned long long)(J.W1 ? J.W1 : J.W0);
    T.src = (const float*)(a0_ + (a1_ - a0_) * (unsigned long long)which) + (size_t)T.e * J.sW + (size_t)(T.k0 + (lane >> 5)) * J.ldw + src;
    return T;
}
__device__ __forceinline__ void tload(const WJob& J, const TItem& T, float (&v)[32]) {
#pragma unroll
    for (int i = 0; i < 32; ++i) v[i] = __builtin_nontemporal_load(T.src + (size_t)(2 * i) * J.ldw);
}
__device__ __forceinline__ void tstore(const WJob& J, const TItem& T, const float (&v)[32], LAS float* scr, int lane) {
#pragma unroll
    for (int i = 0; i < 32; ++i) scr[(2 * i + (lane >> 5)) * 33 + (lane & 31)] = v[i] * T.scale;
    LDS_WAIT(); asm volatile("" ::: "memory");
    const int c = lane & 7;
    f32x4 g0 = (f32x4){1.f, 1.f, 1.f, 1.f}, g1 = g0;
    if (J.gain) { g0 = *(const f32x4*)(J.gain + T.k0 + 8 * c); g1 = *(const f32x4*)(J.gain + T.k0 + 8 * c + 4); }
    if (J.fp8) {
        unsigned char* WT8 = (unsigned char*)J.WT + (size_t)T.e * J.sWT;
        g0 = g0 * W8_SCALE; g1 = g1 * W8_SCALE;
#pragma unroll
        for (int j = 0; j < 4; ++j) { const int n = (lane >> 3) + 8 * j; const LAS float* s = scr + (8 * c) * 33 + n;
            u32x2 o; o.x = pk_fp8x4(s[0 * 33] * g0[0], s[1 * 33] * g0[1], s[2 * 33] * g0[2], s[3 * 33] * g0[3]); o.y = pk_fp8x4(s[4 * 33] * g1[0], s[5 * 33] * g1[1], s[6 * 33] * g1[2], s[7 * 33] * g1[3]);
            *(u32x2*)(WT8 + (size_t)(T.n0 + n) * J.K + T.k0 + 8 * c) = o; }
    } else {
    bf16_t* WT = J.WT + (size_t)T.e * J.sWT;
#pragma unroll
    for (int j = 0; j < 4; ++j) { const int n = (lane >> 3) + 8 * j; const LAS float* s = scr + (8 * c) * 33 + n;
        u32x4 o; o.x = pk2(s[0 * 33] * g0[0], s[1 * 33] * g0[1]); o.y = pk2(s[2 * 33] * g0[2], s[3 * 33] * g0[3]); o.z = pk2(s[4 * 33] * g1[0], s[5 * 33] * g1[1]); o.w = pk2(s[6 * 33] * g1[2], s[7 * 33] * g1[3]);
        *(u32x4*)(WT + (size_t)(T.n0 + n) * J.K + T.k0 + 8 * c) = o; }
    }
    LDS_WAIT(); asm volatile("" ::: "memory");
}
__device__ __forceinline__ WJob make_job(const Ctx& C, int j) {
    WJob J; J.W1 = nullptr; J.gain = nullptr; J.nE = 1; J.sW = 0; J.sWT = 0; J.kind = 0; J.fp8 = (j == 0 || j == 12 || j == 6 || j == 7 || j >= 14) ? 1 : 0;
    switch (j) {
    case 0:  J.W0 = IN_F(3);  J.WT = WSP(bf16_t, WS_WQKV0); J.gain = IN_F(2);  J.K = 1024; J.ldw = 9216; J.Nout = 9216; J.kind = 1; break;
    case 1:  J.W0 = IN_F(4);  J.WT = WSP(bf16_t, WS_WO0);   J.K = 1024; J.ldw = 1024; J.Nout = 1024; break;
    case 2:  J.W0 = IN_F(6);  J.W1 = IN_F(7); J.WT = WSP(bf16_t, WS_W13_0); J.gain = IN_F(5); J.K = 1024; J.ldw = FF; J.Nout = 2 * FF; J.kind = 4; break;
    case 3:  J.W0 = IN_F(8);  J.WT = WSP(bf16_t, WS_W2_0);  J.K = FF; J.ldw = 1024; J.Nout = 1024; break;
    case 4:  J.W0 = IN_F(10); J.WT = WSP(bf16_t, WS_WQKV1); J.gain = IN_F(9);  J.K = 1024; J.ldw = 3072; J.Nout = 3072; J.kind = 1; break;
    case 5:  J.W0 = IN_F(16); J.WT = WSP(bf16_t, WS_WO1);   J.K = 1024; J.ldw = 1024; J.Nout = 1024; break;
    case 6:  J.W0 = IN_F(19); J.W1 = IN_F(20); J.WT = WSP(bf16_t, WS_WM13); J.gain = IN_F(17); J.K = 1024; J.ldw = FFE; J.Nout = 2 * FFE; J.kind = 4; J.nE = 8; J.sW = (size_t)1024 * FFE; J.sWT = (size_t)2 * FFE * 1024; break;
    case 7:  J.W0 = IN_F(21); J.WT = WSP(bf16_t, WS_WM2);   J.K = FFE; J.ldw = 1024; J.Nout = 1024; J.nE = 8; J.sW = (size_t)FFE * 1024; J.sWT = (size_t)1024 * FFE; break;
    case 8:  J.W0 = IN_F(23); J.WT = WSP(bf16_t, WS_WQKV2); J.gain = IN_F(22); J.K = 1024; J.ldw = 1280; J.Nout = 1280; J.kind = 3; break;
    case 9:  J.W0 = IN_F(25); J.WT = WSP(bf16_t, WS_WO2);   J.K = 1024; J.ldw = 1024; J.Nout = 1024; break;
    case 10: J.W0 = IN_F(27); J.W1 = IN_F(28); J.WT = WSP(bf16_t, WS_W13_2); J.gain = IN_F(26); J.K = 1024; J.ldw = FF; J.Nout = 2 * FF; J.kind = 4; break;
    case 11: J.W0 = IN_F(29); J.WT = WSP(bf16_t, WS_W2_2);  J.K = FF; J.ldw = 1024; J.Nout = 1024; break;
    case 12: J.W0 = IN_F(31); J.WT = WSP(bf16_t, WS_WQKV3); J.gain = IN_F(30); J.K = 1024; J.ldw = 9216; J.Nout = 9216; J.kind = 1; break;
    case 13: J.W0 = IN_F(32); J.WT = WSP(bf16_t, WS_WO3);   J.K = 1024; J.ldw = 1024; J.Nout = 1024; break;
    case 14: J.W0 = IN_F(35); J.W1 = IN_F(36); J.WT = WSP(bf16_t, WS_WM13); J.gain = IN_F(33); J.K = 1024; J.ldw = FFE; J.Nout = 2 * FFE; J.kind = 4; J.nE = 8; J.sW = (size_t)1024 * FFE; J.sWT = (size_t)2 * FFE * 1024; break;
    default: J.W0 = IN_F(37); J.WT = WSP(bf16_t, WS_WM2);   J.K = FFE; J.ldw = 1024; J.Nout = 1024; J.nE = 8; J.sW = (size_t)FFE * 1024; J.sWT = (size_t)1024 * FFE; break;
    }
    return J;
}
template <int j>
__device__ __forceinline__ void convert_one(const Ctx& C) {
    LAS float* scr = (LAS float*)(C.lds + C.wave * 16384);
    const int gw = C.bid * 8 + C.wave, NGW = C.G * 8;
    const WJob J = make_job(C, j);
    const int nitems = J.nE * (J.K / 64) * (J.Nout / 32);
    if (gw >= nitems) return;
    TItem T = titem(J, gw, C.lane); float v[32]; tload(J, T, v);
    for (int it = gw; it < nitems; it += NGW) {
        const int nx = it + NGW; TItem Tn = T; float w[32];
        if (nx < nitems) { Tn = titem(J, nx, C.lane); tload(J, Tn, w); }
        tstore(J, T, v, scr, C.lane);
        if (nx < nitems) { T = Tn;
#pragma unroll
            for (int i = 0; i < 32; ++i) v[i] = w[i]; }
    }
}
__device__ __forceinline__ void convert_weights_first(const Ctx& C) {
    convert_one<0>(C); convert_one<1>(C); convert_one<2>(C); convert_one<3>(C); convert_one<4>(C); convert_one<5>(C); convert_one<6>(C);
    convert_one<7>(C); convert_one<8>(C); convert_one<9>(C); convert_one<10>(C); convert_one<11>(C); convert_one<12>(C); convert_one<13>(C);
}
__device__ __forceinline__ void convert_weights_second(const Ctx& C) { convert_one<14>(C); convert_one<15>(C); }
__device__ __forceinline__ void rope_table(const Ctx& C) {
    const int* pos = (const int*)C.in[1];
    float* tab = WSP(float, WS_ROPE);
    for (int i = C.bid * 512 + C.tid; i < NTOK * 8; i += C.G * 512) {
        const int tok = i >> 3, f = i & 7;
        const float inv = powf(500000.0f, -(float)f * 0.125f);
        const float ang = (float)pos[tok] * inv;
        const double a = (double)ang;
        const double k = rint(a * 0.15915494309189535);
        const float r = (float)(a - k * 6.283185307179586);
        tab[(size_t)tok * 16 + f] = cosf(r); tab[(size_t)tok * 16 + 8 + f] = sinf(r);
    }
}
__device__ __forceinline__ void write_ssq_row(float* ssq, int row, float tot, int lane) { if (lane < 16) ssq[(size_t)row * 16 + lane] = (lane == 0) ? tot : 0.f; }
__device__ __forceinline__ void x_to_bf16(const Ctx& C) {
    const float* x = IN_F(0); bf16_t* xb = WSP(bf16_t, WS_XB); float* ssq = WSP(float, WS_SSQ); unsigned char* x8 = WSP(unsigned char, WS_X8);
    const int gw = C.bid * 8 + C.wave, NGW = C.G * 8;
    for (int m = gw; m < NTOK; m += NGW) {
        const f32x4* xr = (const f32x4*)(x + (size_t)m * DM) + C.lane; u32x2* o = (u32x2*)(xb + (size_t)m * DM) + C.lane; unsigned* o8 = (unsigned*)(x8 + (size_t)m * DM) + C.lane;
        float s = 0.f;
#pragma unroll
        for (int j = 0; j < 4; ++j) { const f32x4 v = xr[64 * j]; s += (v[0] * v[0] + v[1] * v[1]) + (v[2] * v[2] + v[3] * v[3]); u32x2 w; w.x = pk2(v[0], v[1]); w.y = pk2(v[2], v[3]); o[64 * j] = w; o8[64 * j] = pk_fp8x4(v[0], v[1], v[2], v[3]); }
        write_ssq_row(ssq, m, wave_sum(s), C.lane);
    }
}

__device__ __forceinline__ void load_q64(const bf16_t* qp, float (&q)[64]) {
#pragma unroll
    for (int c = 0; c < 8; ++c) { const u32x4 w = *(const u32x4*)(qp + 8 * c);
        q[8 * c + 0] = bflo(w.x); q[8 * c + 1] = bfhi(w.x); q[8 * c + 2] = bflo(w.y); q[8 * c + 3] = bfhi(w.y); q[8 * c + 4] = bflo(w.z); q[8 * c + 5] = bfhi(w.z); q[8 * c + 6] = bflo(w.w); q[8 * c + 7] = bfhi(w.w); }
}
__device__ __forceinline__ float dot64(const float (&q)[64], const bf16_t* kp) {
    float s = 0.f;
#pragma unroll
    for (int c = 0; c < 8; ++c) { const u32x4 w = *(const u32x4*)(kp + 8 * c);
        s += q[8 * c + 0] * bflo(w.x); s += q[8 * c + 1] * bfhi(w.x); s += q[8 * c + 2] * bflo(w.y); s += q[8 * c + 3] * bfhi(w.y);
        s += q[8 * c + 4] * bflo(w.z); s += q[8 * c + 5] * bfhi(w.z); s += q[8 * c + 6] * bflo(w.w); s += q[8 * c + 7] * bfhi(w.w); }
    return s;
}
__device__ __forceinline__ void naive_band(const bf16_t* qp, const bf16_t* K, const bf16_t* V, size_t kstride, int jlo, int jhi, float m0, float l0, int lane, float& o_out, float& m_out, float& l_out) {
    float q[64]; load_q64(qp, q);
    float m = m0, l = l0, o = 0.f;
    for (int j0 = jlo; j0 <= jhi; j0 += 64) {
        const int j = j0 + lane; const bool valid = j <= jhi; const int jj = valid ? j : jhi;
        float s = dot64(q, K + (size_t)jj * kstride); if (!valid) s = -INFINITY;
        const float mn = fmaxf(m, wave_max(s)); const float alpha = exp2f(m - mn); const float p = exp2f(s - mn);
        l = l * alpha + wave_sum(p); o *= alpha; m = mn;
        const int cnt = (jhi - j0 + 1) < 64 ? (jhi - j0 + 1) : 64;
        for (int t = 0; t < cnt; ++t) { const float pj = __shfl(p, t); o += pj * bf2f(V[(size_t)(j0 + t) * kstride + lane]); }
    }
    o_out = o; m_out = m; l_out = l;
}
__device__ __forceinline__ void naive_attn_A(const Ctx& C) {
    const bf16_t* QKV = WSP(bf16_t, WS_BIG + BIG_QKV); bf16_t* OG = WSP(bf16_t, WS_BIG + BIG_OG); float* LSE = WSP(float, WS_LSE);
    const int gw = C.bid * 8 + C.wave, NGW = C.G * 8;
    for (int it = gw; it < NTOK * 16 * 3; it += NGW) {
        const int gi = it % 3, h = (it / 3) % 16, tok = it / 48;
        const int dil = gi == 0 ? 1 : (gi == 1 ? 4 : 16);
        const int b = tok / SEQ, s = tok % SEQ, r = s % dil, i = s / dil, L = SEQ / dil;
        const int jlo = i - 64 < 0 ? 0 : i - 64, jhi = i + 64 > L - 1 ? L - 1 : i + 64;
        const bf16_t* base = QKV + (size_t)(b * SEQ + r) * NQKV_A + gi * 3072 + h * 64;
        float o, m, l;
        naive_band(QKV + (size_t)tok * NQKV_A + gi * 3072 + h * 64, base + 1024, base + 2048, (size_t)dil * NQKV_A, jlo, jhi, -1e30f, 0.f, C.lane, o, m, l);
        OG[((size_t)gi * NTOK + tok) * DM + h * 64 + C.lane] = (bf16_t)f2bf(o / l);
        if (C.lane == 0) LSE[((size_t)gi * NTOK + tok) * 16 + h] = m + log2f(l);
    }
}
__device__ __forceinline__ void naive_attn_C(const Ctx& C) {
    const bf16_t* QKV = WSP(bf16_t, WS_BIG + BIG_QKV); bf16_t* O = WSP(bf16_t, WS_O); const float* sink = IN_F(24);
    const int gw = C.bid * 8 + C.wave, NGW = C.G * 8;
    for (int it = gw; it < NTOK * 16; it += NGW) {
        const int h = it % 16, tok = it / 16, g = h / 8;
        const int b = tok / SEQ, s = tok % SEQ;
        const int jlo = s - 128 < 0 ? 0 : s - 128, jhi = s + 128 > SEQ - 1 ? SEQ - 1 : s + 128;
        const bf16_t* base = QKV + (size_t)(b * SEQ) * NQKV_C;
        float o, m, l;
        naive_band(QKV + (size_t)tok * NQKV_C + h * 64, base + 1024 + g * 64, base + 1152 + g * 64, (size_t)NQKV_C, jlo, jhi, sink[h] * LOG2E, 1.f, C.lane, o, m, l);
        O[(size_t)tok * DM + h * 64 + C.lane] = (bf16_t)f2bf(o / l);
    }
}
__device__ __forceinline__ float diff_lambda(const Ctx& C) {
    const float a = IN_F(11)[C.lane] * IN_F(12)[C.lane], b = IN_F(13)[C.lane] * IN_F(14)[C.lane];
    return expf(wave_sum(a)) - expf(wave_sum(b)) + LAMBDA_INIT;
}
__device__ __forceinline__ void naive_attn_B(const Ctx& C) {
    const bf16_t* QKV = WSP(bf16_t, WS_BIG + BIG_QKV); bf16_t* O = WSP(bf16_t, WS_O); const float* subln = IN_F(15);
    const float lam = diff_lambda(C);
    const int gw = C.bid * 8 + C.wave, NGW = C.G * 8, lane = C.lane;
    for (int it = gw; it < NTOK * 8; it += NGW) {
        const int h = it % 8, tok = it / 8, b = tok / SEQ;
        float q0[64], q1[64]; load_q64(QKV + (size_t)tok * NQKV_B + (2 * h) * 64, q0); load_q64(QKV + (size_t)tok * NQKV_B + (2 * h + 1) * 64, q1);
        const bf16_t* Kb = QKV + (size_t)(b * SEQ) * NQKV_B + 1024 + (2 * h) * 64; const bf16_t* Vb = QKV + (size_t)(b * SEQ) * NQKV_B + 2048 + h * 128;
        float m0 = -1e30f, l0 = 0.f, m1 = -1e30f, l1 = 0.f, oa0 = 0.f, ob0 = 0.f, oa1 = 0.f, ob1 = 0.f;
        for (int j0 = 0; j0 < SEQ; j0 += 64) {
            const bf16_t* kr = Kb + (size_t)(j0 + lane) * NQKV_B;
            const float s0 = dot64(q0, kr), s1 = dot64(q1, kr + 64);
            const float mn0 = fmaxf(m0, wave_max(s0)), mn1 = fmaxf(m1, wave_max(s1));
            const float a0 = exp2f(m0 - mn0), a1 = exp2f(m1 - mn1), p0 = exp2f(s0 - mn0), p1 = exp2f(s1 - mn1);
            l0 = l0 * a0 + wave_sum(p0); l1 = l1 * a1 + wave_sum(p1); oa0 *= a0; ob0 *= a0; oa1 *= a1; ob1 *= a1; m0 = mn0; m1 = mn1;
#pragma unroll 8
            for (int t = 0; t < 64; ++t) {
                const bf16_t* vr = Vb + (size_t)(j0 + t) * NQKV_B;
                const float va = bf2f(vr[lane]), vb = bf2f(vr[lane + 64]);
                const float pa = __shfl(p0, t), pb = __shfl(p1, t);
                oa0 += pa * va; ob0 += pa * vb; oa1 += pb * va; ob1 += pb * vb;
            }
        }
        const float f0 = 1.0f / l0, f1 = lam / l1;
        const float ya = oa0 * f0 - oa1 * f1, yb = ob0 * f0 - ob1 * f1;
        const float ms = wave_sum(ya * ya + yb * yb) * (1.0f / 128.0f);
        const float rs = (1.0f / sqrtf(ms + SUBLN_EPS)) * (1.0f - LAMBDA_INIT);
        O[(size_t)tok * DM + h * 128 + lane] = (bf16_t)f2bf(ya * rs * subln[lane]);
        O[(size_t)tok * DM + h * 128 + 64 + lane] = (bf16_t)f2bf(yb * rs * subln[lane + 64]);
    }
}

namespace att {
typedef float f32x16 __attribute__((ext_vector_type(16)));
typedef short s16x4 __attribute__((ext_vector_type(4)));
typedef short v4i16_t __attribute__((ext_vector_type(4)));
typedef __bf16 bf16x2_t __attribute__((ext_vector_type(2)));
#define ADI __device__ __forceinline__
#define MFMA32(a, b, c) __builtin_amdgcn_mfma_f32_32x32x16_bf16((a), (b), (c), 0, 0, 0)
ADI int crow(int i, int hh) { return (i & 3) + 8 * (i >> 2) + 4 * hh; }
ADI float hmax(float v) { auto rr = __builtin_amdgcn_permlane32_swap(__float_as_uint(v), __float_as_uint(v), false, false); return fmaxf(__uint_as_float(rr[0]), __uint_as_float(rr[1])); }
ADI float hsum(float v) { auto rr = __builtin_amdgcn_permlane32_swap(__float_as_uint(v), __float_as_uint(v), false, false); return __uint_as_float(rr[0]) + __uint_as_float(rr[1]); }
ADI unsigned cvtpk(float lo, float hi) { f32x2 v = {lo, hi}; bf16x2_t b = __builtin_convertvector(v, bf16x2_t); return __builtin_bit_cast(unsigned, b); }
template <int S> ADI bf16x8 pack8(const f32x16& x) { u32x4 p; p[0] = cvtpk(x[8 * S], x[8 * S + 1]); p[1] = cvtpk(x[8 * S + 2], x[8 * S + 3]); p[2] = cvtpk(x[8 * S + 4], x[8 * S + 5]); p[3] = cvtpk(x[8 * S + 6], x[8 * S + 7]); return __builtin_bit_cast(bf16x8, p); }
ADI s16x4 vtr(const LAS unsigned char* p) { return __builtin_bit_cast(s16x4, __builtin_amdgcn_ds_read_tr16_b64_v4i16((LAS v4i16_t*)p)); }
ADI bf16x8 cat8(s16x4 lo, s16x4 hi) { return (bf16x8){lo[0], lo[1], lo[2], lo[3], hi[0], hi[1], hi[2], hi[3]}; }
ADI float fexp2(float x) { return __builtin_amdgcn_exp2f(x); }
ADI float max3f(float a, float b, float c) { return __builtin_fmaxf(__builtin_fmaxf(a, b), c); }

ADI void qk_tile(f32x16& s0, f32x16& s1, const LAS unsigned char* kt, const bf16x8 (&q)[4], int kro, int kx6) {
    s0 = f32x16{}; s1 = f32x16{};
#pragma unroll
    for (int d0 = 0; d0 < 4; ++d0) {
        const int ko = kro + (kx6 ^ (d0 << 5));
        const bf16x8 a0 = *(const LAS bf16x8*)(kt + ko); const bf16x8 a1 = *(const LAS bf16x8*)(kt + 4096 + ko);
        s0 = MFMA32(a0, q[d0], s0); s1 = MFMA32(a1, q[d0], s1);
    }
}
ADI void qk_tile_init(f32x16& s0, f32x16& s1, const f32x16& init, const LAS unsigned char* kt, const bf16x8 (&q)[4], int kro, int kx6) {
    s0 = init; s1 = init;
#pragma unroll
    for (int d0 = 0; d0 < 4; ++d0) {
        const int ko = kro + (kx6 ^ (d0 << 5));
        const bf16x8 a0 = *(const LAS bf16x8*)(kt + ko); const bf16x8 a1 = *(const LAS bf16x8*)(kt + 4096 + ko);
        s0 = MFMA32(a0, q[d0], s0); s1 = MFMA32(a1, q[d0], s1);
    }
}
ADI void qk_tile_lq(f32x16& s0, f32x16& s1, const LAS unsigned char* kt, const LAS unsigned char* qf, int kro, int kx6) {
    s0 = f32x16{}; s1 = f32x16{};
#pragma unroll
    for (int d0 = 0; d0 < 4; ++d0) {
        const int ko = kro + (kx6 ^ (d0 << 5));
        const bf16x8 a0 = *(const LAS bf16x8*)(kt + ko); const bf16x8 a1 = *(const LAS bf16x8*)(kt + 4096 + ko);
        const bf16x8 qd = *(const LAS bf16x8*)(qf + d0 * 1024);
        s0 = MFMA32(a0, qd, s0); s1 = MFMA32(a1, qd, s1);
    }
}
template <int NB>
ADI void softmax_tile(f32x16& s0, f32x16& s1, float& m, float& l, f32x16 (&O)[NB], LAS float* scr, int r, int hh) {
    float mxa = max3f(s0[0], s0[1], s1[0]), mxb = max3f(s0[2], s0[3], s1[1]); mxa = max3f(mxa, s1[2], s1[3]);
#pragma unroll
    for (int i = 4; i < 16; i += 4) { mxa = max3f(mxa, s0[i], s0[i + 1]); mxb = max3f(mxb, s0[i + 2], s0[i + 3]); mxa = max3f(mxa, s1[i], s1[i + 1]); mxb = max3f(mxb, s1[i + 2], s1[i + 3]); }
    float mx = hmax(max3f(mxa, mxb, mxb));
    if (__any(mx > m + 8.0f)) {
        const float mn = fmaxf(m, mx), al = fexp2(m - mn); l *= al; m = mn;
        if (hh == 0) scr[r] = al;
#pragma unroll
        for (int g = 0; g < 4; ++g) { const f32x4 a4 = *(const LAS f32x4*)(scr + 8 * g + 4 * hh);
#pragma unroll
            for (int c = 0; c < NB; ++c) { O[c][4 * g] *= a4[0]; O[c][4 * g + 1] *= a4[1]; O[c][4 * g + 2] *= a4[2]; O[c][4 * g + 3] *= a4[3]; } }
    }
    float sa = 0.f, sb = 0.f, sc = 0.f, sd = 0.f;
#pragma unroll
    for (int i = 0; i < 16; i += 2) { s0[i] = fexp2(s0[i] - m); s1[i] = fexp2(s1[i] - m); s0[i + 1] = fexp2(s0[i + 1] - m); s1[i + 1] = fexp2(s1[i + 1] - m); sa += s0[i]; sb += s1[i]; sc += s0[i + 1]; sd += s1[i + 1]; }
    l += (sa + sb) + (sc + sd);
}

template <int NB>
ADI void softmax_max(const f32x16& s0, const f32x16& s1, float& m, float& l, f32x16 (&O)[NB], LAS float* scr, int r, int hh) {
    float mxa = max3f(s0[0], s0[1], s1[0]), mxb = max3f(s0[2], s0[3], s1[1]); mxa = max3f(mxa, s1[2], s1[3]);
#pragma unroll
    for (int i = 4; i < 16; i += 4) { mxa = max3f(mxa, s0[i], s0[i + 1]); mxb = max3f(mxb, s0[i + 2], s0[i + 3]); mxa = max3f(mxa, s1[i], s1[i + 1]); mxb = max3f(mxb, s1[i + 2], s1[i + 3]); }
    const float mx = hmax(max3f(mxa, mxb, mxb));
    if (__any(mx > m + 8.0f)) {
        const float mn = fmaxf(m, mx), al = fexp2(m - mn); l *= al; m = mn;
        if (hh == 0) scr[r] = al;
#pragma unroll
        for (int g = 0; g < 4; ++g) { const f32x4 a4 = *(const LAS f32x4*)(scr + 8 * g + 4 * hh);
#pragma unroll
            for (int c = 0; c < NB; ++c) { O[c][4 * g] *= a4[0]; O[c][4 * g + 1] *= a4[1]; O[c][4 * g + 2] *= a4[2]; O[c][4 * g + 3] *= a4[3]; } }
    }
}
template <int S> ADI bf16x8 exp_pack8(f32x16& x, float m, float& sa, float& sb) {
#pragma unroll
    for (int i = 0; i < 8; i += 2) { x[8 * S + i] = fexp2(x[8 * S + i] - m); x[8 * S + i + 1] = fexp2(x[8 * S + i + 1] - m); sa += x[8 * S + i]; sb += x[8 * S + i + 1]; }
    return pack8<S>(x);
}
ADI void glds16(const void* gsrc, unsigned lds_dst) { unsigned keep;
    asm volatile("s_mov_b32 %0, m0\n\ts_mov_b32 m0, %2\n\ts_nop 0\n\tglobal_load_lds_dwordx4 %1, off\n\ts_mov_b32 m0, %0" : "=&s"(keep) : "v"(gsrc), "s"(lds_dst) : "memory"); }
#define ATT_GLDS(gp, lp) glds16((gp), (unsigned)__builtin_amdgcn_readfirstlane((int)(lp)))
typedef int v8i_a __attribute__((ext_vector_type(8)));
typedef int v4i_a __attribute__((ext_vector_type(4)));
typedef int v2i_a __attribute__((ext_vector_type(2)));
ADI void diff_unit(LAS unsigned char* lds, const unsigned char* QKV8, bf16_t* Oout, const float* subln, float lam, int b, int h, int qb, int tid, int lane, int wave) {
    const int r = lane & 31, hh = lane >> 5, comp = wave & 1, qt = wave >> 1;
    const size_t rowbase = (size_t)b * SEQ;
    v8i_a q8;
    {
        const unsigned char* qrow = QKV8 + (rowbase + qb * 128 + qt * 32 + r) * NQKV_B + (2 * h + comp) * 64 + 32 * hh;
        const v4i_a qa = *(const v4i_a*)qrow, qb_ = *(const v4i_a*)(qrow + 16);
        q8 = __builtin_shufflevector(qa, qb_, 0, 1, 2, 3, 4, 5, 6, 7);
    }
    const bool isV = wave >= 4; const int w4 = wave & 3;
    const int srow = 16 * w4 + (lane >> 2);
    const int vkey = 16 * w4 + (lane >> 3), vf0 = (vkey >> 1) & 1;
    const unsigned char* src0 = isV ? QKV8 + (rowbase + vkey) * NQKV_B + 2048 + h * 128 + ((((lane >> 1) & 3) ^ vf0) << 5) + ((lane & 1) << 4)
                                    : QKV8 + (rowbase + srow) * NQKV_B + 1024 + (2 * h) * 64 + (((lane & 3) ^ ((srow >> 2) & 3)) << 4);
    const unsigned char* src1 = isV ? QKV8 + (rowbase + vkey + 8) * NQKV_B + 2048 + h * 128 + ((((lane >> 1) & 3) ^ (vf0 | 2)) << 5) + ((lane & 1) << 4)
                                    : src0 + 64;
    const unsigned lb = (unsigned)(uintptr_t)lds;
    const unsigned dk0 = lb + (isV ? 8192 + (2 * w4) * 1024 : w4 * 1024), dk1 = lb + (isV ? 8192 + (2 * w4 + 1) * 1024 : 4096 + w4 * 1024);
#define DIFF_DMA(tt) do { const unsigned so_ = ((tt) & 3) * 16384; const size_t go_ = (size_t)(tt) * 64 * NQKV_B; \
        ATT_GLDS(src0 + go_, dk0 + so_); ATT_GLDS(src1 + go_, dk1 + so_); } while (0)
    const int kx = (r >> 2) & 3;
    const int kro0 = comp * 4096 + r * 64 + (((2 * hh) ^ kx) << 4), kro1 = comp * 4096 + r * 64 + (((2 * hh + 1) ^ kx) << 4);
    const int ts_ = lane & 15, tblk = (lane >> 4) & 1;
    const int te = ts_ >> 1, tcol = ts_ & 1;
    const int tkey = (te & 3) + 8 * (te >> 2) + 4 * hh;
    const int tfx = (te >> 1) & 3;
    const int vro = 8192 + tkey * 128 + 16 * tblk + 8 * tcol;
    LAS float* scr = (LAS float*)(lds + 132096 + wave * 256);
    f32x16 O[4];
#pragma unroll
    for (int c = 0; c < 4; ++c) O[c] = f32x16{};
    float m4 = 0.f, l = 0.f;
    f32x16 negm = f32x16{};
    constexpr int NT = SEQ / 64;
    DIFF_DMA(0); DIFF_DMA(1);
    asm volatile("s_waitcnt vmcnt(2)\n\ts_barrier" ::: "memory");
    if (wave >= 4) __builtin_amdgcn_s_setprio(1);
    for (int t = 0; t < NT; ++t) {
        if (t + 2 < NT) DIFF_DMA(t + 2);
        const LAS unsigned char* st = lds + (t & 3) * 16384;
        f32x16 s0, s1;
        {
            const v4i_a a0 = *(const LAS v4i_a*)(st + kro0), a1 = *(const LAS v4i_a*)(st + kro1), b0 = *(const LAS v4i_a*)(st + 2048 + kro0), b1 = *(const LAS v4i_a*)(st + 2048 + kro1);
            const v8i_a k0 = __builtin_shufflevector(a0, a1, 0, 1, 2, 3, 4, 5, 6, 7), k1 = __builtin_shufflevector(b0, b1, 0, 1, 2, 3, 4, 5, 6, 7);
            asm volatile("s_nop 3\n\tv_mfma_f32_32x32x64_f8f6f4 %0, %2, %4, %5\n\tv_mfma_f32_32x32x64_f8f6f4 %1, %3, %4, %5\n\ts_nop 15\n\ts_nop 7"
                         : "=&v"(s0), "=&v"(s1) : "v"(k0), "v"(k1), "v"(q8), "v"(negm));
        }
        {
            float mxa = max3f(s0[0], s0[1], s1[0]), mxb = max3f(s0[2], s0[3], s1[1]); mxa = max3f(mxa, s1[2], s1[3]);
#pragma unroll
            for (int i = 4; i < 16; i += 4) { mxa = max3f(mxa, s0[i], s0[i + 1]); mxb = max3f(mxb, s0[i + 2], s0[i + 3]); mxa = max3f(mxa, s1[i], s1[i + 1]); mxb = max3f(mxb, s1[i + 2], s1[i + 3]); }
            const float mx = hmax(max3f(mxa, mxb, mxb));
            if (t == 0 || __any(mx > 8.0f)) {
                const float dl = (t == 0) ? (mx - 4.0f) : fmaxf(mx - 4.0f, 0.f);
                const float al = (t == 0) ? 0.f : fexp2(-dl); l *= al; m4 += dl;
#pragma unroll
                for (int i = 0; i < 16; ++i) { s0[i] -= dl; s1[i] -= dl; negm[i] = -m4; }
                if (hh == 0) scr[r] = al;
#pragma unroll
                for (int g = 0; g < 4; ++g) { const f32x4 a4 = *(const LAS f32x4*)(scr + 8 * g + 4 * hh);
#pragma unroll
                    for (int c = 0; c < 4; ++c) { O[c][4 * g] *= a4[0]; O[c][4 * g + 1] *= a4[1]; O[c][4 * g + 2] *= a4[2]; O[c][4 * g + 3] *= a4[3]; } }
            }
        }
        float sa = 0.f, sb = 0.f, sc = 0.f, sd = 0.f;
#pragma unroll
        for (int i = 0; i < 16; i += 2) { s0[i] = fexp2(s0[i]); s1[i] = fexp2(s1[i]); s0[i + 1] = fexp2(s0[i + 1]); s1[i + 1] = fexp2(s1[i + 1]); sa += s0[i]; sb += s1[i]; sc += s0[i + 1]; sd += s1[i + 1]; }
        l += ((sa + sb) + (sc + sd)) * 0.0625f;
        v8i_a P8;
#pragma unroll
        for (int g = 0; g < 4; ++g) { P8[g] = (int)pk_fp8x4_nc(s0[4 * g], s0[4 * g + 1], s0[4 * g + 2], s0[4 * g + 3]); P8[4 + g] = (int)pk_fp8x4_nc(s1[4 * g], s1[4 * g + 1], s1[4 * g + 2], s1[4 * g + 3]); }
#pragma unroll
        for (int c = 0; c < 4; ++c) {
            const LAS unsigned char* vp = st + vro + ((c ^ tfx) << 5);
            const v2i_a t0 = __builtin_amdgcn_ds_read_tr8_b64_v2i32((LAS v2i_a*)(vp)), t1 = __builtin_amdgcn_ds_read_tr8_b64_v2i32((LAS v2i_a*)(vp + 16 * 128));
            const v2i_a t2 = __builtin_amdgcn_ds_read_tr8_b64_v2i32((LAS v2i_a*)(vp + 32 * 128)), t3 = __builtin_amdgcn_ds_read_tr8_b64_v2i32((LAS v2i_a*)(vp + 48 * 128));
            const v8i_a V8 = (v8i_a){t0[0], t0[1], t1[0], t1[1], t2[0], t2[1], t3[0], t3[1]};
            asm volatile("s_nop 3\n\tv_mfma_f32_32x32x64_f8f6f4 %0, %1, %2, %0" : "+v"(O[c]) : "v"(P8), "v"(V8));
        }
        if (t + 2 < NT) asm volatile("s_waitcnt vmcnt(2) lgkmcnt(0)\n\ts_barrier" ::: "memory"); else asm volatile("s_waitcnt vmcnt(0) lgkmcnt(0)\n\ts_barrier" ::: "memory");
    }
#undef DIFF_DMA
    __builtin_amdgcn_s_setprio(0);
    asm volatile("s_nop 15\n\ts_nop 15" ::: "memory");
    l = hsum(l);
    if (hh == 0) scr[r] = (comp == 0 ? 0.0625f : 0.0625f * lam) / l;
    LAS float* xch = (LAS float*)(lds + qt * 16384) + lane;
#pragma unroll
    for (int g = 0; g < 4; ++g) { const f32x4 a4 = *(const LAS f32x4*)(scr + 8 * g + 4 * hh);
#pragma unroll
        for (int c = 0; c < 4; ++c) { O[c][4 * g] *= a4[0]; O[c][4 * g + 1] *= a4[1]; O[c][4 * g + 2] *= a4[2]; O[c][4 * g + 3] *= a4[3]; } }
    if (comp == 1) {
#pragma unroll
        for (int c = 0; c < 4; ++c)
#pragma unroll
            for (int i = 0; i < 16; ++i) xch[(c * 16 + i) * 64] = O[c][i];
    }
    __syncthreads();
    if (comp == 0) {
        float sg[4];
#pragma unroll
        for (int c = 0; c < 4; ++c) sg[c] = subln[32 * c + r] * (1.0f - LAMBDA_INIT);
#pragma unroll
        for (int i = 0; i < 16; ++i) {
            float y[4]; float ss = 0.f;
#pragma unroll
            for (int c = 0; c < 4; ++c) { y[c] = O[c][i] - xch[(c * 16 + i) * 64]; ss += y[c] * y[c]; }
            ss += __shfl_xor(ss, 1); ss += __shfl_xor(ss, 2); ss += __shfl_xor(ss, 4); ss += __shfl_xor(ss, 8); ss += __shfl_xor(ss, 16);
            const float rs = 1.0f / sqrtf(ss * (1.0f / 128.0f) + SUBLN_EPS);
            bf16_t* op = Oout + (rowbase + qb * 128 + qt * 32 + crow(i, hh)) * DM + h * 128 + r;
#pragma unroll
            for (int c = 0; c < 4; ++c) op[32 * c] = (bf16_t)f2bf(y[c] * rs * sg[c]);
        }
    }
    __syncthreads();
}

struct BandW { const bf16_t* qrow; int qi0, tlo, thi; float m0, l0; bf16_t* out; size_t ostride; float* lse; size_t lstride; };
template <bool LSE_OUT>
ADI void band_unit(LAS unsigned char* lds, const bf16_t* Kb, const bf16_t* Vb, size_t kstride, int L, int jstart, int ntiles, int halfw, const BandW& W, int tid, int lane, int wave) {
    const int r = lane & 31, hh = lane >> 5;
    bf16x8 q[4];
#pragma unroll
    for (int d0 = 0; d0 < 4; ++d0) q[d0] = *(const bf16x8*)(W.qrow + 16 * d0 + 8 * hh);
    const int srow = tid >> 3, sch = tid & 7;
    const int kdst = srow * 128 + ((sch ^ ((srow >> 1) & 7)) << 4);
    const int vdst = 8192 + srow * 128 + ((sch ^ (((srow >> 1) & 1) << 2)) << 4);
    const int xs = (r >> 1) & 7;
    const int kro = r * 128 + ((hh ^ (xs & 1)) << 4), kx6 = (xs & 6) << 4;
    const int blk = (lane >> 4) & 1, qq = (lane & 15) >> 2, pp = lane & 3;
    const int vro = 8192 + (4 * hh + qq) * 128 + ((2 * blk + (pp >> 1)) << 4) + 8 * (pp & 1), vq6 = ((qq >> 1) & 1) << 6;
    LAS float* scr = (LAS float*)(lds + 132096 + wave * 256);
    f32x16 O[2]; O[0] = f32x16{}; O[1] = f32x16{};
    float m = W.m0, l = W.l0;
    const int qi = W.qi0 + r;
    {
        int j = jstart + srow; j = j < 0 ? 0 : (j > L - 1 ? L - 1 : j);
        const u32x4 ka = *(const u32x4*)(Kb + (size_t)j * kstride + sch * 8), va = *(const u32x4*)(Vb + (size_t)j * kstride + sch * 8);
        *(LAS u32x4*)(lds + kdst) = ka; *(LAS u32x4*)(lds + vdst) = va;
    }
    __syncthreads();
    for (int t = 0; t < ntiles; ++t) {
        const LAS unsigned char* st = lds + (t & 1) * 16384;
        const bool active = (t >= W.tlo) && (t <= W.thi);
        bf16x8 P[4];
        if (active) {
            f32x16 s0, s1;
            qk_tile(s0, s1, st, q, kro, kx6);
            const int jb = jstart + 64 * t + 4 * hh;
#pragma unroll
            for (int i = 0; i < 16; ++i) {
                const int j0 = jb + (i & 3) + 8 * (i >> 2), j1 = j0 + 32;
                if (!(((unsigned)j0 < (unsigned)L) && ((unsigned)(j0 - qi + halfw) <= (unsigned)(2 * halfw)))) s0[i] = -INFINITY;
                if (!(((unsigned)j1 < (unsigned)L) && ((unsigned)(j1 - qi + halfw) <= (unsigned)(2 * halfw)))) s1[i] = -INFINITY;
            }
            softmax_tile<2>(s0, s1, m, l, O, scr, r, hh);
            P[0] = pack8<0>(s0); P[1] = pack8<1>(s0); P[2] = pack8<0>(s1); P[3] = pack8<1>(s1);
        }
        int j = jstart + 64 * ((t + 1 < ntiles) ? t + 1 : t) + srow; j = j < 0 ? 0 : (j > L - 1 ? L - 1 : j);
        const u32x4 ka = *(const u32x4*)(Kb + (size_t)j * kstride + sch * 8), va = *(const u32x4*)(Vb + (size_t)j * kstride + sch * 8);
        if (active) {
#pragma unroll
            for (int c = 0; c < 2; ++c)
#pragma unroll
                for (int kc = 0; kc < 4; ++kc) {
                    const LAS unsigned char* vp = st + vro + (vq6 ^ (c << 6)) + kc * 2048;
                    const bf16x8 vf = cat8(vtr(vp), vtr(vp + 1024));
                    O[c] = MFMA32(P[kc], vf, O[c]);
                }
        }
        LAS unsigned char* sn = lds + ((t + 1) & 1) * 16384;
        *(LAS u32x4*)(sn + kdst) = ka; *(LAS u32x4*)(sn + vdst) = va;
        __syncthreads();
    }
    l = hsum(l);
    if (hh == 0) scr[r] = 1.0f / l;
    if (LSE_OUT) { if (hh == 0) W.lse[(size_t)(W.qi0 + r) * W.lstride] = m + log2f(l); }
#pragma unroll
    for (int g = 0; g < 4; ++g) { const f32x4 a4 = *(const LAS f32x4*)(scr + 8 * g + 4 * hh);
#pragma unroll
        for (int k = 0; k < 4; ++k) { bf16_t* op = W.out + (size_t)(W.qi0 + 8 * g + 4 * hh + k) * W.ostride + r;
            op[0] = (bf16_t)f2bf(O[0][4 * g + k] * a4[k]); op[32] = (bf16_t)f2bf(O[1][4 * g + k] * a4[k]); } }
}

struct BandDesc { const bf16_t* Kb; const bf16_t* Vb; size_t kstride; int L, jstart; const bf16_t* qrow; int qi0, tlo, thi; float m0, l0; bf16_t* out; size_t ostride; float* lse; size_t lstride; };
template <int NTL, int HALFW, bool LSE_OUT, class F>
ADI void band_stream(LAS unsigned char* lds, int nunits, const F& get, int tid, int lane, int wave) {
    const int r = lane & 31, hh = lane >> 5;
    const unsigned lbase = (unsigned)(uintptr_t)lds;
    const int srow = 8 * wave + (lane >> 3), kchs = ((lane & 7) ^ ((srow >> 1) & 7)) * 8, vchs = ((lane & 7) ^ (((srow >> 1) & 1) << 2)) * 8;
    const int xs = (r >> 1) & 7;
    const int kro = r * 128 + ((hh ^ (xs & 1)) << 4), kx6 = (xs & 6) << 4;
    const int blk = (lane >> 4) & 1, qq = (lane & 15) >> 2, pp = lane & 3;
    const int vro = 8192 + (4 * hh + qq) * 128 + ((2 * blk + (pp >> 1)) << 4) + 8 * (pp & 1), vq6 = ((qq >> 1) & 1) << 6;
    LAS float* scr = (LAS float*)(lds + 132096 + wave * 256);
    const int total = nunits * NTL;
#define BAND_TILE_DMA(sp) do { const int sp_ = (sp) < total ? (sp) : total - 1; const int k_ = sp_ / NTL, t_ = sp_ % NTL; const BandDesc D_ = get(k_); \
        int j_ = D_.jstart + 64 * t_ + srow; j_ = j_ < 0 ? 0 : (j_ > D_.L - 1 ? D_.L - 1 : j_); const unsigned st_ = lbase + ((sp) & 3) * 16384 + wave * 1024; \
        ATT_GLDS(D_.Kb + (size_t)j_ * D_.kstride + kchs, st_); ATT_GLDS(D_.Vb + (size_t)j_ * D_.kstride + vchs, st_ + 8192); } while (0)
#define BAND_Q_DMA(ku, d0) do { const int ku_ = (ku) < nunits ? (ku) : nunits - 1; const BandDesc D_ = get(ku_); \
        ATT_GLDS(D_.qrow + 16 * (d0) + 8 * hh, lbase + 65536 + ((ku) & 1) * 32768 + wave * 4096 + (d0) * 1024); } while (0)
    BAND_Q_DMA(0, 0); BAND_Q_DMA(0, 1); BAND_Q_DMA(0, 2); BAND_Q_DMA(0, 3);
    BAND_TILE_DMA(0); BAND_TILE_DMA(1);
    asm volatile("s_waitcnt vmcnt(2)\n\ts_barrier" ::: "memory");
    bf16x8 q[4]; f32x16 O[2]; float m = 0.f, l = 0.f;
    O[0] = f32x16{}; O[1] = f32x16{};
#pragma unroll
    for (int d0 = 0; d0 < 4; ++d0) q[d0] = bf16x8{};
    int k = 0, t = 0;
    for (int s = 0; s < total; ++s) {
        BAND_TILE_DMA(s + 2); BAND_Q_DMA(k + 1, (t < 4 ? t : 3));
        const BandDesc D = get(k);
        if (t == 0) {
            const LAS unsigned char* qs = lds + 65536 + (k & 1) * 32768 + wave * 4096 + lane * 16;
#pragma unroll
            for (int d0 = 0; d0 < 4; ++d0) q[d0] = *(const LAS bf16x8*)(qs + d0 * 1024);
            O[0] = f32x16{}; O[1] = f32x16{}; m = D.m0; l = D.l0;
        }
        const LAS unsigned char* st = lds + (s & 3) * 16384;
        if (t >= D.tlo && t <= D.thi) {
            f32x16 s0, s1;
            qk_tile(s0, s1, st, q, kro, kx6);
            const int ts = D.jstart + 64 * t;
            if (!(ts >= D.qi0 + 31 - HALFW && ts + 63 <= D.qi0 + HALFW && ts >= 0 && ts + 63 < D.L)) {
                const int jb = ts + 4 * hh, qi = D.qi0 + r;
#pragma unroll
                for (int i = 0; i < 16; ++i) {
                    const int j0 = jb + (i & 3) + 8 * (i >> 2), j1 = j0 + 32;
                    if (!(((unsigned)j0 < (unsigned)D.L) && ((unsigned)(j0 - qi + HALFW) <= (unsigned)(2 * HALFW)))) s0[i] = -INFINITY;
                    if (!(((unsigned)j1 < (unsigned)D.L) && ((unsigned)(j1 - qi + HALFW) <= (unsigned)(2 * HALFW)))) s1[i] = -INFINITY;
                }
            }
            softmax_tile<2>(s0, s1, m, l, O, scr, r, hh);
            bf16x8 P[4]; P[0] = pack8<0>(s0); P[1] = pack8<1>(s0); P[2] = pack8<0>(s1); P[3] = pack8<1>(s1);
#pragma unroll
            for (int c = 0; c < 2; ++c)
#pragma unroll
                for (int kc = 0; kc < 4; ++kc) {
                    const LAS unsigned char* vp = st + vro + (vq6 ^ (c << 6)) + kc * 2048;
                    const bf16x8 vf = cat8(vtr(vp), vtr(vp + 1024));
                    O[c] = MFMA32(P[kc], vf, O[c]);
                }
        }
        if (t == NTL - 1 && D.tlo <= D.thi) {
            const float lt = hsum(l);
            if (hh == 0) scr[r] = 1.0f / lt;
            if (LSE_OUT) { if (hh == 0) D.lse[(size_t)(D.qi0 + r) * D.lstride] = m + log2f(lt); }
#pragma unroll
            for (int g = 0; g < 4; ++g) { const f32x4 a4 = *(const LAS f32x4*)(scr + 8 * g + 4 * hh);
#pragma unroll
                for (int kk = 0; kk < 4; ++kk) { bf16_t* op = D.out + (size_t)(D.qi0 + 8 * g + 4 * hh + kk) * D.ostride + r;
                    op[0] = (bf16_t)f2bf(O[0][4 * g + kk] * a4[kk]); op[32] = (bf16_t)f2bf(O[1][4 * g + kk] * a4[kk]); } }
        }
        asm volatile("s_waitcnt vmcnt(3) lgkmcnt(0)\n\ts_barrier" ::: "memory");
        if (++t == NTL) { t = 0; ++k; }
    }
    asm volatile("s_waitcnt vmcnt(0)\n\ts_barrier" ::: "memory");
#undef BAND_TILE_DMA
#undef BAND_Q_DMA
}

template <int NB>
ADI void softmax_tile8(f32x16& s0, f32x16& s1, float& m, float& l, f32x16 (&O)[NB], LAS float* scr, int r, int hh) {
    float mxa = max3f(s0[0], s0[1], s1[0]), mxb = max3f(s0[2], s0[3], s1[1]); mxa = max3f(mxa, s1[2], s1[3]);
#pragma unroll
    for (int i = 4; i < 16; i += 4) { mxa = max3f(mxa, s0[i], s0[i + 1]); mxb = max3f(mxb, s0[i + 2], s0[i + 3]); mxa = max3f(mxa, s1[i], s1[i + 1]); mxb = max3f(mxb, s1[i + 2], s1[i + 3]); }
    float mx = hmax(max3f(mxa, mxb, mxb));
    if (__any(mx > m + 4.0f)) {
        const float mn = fmaxf(m, mx), al = fexp2(m - mn); l *= al; m = mn;
        if (hh == 0) scr[r] = al;
#pragma unroll
        for (int g = 0; g < 4; ++g) { const f32x4 a4 = *(const LAS f32x4*)(scr + 8 * g + 4 * hh);
#pragma unroll
            for (int c = 0; c < NB; ++c) { O[c][4 * g] *= a4[0]; O[c][4 * g + 1] *= a4[1]; O[c][4 * g + 2] *= a4[2]; O[c][4 * g + 3] *= a4[3]; } }
    }
    const float m4 = m - 4.0f;
    float sa = 0.f, sb = 0.f, sc = 0.f, sd = 0.f;
#pragma unroll
    for (int i = 0; i < 16; i += 2) { s0[i] = fexp2(s0[i] - m4); s1[i] = fexp2(s1[i] - m4); s0[i + 1] = fexp2(s0[i + 1] - m4); s1[i + 1] = fexp2(s1[i + 1] - m4); sa += s0[i]; sb += s1[i]; sc += s0[i + 1]; sd += s1[i + 1]; }
    l += ((sa + sb) + (sc + sd)) * 0.0625f;
}

struct BandDesc8 { const unsigned char* Kb; const unsigned char* Vb; size_t kstride; int L, jstart; const unsigned char* qrow; int qi0, tlo, thi; float m0, l0; bf16_t* out; size_t ostride; float* lse; size_t lstride; };
template <int NTL, int HALFW, class F>
ADI void band_stream8(LAS unsigned char* lds, int nunits, const F& get, int tid, int lane, int wave) {
    static_assert(2 * NTL * 8192 + 32768 <= 132096, "LDS");
    const int r = lane & 31, hh = lane >> 5;
    const unsigned lbase = (unsigned)(uintptr_t)lds;
    const bool isV = wave >= 4;
    const int srow = 16 * (wave & 3) + (lane >> 2);
    const int soff = isV ? (((((lane >> 1) & 1) ^ ((srow >> 3) & 1)) << 5) + ((lane & 1) << 4)) : (((lane & 3) ^ ((srow >> 2) & 3)) << 4);
    const int kx = (r >> 2) & 3;
    const int kro0 = r * 64 + (((2 * hh) ^ kx) << 4), kro1 = r * 64 + (((2 * hh + 1) ^ kx) << 4);
    const int ts_ = lane & 15, tblk = (lane >> 4) & 1, te = ts_ >> 1, tcol = ts_ & 1;
    const int tkey = (te & 3) + 8 * (te >> 2) + 4 * hh, tfx = (te >> 2) & 1;
    const int vro = 4096 + tkey * 64 + 16 * tblk + 8 * tcol;
    LAS float* scr = (LAS float*)(lds + 132096 + wave * 256);
#define B8_UNIT_DMA(ku) do { if ((ku) < nunits) { const BandDesc8 D_ = get(ku); \
        _Pragma("unroll") for (int ti_ = 0; ti_ < NTL; ++ti_) { int j_ = D_.jstart + 64 * ti_ + srow; j_ = j_ < 0 ? 0 : (j_ > D_.L - 1 ? D_.L - 1 : j_); \
            ATT_GLDS((isV ? D_.Vb : D_.Kb) + (size_t)j_ * D_.kstride + soff, lbase + ((ku) & 1) * (NTL * 8192) + ti_ * 8192 + wave * 1024); } \
        ATT_GLDS(D_.qrow + 32 * hh, lbase + 2 * NTL * 8192 + ((ku) & 1) * 16384 + wave * 2048); \
        ATT_GLDS(D_.qrow + 32 * hh + 16, lbase + 2 * NTL * 8192 + ((ku) & 1) * 16384 + wave * 2048 + 1024); } } while (0)
    B8_UNIT_DMA(0);
    asm volatile("s_waitcnt vmcnt(0)\n\ts_barrier" ::: "memory");
    for (int k = 0; k < nunits; ++k) {
        B8_UNIT_DMA(k + 1);
        const BandDesc8 D = get(k);
        const int tlo = __builtin_amdgcn_readfirstlane(D.tlo), thi = __builtin_amdgcn_readfirstlane(D.thi);
        if (tlo <= thi) {
            v8i_a q8; f32x16 O[2]; float m = D.m0, l = D.l0;
            {
                const LAS unsigned char* qs = lds + 2 * NTL * 8192 + (k & 1) * 16384 + wave * 2048 + lane * 16;
                const v4i_a qa = *(const LAS v4i_a*)qs, qb = *(const LAS v4i_a*)(qs + 1024);
                q8 = __builtin_shufflevector(qa, qb, 0, 1, 2, 3, 4, 5, 6, 7);
            }
            O[0] = f32x16{}; O[1] = f32x16{};
#pragma unroll 1
            for (int t = tlo; t <= thi; ++t) {
                const LAS unsigned char* st = lds + (k & 1) * (NTL * 8192) + t * 8192;
                f32x16 s0, s1;
                {
                    const v4i_a a0 = *(const LAS v4i_a*)(st + kro0), a1 = *(const LAS v4i_a*)(st + kro1), b0 = *(const LAS v4i_a*)(st + 2048 + kro0), b1 = *(const LAS v4i_a*)(st + 2048 + kro1);
                    const v8i_a k0 = __builtin_shufflevector(a0, a1, 0, 1, 2, 3, 4, 5, 6, 7), k1 = __builtin_shufflevector(b0, b1, 0, 1, 2, 3, 4, 5, 6, 7);
                    asm volatile("v_mfma_f32_32x32x64_f8f6f4 %0, %2, %4, 0\n\tv_mfma_f32_32x32x64_f8f6f4 %1, %3, %4, 0\n\ts_nop 15\n\ts_nop 7"
                                 : "=&v"(s0), "=&v"(s1) : "v"(k0), "v"(k1), "v"(q8));
                }
                const int ts = D.jstart + 64 * t;
                if (!(ts >= D.qi0 + 31 - HALFW && ts + 63 <= D.qi0 + HALFW && ts >= 0 && ts + 63 < D.L)) {
                    const int jb = ts + 4 * hh, qi = D.qi0 + r;
#pragma unroll
                    for (int i = 0; i < 16; ++i) {
                        const int j0 = jb + (i & 3) + 8 * (i >> 2), j1 = j0 + 32;
                        if (!(((unsigned)j0 < (unsigned)D.L) && ((unsigned)(j0 - qi + HALFW) <= (unsigned)(2 * HALFW)))) s0[i] = -INFINITY;
                        if (!(((unsigned)j1 < (unsigned)D.L) && ((unsigned)(j1 - qi + HALFW) <= (unsigned)(2 * HALFW)))) s1[i] = -INFINITY;
                    }
                }
                softmax_tile8<2>(s0, s1, m, l, O, scr, r, hh);
                v8i_a P8;
#pragma unroll
                for (int g = 0; g < 4; ++g) { P8[g] = (int)pk_fp8x4_nc(s0[4 * g], s0[4 * g + 1], s0[4 * g + 2], s0[4 * g + 3]); P8[4 + g] = (int)pk_fp8x4_nc(s1[4 * g], s1[4 * g + 1], s1[4 * g + 2], s1[4 * g + 3]); }
#pragma unroll
                for (int c = 0; c < 2; ++c) {
                    const LAS unsigned char* vp = st + vro + ((c ^ tfx) << 5);
                    const v2i_a t0 = __builtin_amdgcn_ds_read_tr8_b64_v2i32((LAS v2i_a*)(vp)), t1 = __builtin_amdgcn_ds_read_tr8_b64_v2i32((LAS v2i_a*)(vp + 16 * 64));
                    const v2i_a t2 = __builtin_amdgcn_ds_read_tr8_b64_v2i32((LAS v2i_a*)(vp + 32 * 64)), t3 = __builtin_amdgcn_ds_read_tr8_b64_v2i32((LAS v2i_a*)(vp + 48 * 64));
                    const v8i_a V8 = (v8i_a){t0[0], t0[1], t1[0], t1[1], t2[0], t2[1], t3[0], t3[1]};
                    asm volatile("s_nop 3\n\tv_mfma_f32_32x32x64_f8f6f4 %0, %1, %2, %0" : "+v"(O[c]) : "v"(P8), "v"(V8));
                }
            }
            asm volatile("s_nop 15\n\ts_nop 15" ::: "memory");
            const float lt = hsum(l);
            if (hh == 0) scr[r] = 0.0625f / lt;
            asm volatile("s_waitcnt vmcnt(0)" ::: "memory");
            if (hh == 0 && D.lse != nullptr) D.lse[(size_t)(D.qi0 + r) * D.lstride] = m + log2f(lt);
#pragma unroll
            for (int g = 0; g < 4; ++g) { const f32x4 a4 = *(const LAS f32x4*)(scr + 8 * g + 4 * hh);
#pragma unroll
                for (int kk = 0; kk < 4; ++kk) { bf16_t* op = D.out + (size_t)(D.qi0 + 8 * g + 4 * hh + kk) * D.ostride + r;
                    op[0] = (bf16_t)f2bf(O[0][4 * g + kk] * a4[kk]); op[32] = (bf16_t)f2bf(O[1][4 * g + kk] * a4[kk]); } }
        } else {
            asm volatile("s_waitcnt vmcnt(0)" ::: "memory");
        }
        asm volatile("s_waitcnt lgkmcnt(0)\n\ts_barrier" ::: "memory");
    }
    asm volatile("s_waitcnt vmcnt(0)\n\ts_barrier" ::: "memory");
#undef B8_UNIT_DMA
}
}

__device__ __forceinline__ void attn_B(const Ctx& C) {
    const bf16_t* QKV = WSP(bf16_t, WS_BIG + BIG_QKV); bf16_t* O = WSP(bf16_t, WS_O); const float* subln = IN_F(15);
    const float lam = diff_lambda(C);
    const int vcu = (C.G % 8 == 0) ? (C.bid % 8) * (C.G / 8) + C.bid / 8 : C.bid;
    for (int u = vcu; u < 1024; u += C.G) {
        const int k = u / C.G, v = u % C.G; int bh, qb;
        if (C.G == 256) { bh = v >> 4; qb = (v & 15) * 4 + k; } else { bh = u >> 6; qb = u & 63; }
        att::diff_unit(C.lds, (const unsigned char*)QKV, O, subln, lam, bh >> 3, bh & 7, qb, C.tid, C.lane, C.wave);
    }
}

struct GetA {
    const bf16_t* QKV; bf16_t* OG; float* LSE; int vcu, G, wave, r;
    __device__ __forceinline__ att::BandDesc operator()(int k) const {
        const int U = vcu + k * G; att::BandDesc D;
        const bool ok = U < 3072; const int Uc = ok ? U : 0;
        const int v = Uc & 31, t3 = Uc >> 5, gi = t3 % 3, bh = t3 / 3, b = bh >> 4, h = bh & 15;
        const int sh = 2 * gi, dil = 1 << sh, Lg = SEQ >> sh, nqb = 32 >> sh, res = v >> (5 - sh), i0 = (v & (nqb - 1)) << 8;
        const size_t tok0 = (size_t)b * SEQ + res;
        const bf16_t* base = QKV + tok0 * NQKV_A + gi * 3072 + h * 64;
        D.Kb = base + 1024; D.Vb = base + 2048; D.kstride = (size_t)dil * NQKV_A; D.L = Lg; D.jstart = i0 - 64;
        D.qi0 = i0 + 32 * wave; D.tlo = ok ? (wave >> 1) : 1; D.thi = ok ? ((32 * wave + 159) >> 6) : 0; D.m0 = -1e30f; D.l0 = 0.f;
        D.qrow = base + (size_t)(D.qi0 + r) * dil * NQKV_A;
        D.out = OG + ((size_t)gi * NTOK + tok0) * DM + h * 64; D.ostride = (size_t)dil * DM;
        D.lse = LSE + ((size_t)gi * NTOK + tok0) * 16 + h; D.lstride = (size_t)dil * 16;
        return D;
    }
};
struct GetA8 {
    const unsigned char* QKV8; bf16_t* OG; float* LSE; int vcu, G, wave, r;
    __device__ __forceinline__ att::BandDesc8 operator()(int k) const {
        const int U = vcu + k * G; att::BandDesc8 D;
        const bool ok = U < 3072; const int Uc = ok ? U : 0;
        const int v = Uc & 31, t3 = Uc >> 5, gi = t3 % 3, bh = t3 / 3, b = bh >> 4, h = bh & 15;
        const int sh = 2 * gi, dil = 1 << sh, Lg = SEQ >> sh, nqb = 32 >> sh, res = v >> (5 - sh), i0 = (v & (nqb - 1)) << 8;
        const size_t tok0 = (size_t)b * SEQ + res;
        const unsigned char* base = QKV8 + (size_t)(3 * gi) * ((size_t)NTOK * 1024) + (size_t)((b * 16 + h) * SEQ + res * Lg) * 64;
        D.Kb = base + (size_t)NTOK * 1024; D.Vb = base + (size_t)2 * NTOK * 1024; D.kstride = 64; D.L = Lg; D.jstart = i0 - 64;
        D.qi0 = i0 + 32 * wave; D.tlo = ok ? (wave >> 1) : 1; D.thi = ok ? ((32 * wave + 159) >> 6) : 0; D.m0 = -1e30f; D.l0 = 0.f;
        D.qrow = base + (size_t)(D.qi0 + r) * 64;
        D.out = OG + ((size_t)gi * NTOK + tok0) * DM + h * 64; D.ostride = (size_t)dil * DM;
        D.lse = LSE + ((size_t)gi * NTOK + tok0) * 16 + h; D.lstride = (size_t)dil * 16;
        return D;
    }
};
__device__ __forceinline__ void attn_A8(const Ctx& C) {
    GetA8 g; g.QKV8 = WSP(unsigned char, WS_BIG + BIG_QKV); g.OG = WSP(bf16_t, WS_BIG + BIG_OG); g.LSE = WSP(float, WS_LSE);
    g.vcu = (C.G % 8 == 0) ? (C.bid % 8) * (C.G / 8) + C.bid / 8 : C.bid; g.G = C.G; g.wave = C.wave; g.r = C.lane & 31;
    att::band_stream8<6, 64, GetA8>(C.lds, (3072 + C.G - 1) / C.G, g, C.tid, C.lane, C.wave);
}
__device__ __forceinline__ void attn_A(const Ctx& C) {
    GetA g; g.QKV = WSP(bf16_t, WS_BIG + BIG_QKV); g.OG = WSP(bf16_t, WS_BIG + BIG_OG); g.LSE = WSP(float, WS_LSE);
    g.vcu = (C.G % 8 == 0) ? (C.bid % 8) * (C.G / 8) + C.bid / 8 : C.bid; g.G = C.G; g.wave = C.wave; g.r = C.lane & 31;
    att::band_stream<6, 64, true, GetA>(C.lds, (3072 + C.G - 1) / C.G, g, C.tid, C.lane, C.wave);
}
struct GetC {
    const bf16_t* QKV; bf16_t* O; float sk0, sk1; int vcu, G, wave, r, hh;
    __device__ __forceinline__ att::BandDesc operator()(int k) const {
        const int U = vcu + k * G; att::BandDesc D;
        const bool ok = U < 1024; const int Uc = ok ? U : 0;
        const int qblk = Uc & 255, bg = Uc >> 8, b = bg >> 1, g = bg & 1, i0 = qblk * 32, head = 8 * g + wave;
        const bf16_t* base = QKV + (size_t)b * SEQ * NQKV_C;
        D.Kb = base + 1024 + g * 64; D.Vb = base + 1152 + g * 64; D.kstride = (size_t)NQKV_C; D.L = SEQ; D.jstart = i0 - 128;
        D.qi0 = i0; D.tlo = ok ? 0 : 1; D.thi = ok ? 4 : 0; D.m0 = (g ? sk1 : sk0) * LOG2E; D.l0 = hh == 0 ? 1.f : 0.f;
        D.qrow = base + (size_t)(i0 + r) * NQKV_C + head * 64;
        D.out = O + (size_t)b * SEQ * DM + head * 64; D.ostride = DM; D.lse = nullptr; D.lstride = 0;
        return D;
    }
};
struct GetC8 {
    const unsigned char* QKV8; bf16_t* O; float sk0, sk1; int vcu, G, wave, r, hh;
    __device__ __forceinline__ att::BandDesc8 operator()(int k) const {
        const int U = vcu + k * G; att::BandDesc8 D;
        const bool ok = U < 1024; const int Uc = ok ? U : 0;
        const int qblk = Uc & 255, bg = Uc >> 8, b = bg >> 1, g = bg & 1, i0 = qblk * 32, head = 8 * g + wave;
        const unsigned char* base = QKV8 + (size_t)b * SEQ * NQKV_C;
        D.Kb = base + 1024 + g * 64; D.Vb = base + 1152 + g * 64; D.kstride = (size_t)NQKV_C; D.L = SEQ; D.jstart = i0 - 128;
        D.qi0 = i0; D.tlo = ok ? 0 : 1; D.thi = ok ? 4 : 0; D.m0 = (g ? sk1 : sk0) * LOG2E; D.l0 = hh == 0 ? 1.f : 0.f;
        D.qrow = base + (size_t)(i0 + r) * NQKV_C + head * 64;
        D.out = O + (size_t)b * SEQ * DM + head * 64; D.ostride = DM; D.lse = nullptr; D.lstride = 0;
        return D;
    }
};
__device__ __forceinline__ void attn_C8(const Ctx& C) {
    GetC8 g; g.QKV8 = WSP(unsigned char, WS_BIG + BIG_QKV); g.O = WSP(bf16_t, WS_O); g.sk0 = IN_F(24)[C.wave]; g.sk1 = IN_F(24)[8 + C.wave];
    g.vcu = (C.G % 8 == 0) ? (C.bid % 8) * (C.G / 8) + C.bid / 8 : C.bid; g.G = C.G; g.wave = C.wave; g.r = C.lane & 31; g.hh = C.lane >> 5;
    asm volatile("s_waitcnt vmcnt(0)" ::: "memory");
    att::band_stream8<5, 128, GetC8>(C.lds, (1024 + C.G - 1) / C.G, g, C.tid, C.lane, C.wave);
}
__device__ __forceinline__ void attn_C(const Ctx& C) {
    GetC g; g.QKV = WSP(bf16_t, WS_BIG + BIG_QKV); g.O = WSP(bf16_t, WS_O); g.sk0 = IN_F(24)[C.wave]; g.sk1 = IN_F(24)[8 + C.wave];
    g.vcu = (C.G % 8 == 0) ? (C.bid % 8) * (C.G / 8) + C.bid / 8 : C.bid; g.G = C.G; g.wave = C.wave; g.r = C.lane & 31; g.hh = C.lane >> 5;
    asm volatile("s_waitcnt vmcnt(0)" ::: "memory");
    att::band_stream<5, 128, false, GetC>(C.lds, (1024 + C.G - 1) / C.G, g, C.tid, C.lane, C.wave);
}

__device__ __forceinline__ void combine_A(const Ctx& C) {
    const bf16_t* OG = WSP(bf16_t, WS_BIG + BIG_OG); const float* LSE = WSP(float, WS_LSE); bf16_t* O = WSP(bf16_t, WS_O);
    const int gw = C.bid * 8 + C.wave, NGW = C.G * 8, lane = C.lane, h = lane >> 2;
    for (int tok = gw; tok < NTOK; tok += NGW) {
        const float L0 = LSE[((size_t)0 * NTOK + tok) * 16 + h], L1 = LSE[((size_t)1 * NTOK + tok) * 16 + h], L2 = LSE[((size_t)2 * NTOK + tok) * 16 + h];
        const float M = fmaxf(L0, fmaxf(L1, L2));
        float w0 = exp2f(L0 - M), w1 = exp2f(L1 - M), w2 = exp2f(L2 - M); const float inv = 1.0f / (w0 + w1 + w2); w0 *= inv; w1 *= inv; w2 *= inv;
#pragma unroll
        for (int c = 0; c < 2; ++c) {
            const size_t off = (size_t)tok * DM + lane * 16 + c * 8;
            const u32x4 a = *(const u32x4*)(OG + off), b = *(const u32x4*)(OG + (size_t)NTOK * DM + off), d = *(const u32x4*)(OG + (size_t)2 * NTOK * DM + off);
            u32x4 o;
#pragma unroll
            for (int i = 0; i < 4; ++i) o[i] = pk2(w0 * bflo(a[i]) + w1 * bflo(b[i]) + w2 * bflo(d[i]), w0 * bfhi(a[i]) + w1 * bfhi(b[i]) + w2 * bfhi(d[i]));
            *(u32x4*)(O + off) = o;
        }
    }
}

template <int N, int MASK>
__device__ __forceinline__ void halve_step(float (&v)[64], int lane) {
    const bool up = (lane & MASK) != 0;
#pragma unroll
    for (int i = 0; i < N / 2; ++i) { const float keep = up ? v[i + N / 2] : v[i], send = up ? v[i] : v[i + N / 2]; v[i] = keep + __shfl_xor(send, MASK); }
}
__device__ __forceinline__ void moe_router(const Ctx& C, const float* gain, const float* router) {
    const bf16_t* X = WSP(bf16_t, WS_XB);
    LAS float* grt = (LAS float*)C.lds;
    LAS int* tE = (LAS int*)(C.lds + 32768); LAS float* tG0 = (LAS float*)(C.lds + 32768 + 256); LAS float* tG1 = (LAS float*)(C.lds + 32768 + 512);
    for (int i = C.tid; i < 8192; i += 512) { const int k = i >> 3, e = i & 7; grt[e * 1024 + k] = gain[k] * router[i]; }
    __syncthreads();
    int* gE = WSP(int, WS_TOK + TOK_E); float* gG0 = WSP(float, WS_TOK + TOK_G0); float* gG1 = WSP(float, WS_TOK + TOK_G1); int* gR = WSP(int, WS_TOK + TOK_RANK); int* hist = WSP(int, WS_TOK + TOK_HIST);
    const int lane = C.lane;
    for (int chunk = C.bid; chunk < NTOK / 64; chunk += C.G) {
        float v[64]; float sv[64];
        u32x2 raw[8][4];
#pragma unroll
        for (int j = 0; j < 8; ++j) { const u32x2* xr = (const u32x2*)(X + (size_t)(chunk * 64 + C.wave * 8 + j) * DM) + lane;
#pragma unroll
            for (int jj = 0; jj < 4; ++jj) raw[j][jj] = xr[64 * jj]; }
        asm volatile("" ::: "memory");
#pragma unroll
        for (int j = 0; j < 8; ++j) {
            f32x4 x[4]; float ss = 0.f;
#pragma unroll
            for (int jj = 0; jj < 4; ++jj) { const u32x2 w = raw[j][jj]; x[jj] = (f32x4){bflo(w.x), bfhi(w.x), bflo(w.y), bfhi(w.y)}; ss += (x[jj][0] * x[jj][0] + x[jj][1] * x[jj][1]) + (x[jj][2] * x[jj][2] + x[jj][3] * x[jj][3]); }
            sv[j] = ss;
#pragma unroll
            for (int e = 0; e < 8; ++e) { float a = 0.f;
#pragma unroll
                for (int jj = 0; jj < 4; ++jj) { const f32x4 w = *(const LAS f32x4*)(grt + e * 1024 + (64 * jj + lane) * 4); a += x[jj][0] * w[0]; a += x[jj][1] * w[1]; a += x[jj][2] * w[2]; a += x[jj][3] * w[3]; }
                v[j * 8 + e] = a; }
        }
        halve_step<64, 32>(v, lane); halve_step<32, 16>(v, lane); halve_step<16, 8>(v, lane); halve_step<8, 4>(v, lane); halve_step<4, 2>(v, lane); halve_step<2, 1>(v, lane);
        halve_step<8, 32>(sv, lane); halve_step<4, 16>(sv, lane); halve_step<2, 8>(sv, lane);
        float ss = sv[0]; ss += __shfl_xor(ss, 1); ss += __shfl_xor(ss, 2); ss += __shfl_xor(ss, 4);
        const float rstd = 1.0f / sqrtf(ss * (1.0f / 1024.0f) + NORM_EPS);
        const float val = v[0]; const int idx = lane & 7;
        float v0 = val; int e0 = idx;
#pragma unroll
        for (int o = 1; o < 8; o <<= 1) { const float ov = __shfl_xor(v0, o); const int oi = __shfl_xor(e0, o); if (ov > v0 || (ov == v0 && oi < e0)) { v0 = ov; e0 = oi; } }
        float v1 = (idx == e0) ? -INFINITY : val; int e1 = idx;
#pragma unroll
        for (int o = 1; o < 8; o <<= 1) { const float ov = __shfl_xor(v1, o); const int oi = __shfl_xor(e1, o); if (ov > v1 || (ov == v1 && oi < e1)) { v1 = ov; e1 = oi; } }
        const float ex = expf((v1 - v0) * rstd), g0 = 1.0f / (1.0f + ex), g1 = ex / (1.0f + ex);
        if (idx == 0) { const int tl = C.wave * 8 + (lane >> 3); tE[tl] = e0 | (e1 << 8); tG0[tl] = g0; tG1[tl] = g1; }
        __syncthreads();
        if (C.wave == 0) {
            const int ee = tE[C.lane], f0 = ee & 255, f1 = ee >> 8; int r0 = 0, r1 = 0;
            const unsigned long long lt = (1ull << C.lane) - 1ull;
#pragma unroll
            for (int e = 0; e < 8; ++e) {
                const unsigned long long b0 = __ballot(f0 == e), b1 = __ballot(f1 == e);
                const int before = __popcll(b0 & lt) + __popcll(b1 & lt);
                if (f0 == e) r0 = before; if (f1 == e) r1 = before;
                if (C.lane == 0) hist[chunk * 8 + e] = __popcll(b0) + __popcll(b1);
            }
            const int tok = chunk * 64 + C.lane;
            gE[tok] = ee; gG0[tok] = tG0[C.lane]; gG1[tok] = tG1[C.lane]; gR[tok] = r0 | (r1 << 16);
        }
        __syncthreads();
    }
}
__device__ __forceinline__ void moe_gather(const Ctx& C) {
    const bf16_t* X = WSP(bf16_t, WS_XB); unsigned char* XBUF = WSP(unsigned char, WS_BIG + BIG_XBUF);
    const int* gE = WSP(int, WS_TOK + TOK_E); const int* gR = WSP(int, WS_TOK + TOK_RANK); const int* hist = WSP(int, WS_TOK + TOK_HIST);
    int* gD0 = WSP(int, WS_TOK + TOK_D0); int* gD1 = WSP(int, WS_TOK + TOK_D1); int* pendg = WSP(int, WS_TOK + TOK_PEND);
    LAS int* pre = (LAS int*)C.lds;
    LAS int* tot = (LAS int*)(C.lds + 8192);
    {
        const int e = C.wave; int h4[4]; int s = 0;
#pragma unroll
        for (int i = 0; i < 4; ++i) { h4[i] = hist[(4 * C.lane + i) * 8 + e]; s += h4[i]; }
        int inc = s;
#pragma unroll
        for (int o = 1; o < 64; o <<= 1) { const int t = __shfl_up(inc, o); if (C.lane >= o) inc += t; }
        int ex = inc - s;
#pragma unroll
        for (int i = 0; i < 4; ++i) { pre[(4 * C.lane + i) * 8 + e] = ex; ex += h4[i]; }
        if (C.lane == 63) tot[e] = inc;
    }
    __syncthreads();
    if (C.tid == 0) { int p = 0; for (int e = 0; e < 8; ++e) { tot[8 + e] = p; p += ((tot[e] + 255) >> 8) << 8; tot[16 + e] = p; } }
    __syncthreads();
    if (C.bid == 0 && C.tid < 8) pendg[C.tid] = tot[16 + C.tid];
    if (C.bid == 0 && C.tid == 8) pendg[8] = tot[23] >> 8;
    for (int chunk = C.bid; chunk < NTOK / 64; chunk += C.G) {
        for (int tl = C.wave * 8; tl < C.wave * 8 + 8; ++tl) {
            const int tok = chunk * 64 + tl;
            const int ee = gE[tok], e0 = ee & 255, e1 = ee >> 8, rr = gR[tok];
            const int d0 = tot[8 + e0] + pre[chunk * 8 + e0] + (rr & 0xffff), d1 = tot[8 + e1] + pre[chunk * 8 + e1] + (rr >> 16);
            if (C.lane == 0) { gD0[tok] = d0; gD1[tok] = d1; }
            const u32x2* xr = (const u32x2*)(X + (size_t)tok * DM) + C.lane;
            f32x4 v[4]; float ss = 0.f;
#pragma unroll
            for (int j = 0; j < 4; ++j) { const u32x2 w = xr[64 * j]; v[j] = (f32x4){bflo(w.x), bfhi(w.x), bflo(w.y), bfhi(w.y)}; ss += (v[j][0] * v[j][0] + v[j][1] * v[j][1]) + (v[j][2] * v[j][2] + v[j][3] * v[j][3]); }
            const float rstd = 1.0f / sqrtf(wave_sum(ss) * (1.0f / 1024.0f) + NORM_EPS);
            unsigned* o0 = (unsigned*)(XBUF + (size_t)d0 * DM) + C.lane; unsigned* o1 = (unsigned*)(XBUF + (size_t)d1 * DM) + C.lane;
#pragma unroll
            for (int j = 0; j < 4; ++j) { const unsigned w = pk_fp8x4(v[j][0] * rstd, v[j][1] * rstd, v[j][2] * rstd, v[j][3] * rstd); o0[64 * j] = w; o1[64 * j] = w; }
        }
    }
    if (C.bid < 8) {
        const int e = C.bid, r0 = tot[8 + e] + tot[e], r1 = tot[16 + e];
        for (int i = C.tid; i < (r1 - r0) * 64; i += 512) *((u32x4*)(XBUF + (size_t)r0 * DM) + i) = (u32x4){0u, 0u, 0u, 0u};
    }
}
template <bool FINAL>
__device__ __forceinline__ void moe_combine(const Ctx& C, const float* gfinal) {
    bf16_t* XB = WSP(bf16_t, WS_XB); float* ssq = WSP(float, WS_SSQ); const bf16_t* Y = WSP(bf16_t, WS_BIG + BIG_YBUF);
    const float* gG0 = WSP(float, WS_TOK + TOK_G0); const float* gG1 = WSP(float, WS_TOK + TOK_G1); const int* gD0 = WSP(int, WS_TOK + TOK_D0); const int* gD1 = WSP(int, WS_TOK + TOK_D1);
    const int gw = C.bid * 8 + C.wave, NGW = C.G * 8;
    for (int tok = gw; tok < NTOK; tok += NGW) {
        const float g0 = gG0[tok] * (1.0f / (W8_SCALE * H8_SCALE)), g1 = gG1[tok] * (1.0f / (W8_SCALE * H8_SCALE)); const int d0 = gD0[tok], d1 = gD1[tok];
        const u32x2* xr = (const u32x2*)(XB + (size_t)tok * DM) + C.lane;
        const u32x2* y0 = (const u32x2*)(Y + (size_t)d0 * DM) + C.lane; const u32x2* y1 = (const u32x2*)(Y + (size_t)d1 * DM) + C.lane;
        f32x4 v[4]; float ss = 0.f;
#pragma unroll
        for (int j = 0; j < 4; ++j) { const u32x2 xw = xr[64 * j]; const f32x4 x = (f32x4){bflo(xw.x), bfhi(xw.x), bflo(xw.y), bfhi(xw.y)}; const u32x2 a = y0[64 * j], b = y1[64 * j];
            v[j][0] = x[0] + g0 * bflo(a.x) + g1 * bflo(b.x); v[j][1] = x[1] + g0 * bfhi(a.x) + g1 * bfhi(b.x);
            v[j][2] = x[2] + g0 * bflo(a.y) + g1 * bflo(b.y); v[j][3] = x[3] + g0 * bfhi(a.y) + g1 * bfhi(b.y);
            ss += (v[j][0] * v[j][0] + v[j][1] * v[j][1]) + (v[j][2] * v[j][2] + v[j][3] * v[j][3]); }
        const float tot = wave_sum(ss);
        if (FINAL) {
            const float rstd = 1.0f / sqrtf(tot * (1.0f / 1024.0f) + NORM_EPS);
            f32x4* o = (f32x4*)(C.out + (size_t)tok * DM) + C.lane; const f32x4* gf = (const f32x4*)gfinal + C.lane;
#pragma unroll
            for (int j = 0; j < 4; ++j) { const f32x4 g = gf[64 * j]; o[64 * j] = v[j] * rstd * g; }
        } else {
            u32x2* bo = (u32x2*)(XB + (size_t)tok * DM) + C.lane;
#pragma unroll
            for (int j = 0; j < 4; ++j) { u32x2 w; w.x = pk2(v[j][0], v[j][1]); w.y = pk2(v[j][2], v[j][3]); bo[64 * j] = w; }
            write_ssq_row(ssq, tok, tot, C.lane);
        }
    }
}

constexpr int RTAB_OFF = 134144, RTAB_UNITS = 13;
template <class Epi, bool FP8 = false>
__device__ __forceinline__ void dense_gemm(const Ctx& C, const bf16_t* A, const bf16_t* Bt, int M, int N, int K, const Epi& E, const float* ssq = nullptr, int sx = SC_ONE) {
    pg8::Gemm g{A, Bt, M, N, FP8 ? K / 2 : K, 0, SC_W8, sx}; pg8::StaticOrder S; S.init(M, N, C.G, C.bid);
    if (ssq) {
        LAS float* tab = (LAS float*)(C.lds + RTAB_OFF); pg8::Unit u;
        for (int i = C.tid >> 8; i < RTAB_UNITS && S.next(i, u); i += 2) tab[i * 256 + (C.tid & 255)] = pg8::row_rstd(ssq, u.pm * 256 + (C.tid & 255)) * (FP8 ? (1.0f / W8_SCALE) : 1.0f);
        __syncthreads();
    }
    pg8::gemm_phase<Epi, pg8::StaticOrder, FP8>(C.lds, g, S, E);
}
template <class Epi>
__device__ __forceinline__ void moe_gemm(const Ctx& C, const bf16_t* A, const bf16_t* Bt, int NC, int K, const Epi& E) {
    const int* pendg = WSP(int, WS_TOK + TOK_PEND);
    pg8::GroupedOrder S; S.NC = NC; S.G = C.G; S.c = C.bid;
#pragma unroll
    for (int e = 0; e < 8; ++e) S.pend[e] = __builtin_amdgcn_readfirstlane(pendg[e]);
    S.RT = __builtin_amdgcn_readfirstlane(pendg[8]);
    pg8::Gemm g{A, Bt, S.RT * 256, NC * 256, K / 2, 0, SC_W8, SC_ONE};
    pg8::gemm_phase<Epi, pg8::GroupedOrder, true>(C.lds, g, S, E);
}

constexpr int DOWN_NSL = 7, DOWN_SNT = 4;
__device__ __forceinline__ void moe_gemm_down(const Ctx& C, const bf16_t* A, const bf16_t* Bt, bf16_t* Y, float* part) {
    const int* pendg = WSP(int, WS_TOK + TOK_PEND);
    pg8::GroupedOrderK S; S.NC = 4; S.G = C.G; S.c = C.bid; S.NSL = DOWN_NSL; S.SNT = DOWN_SNT;
#pragma unroll
    for (int e = 0; e < 8; ++e) S.pend[e] = __builtin_amdgcn_readfirstlane(pendg[e]);
    S.RT = __builtin_amdgcn_readfirstlane(pendg[8]);
    const int full = 2 * C.G / 4, rtf = S.RT < full ? S.RT : full;
    pg8::Gemm g{A, Bt, S.RT * 256, 1024, FFE / 2, 0, SC_W8, SC_H8};
    pg8::EpiPlainK E{Y, DM, part, rtf, DOWN_NSL};
    pg8::gemm_phase<pg8::EpiPlainK, pg8::GroupedOrderK, true>(C.lds, g, S, E);
}
__device__ __forceinline__ void moe_down_reduce(const Ctx& C, bf16_t* Y, const float* part) {
    const int* pendg = WSP(int, WS_TOK + TOK_PEND);
    const int RT = pendg[8], full = 2 * C.G / 4, rtf = RT < full ? RT : full;
    const int nitems = (RT - rtf) * 256 * 128;
    for (int it = C.bid * 512 + C.tid; it < nitems; it += C.G * 512) {
        const int cg = it & 127, row = it >> 7, trel = row >> 8, lr = row & 255, ct = cg >> 5, lc = (cg & 31) * 8;
        const float* p = part + (size_t)((trel * 4 + ct) * DOWN_NSL) * 65536 + (size_t)lr * 256 + lc;
        f32x4 a = (f32x4){0.f, 0.f, 0.f, 0.f}, b = a;
#pragma unroll
        for (int ks = 0; ks < DOWN_NSL; ++ks) { a += *(const f32x4*)(p + (size_t)ks * 65536); b += *(const f32x4*)(p + (size_t)ks * 65536 + 4); }
        u32x4 w; w.x = pk2(a[0], a[1]); w.y = pk2(a[2], a[3]); w.z = pk2(b[0], b[1]); w.w = pk2(b[2], b[3]);
        *(u32x4*)(Y + (size_t)((rtf + trel) * 256 + lr) * DM + ct * 256 + lc) = w;
    }
}

constexpr int N_PHASES = 29;
struct Args { const void* in[39]; float* out; unsigned char* ws; int ph_lo, ph_hi; };

__global__ void __launch_bounds__(512, 2) fwd_kernel(Args args) {
    extern __shared__ __attribute__((aligned(16))) unsigned char lds_raw[];
    Ctx C0;
    C0.lds = (LAS unsigned char*)lds_raw; C0.ws = args.ws; C0.in = args.in; C0.out = args.out;
    C0.tid = threadIdx.x; C0.lane = C0.tid & 63; C0.wave = __builtin_amdgcn_readfirstlane(C0.tid >> 6); C0.G = gridDim.x; C0.bid = blockIdx.x;
    const Ctx& C = C0;
    volatile LAS unsigned* MISC = (volatile LAS unsigned*)(C.lds + MISC_OFF);
    for (int u = C.tid; u < (LDS_BYTES - RING_BYTES) / 4; u += 512) ((LAS unsigned*)(C.lds + RING_BYTES))[u] = 0u;
    __syncthreads();
    XcdBarrier bar; bar.bar = WSP(unsigned, WS_CTL) + CW_BAR; bar.x = 0; bar.st = nullptr;
    if (MK_SINGLE) bar = xcd_barrier_post(WSP(unsigned, WS_CTL) + CW_BAR, MISC + 8);
    const int lo = args.ph_lo, hi = args.ph_hi;
#define IN(k) (lo <= (k) && (k) < hi)
#define SEAM(k) do { if (IN(k) && IN((k) + 1)) xcd_barrier(bar); else __syncthreads(); } while (0)
#define PHASE(k, ...) if (IN(k)) { Ctx C = C0; { int t_ = (int)threadIdx.x; asm volatile("" : "+v"(t_)); C.tid = t_; C.lane = t_ & 63; } { __VA_ARGS__ } if (PROBE_PHASE == (k)) { xcd_barrier(bar); { __VA_ARGS__ } } } SEAM(k);

    const LAS float* const RTAB = (const LAS float*)(C.lds + RTAB_OFF);
    bf16_t* const XB = WSP(bf16_t, WS_XB); float* const SSQ = WSP(float, WS_SSQ); const float* const ROPE = WSP(float, WS_ROPE);
    bf16_t* const QKV = WSP(bf16_t, WS_BIG + BIG_QKV); bf16_t* const OB = WSP(bf16_t, WS_O); bf16_t* const HB = WSP(bf16_t, WS_BIG + BIG_H);
    bf16_t* const XBUF = WSP(bf16_t, WS_BIG + BIG_XBUF); bf16_t* const YBUF = WSP(bf16_t, WS_BIG + BIG_YBUF); bf16_t* const HBUF = WSP(bf16_t, WS_BIG + BIG_HBUF);

    PHASE(0, convert_weights_first(C); rope_table(C); x_to_bf16(C);)
    PHASE(1, pg8::EpiQKV E{QKV, NQKV_A, RTAB, ROPE, 3072, 2048, nullptr, (unsigned char*)QKV, 1}; dense_gemm<pg8::EpiQKV, true>(C, WSP(bf16_t, WS_X8), WSP(bf16_t, WS_WQKV0), NTOK, NQKV_A, DM, E, SSQ, SC_ONE);)
    PHASE(2, attn_A8(C);)
    PHASE(3, combine_A(C);)
    PHASE(4, pg8::EpiRes E{XB, SSQ, DM, nullptr}; dense_gemm(C, OB, WSP(bf16_t, WS_WO0), NTOK, DM, DM, E);)
    PHASE(5, pg8::EpiSwiGLU E{HB, FF, RTAB}; dense_gemm(C, XB, WSP(bf16_t, WS_W13_0), NTOK, 2 * FF, DM, E, SSQ);)
    PHASE(6, pg8::EpiRes E{XB, SSQ, DM, nullptr}; dense_gemm(C, HB, WSP(bf16_t, WS_W2_0), NTOK, DM, FF, E);)
    PHASE(7, pg8::EpiQKV E{QKV, NQKV_B, RTAB, ROPE, 3072, 2048, nullptr, (unsigned char*)QKV}; dense_gemm(C, XB, WSP(bf16_t, WS_WQKV1), NTOK, NQKV_B, DM, E, SSQ);)
    PHASE(8, attn_B(C);)
    PHASE(9, pg8::EpiRes E{XB, SSQ, DM, nullptr}; dense_gemm(C, OB, WSP(bf16_t, WS_WO1), NTOK, DM, DM, E);)
    PHASE(10, moe_router(C, IN_F(17), IN_F(18));)
    PHASE(11, moe_gather(C);)
    PHASE(12, pg8::EpiSwiGLU8 E{(unsigned char*)HBUF, FFE}; moe_gemm(C, XBUF, WSP(bf16_t, WS_WM13), 2 * FFE / 256, DM, E);)
    PHASE(13, moe_gemm_down(C, HBUF, WSP(bf16_t, WS_WM2), YBUF, WSP(float, WS_BIG + BIG_XBUF));)
    PHASE(14, moe_down_reduce(C, YBUF, WSP(float, WS_BIG + BIG_XBUF)); xcd_barrier(bar); moe_combine<false>(C, nullptr); convert_weights_second(C);)
    PHASE(15, pg8::EpiQKV E{QKV, NQKV_C, RTAB, ROPE, 4096, 1152, nullptr, (unsigned char*)QKV}; dense_gemm(C, XB, WSP(bf16_t, WS_WQKV2), NTOK, NQKV_C, DM, E, SSQ);)
    PHASE(16, attn_C8(C);)
    PHASE(17, pg8::EpiRes E{XB, SSQ, DM, nullptr}; dense_gemm(C, OB, WSP(bf16_t, WS_WO2), NTOK, DM, DM, E);)
    PHASE(18, pg8::EpiSwiGLU E{HB, FF, RTAB}; dense_gemm(C, XB, WSP(bf16_t, WS_W13_2), NTOK, 2 * FF, DM, E, SSQ);)
    PHASE(19, pg8::EpiRes E{XB, SSQ, DM, WSP(unsigned char, WS_X8)}; dense_gemm(C, HB, WSP(bf16_t, WS_W2_2), NTOK, DM, FF, E);)
    PHASE(20, pg8::EpiQKV E{QKV, NQKV_A, RTAB, ROPE, 3072, 2048, nullptr, (unsigned char*)QKV, 1}; dense_gemm<pg8::EpiQKV, true>(C, WSP(bf16_t, WS_X8), WSP(bf16_t, WS_WQKV3), NTOK, NQKV_A, DM, E, SSQ, SC_ONE);)
    PHASE(21, attn_A8(C);)
    PHASE(22, combine_A(C);)
    PHASE(23, pg8::EpiRes E{XB, SSQ, DM, nullptr}; dense_gemm(C, OB, WSP(bf16_t, WS_WO3), NTOK, DM, DM, E);)
    PHASE(24, moe_router(C, IN_F(33), IN_F(34));)
    PHASE(25, moe_gather(C);)
    PHASE(26, pg8::EpiSwiGLU8 E{(unsigned char*)HBUF, FFE}; moe_gemm(C, XBUF, WSP(bf16_t, WS_WM13), 2 * FFE / 256, DM, E);)
    PHASE(27, moe_gemm_down(C, HBUF, WSP(bf16_t, WS_WM2), YBUF, WSP(float, WS_BIG + BIG_XBUF));)
    if (IN(28)) { Ctx C = C0; { int t_ = (int)threadIdx.x; asm volatile("" : "+v"(t_)); C.tid = t_; C.lane = t_ & 63; } moe_down_reduce(C, YBUF, WSP(float, WS_BIG + BIG_XBUF)); xcd_barrier(bar); moe_combine<true>(C, IN_F(38)); }
#undef IN
#undef SEAM
#undef PHASE
}

extern "C" void kernel_launch(void* const* d_in, const int* in_sizes, int n_in, void* d_out, int out_size, void* d_ws, size_t ws_size, hipStream_t stream) {
    static int grid = 0;
    if (grid == 0) {
        if (n_in != 39 || out_size != NTOK * DM || ws_size < WS_END) { fprintf(stderr, "kernel_launch: unexpected shapes (n_in %d out %d ws %zu)\n", n_in, out_size, ws_size); grid = -1; return; }
        int dev = 0, cus = 0, per_cu = 0;
        if (hipGetDevice(&dev) != hipSuccess || hipDeviceGetAttribute(&cus, hipDeviceAttributeMultiprocessorCount, dev) != hipSuccess) { grid = -1; return; }
        if (hipFuncSetAttribute((const void*)fwd_kernel, hipFuncAttributeMaxDynamicSharedMemorySize, LDS_BYTES) != hipSuccess) { grid = -1; return; }
        if (hipOccupancyMaxActiveBlocksPerMultiprocessor(&per_cu, (const void*)fwd_kernel, 512, LDS_BYTES) != hipSuccess || per_cu < 1) { fprintf(stderr, "kernel_launch: occupancy query says %d\n", per_cu); }
        (void)hipGetLastError();
        grid = cus;
    }
    if (grid < 0) return;
    if (hipMemsetAsync((char*)d_ws + WS_CTL, 0, CTL_ZERO_BYTES, stream) != hipSuccess) return;
    Args a{};
    for (int i = 0; i < 39; ++i) a.in[i] = d_in[i];
    a.out = (float*)d_out; a.ws = (unsigned char*)d_ws;
#if MK_SINGLE
    a.ph_lo = 0; a.ph_hi = N_PHASES;
    hipLaunchKernelGGL(fwd_kernel, dim3(grid), dim3(512), LDS_BYTES, stream, a);
#else
    for (int p = 0; p < N_PHASES; ++p) { a.ph_lo = p; a.ph_hi = p + 1; hipLaunchKernelGGL(fwd_kernel, dim3(grid), dim3(512), LDS_BYTES, stream, a); }
#endif
}
```

```cpp
#include <hip/hip_runtime.h>
#include <cstdio>
#include <cstdint>
#include <cmath>

#ifndef MK_SINGLE
#define MK_SINGLE 1
#endif
#ifndef PROBE_PHASE
#define PROBE_PHASE -1
#endif

#define LAS __attribute__((address_space(3)))
#define GAS __attribute__((address_space(1)))
typedef unsigned short bf16_t;
typedef short bf16x8 __attribute__((ext_vector_type(8)));
typedef float f32x4 __attribute__((ext_vector_type(4)));
typedef float f32x2 __attribute__((ext_vector_type(2)));
typedef unsigned u32x4 __attribute__((ext_vector_type(4)));
typedef unsigned u32x2 __attribute__((ext_vector_type(2)));

constexpr int NTOK = 16384, SEQ = 8192, DM = 1024;
constexpr int NQKV_A = 9216, NQKV_B = 3072, NQKV_C = 1280;
constexpr int FF = 2816, FFE = 3584, NEXP = 8;
constexpr int MOE_ROWS = 32768 + 2048;
constexpr float LOG2E = 1.4426950408889634f;
constexpr float C2 = 0.125f * 1.4426950408889634f;
constexpr float NORM_EPS = 1e-6f, SUBLN_EPS = 1e-5f;
constexpr float LAMBDA_INIT = 0.35550906759096926f;

constexpr size_t MiB = 1u << 20;
constexpr size_t WS_CTL = 0, CTL_ZERO_BYTES = 1 * MiB;
constexpr size_t WS_ROPE = 1 * MiB;
constexpr size_t WS_SSQ = 2 * MiB;
constexpr size_t WS_TOK = 3 * MiB;
constexpr size_t WS_LSE = 4 * MiB;
constexpr size_t WS_WQKV0 = 8 * MiB, WS_WO0 = 26 * MiB, WS_W13_0 = 28 * MiB, WS_W2_0 = 39 * MiB;
constexpr size_t WS_WQKV1 = 45 * MiB, WS_WO1 = 51 * MiB;
constexpr size_t WS_WQKV2 = 53 * MiB, WS_WO2 = 56 * MiB, WS_W13_2 = 58 * MiB, WS_W2_2 = 69 * MiB;
constexpr size_t WS_WQKV3 = 75 * MiB, WS_WO3 = 93 * MiB;
constexpr size_t WS_WM13 = 96 * MiB, WS_WM2 = 208 * MiB;
constexpr size_t WS_X = 264 * MiB, WS_XB = 328 * MiB, WS_O = 360 * MiB, WS_BIG = 392 * MiB, WS_END = 776 * MiB;
constexpr size_t WS_VT8 = WS_X + 16 * MiB;
constexpr size_t WS_X8 = WS_X;
constexpr size_t BIG_QKV = 0, BIG_OG = 288 * MiB, BIG_H = 0, BIG_XBUF = 0, BIG_YBUF = 68 * MiB, BIG_HBUF = 136 * MiB;
constexpr size_t TOK_E = 0, TOK_G0 = 64 * 1024, TOK_G1 = 128 * 1024, TOK_RANK = 192 * 1024, TOK_D0 = 256 * 1024, TOK_D1 = 320 * 1024, TOK_HIST = 512 * 1024, TOK_PEND = 600 * 1024;
constexpr int CW_BAR = 4096;

constexpr int RING_BYTES = 131072;
constexpr int MISC_OFF = RING_BYTES + 320;
constexpr int LDS_BYTES = 147456;

__device__ __forceinline__ unsigned f2bf(float f) { unsigned u = __builtin_bit_cast(unsigned, f); return (u + 0x7fffu + ((u >> 16) & 1u)) >> 16; }
__device__ __forceinline__ unsigned pk2(float lo, float hi) { return f2bf(lo) | (f2bf(hi) << 16); }
__device__ __forceinline__ float bf2f(unsigned short b) { return __builtin_bit_cast(float, (unsigned)b << 16); }
__device__ __forceinline__ float bflo(unsigned w) { return __builtin_bit_cast(float, w << 16); }
__device__ __forceinline__ float bfhi(unsigned w) { return __builtin_bit_cast(float, w & 0xffff0000u); }
__device__ __forceinline__ float wave_sum(float v) {
#pragma unroll
    for (int o = 1; o < 64; o <<= 1) v += __shfl_xor(v, o);
    return v;
}
__device__ __forceinline__ float wave_max(float v) {
#pragma unroll
    for (int o = 1; o < 64; o <<= 1) v = fmaxf(v, __shfl_xor(v, o));
    return v;
}
#define LDS_WAIT() asm volatile("s_waitcnt lgkmcnt(0)" ::: "memory")
__device__ __forceinline__ unsigned pk_fp8x4(float a, float b, float c, float d) {
    a = fminf(fmaxf(a, -448.f), 448.f); b = fminf(fmaxf(b, -448.f), 448.f); c = fminf(fmaxf(c, -448.f), 448.f); d = fminf(fmaxf(d, -448.f), 448.f);
    int p = __builtin_bit_cast(int, a); p = __builtin_amdgcn_cvt_pk_fp8_f32(a, b, p, false); p = __builtin_amdgcn_cvt_pk_fp8_f32(c, d, p, true); return (unsigned)p;
}
__device__ __forceinline__ unsigned pk_fp8x4_nc(float a, float b, float c, float d) {
    int p; asm volatile("" : "=v"(p));
    p = __builtin_amdgcn_cvt_pk_fp8_f32(a, b, p, false); p = __builtin_amdgcn_cvt_pk_fp8_f32(c, d, p, true); return (unsigned)p;
}
__device__ __forceinline__ unsigned char fp8_byte(float x) { x = fminf(fmaxf(x, -448.f), 448.f); return (unsigned char)__builtin_amdgcn_cvt_pk_fp8_f32(x, x, 0, false); }
constexpr float W8_SCALE = 64.0f, H8_SCALE = 8.0f;
constexpr int SC_ONE = 0x7f7f7f7f, SC_W8 = 0x79797979, SC_H8 = 0x7c7c7c7c;

namespace pg8 {
#define PG8_LAS __attribute__((address_space(3)))
constexpr int BM = 256, BK = 64, HALF = 128, HTB = HALF * BK * 2, STAGE_BYTES = 8 * HTB, NXCD = 8, WGM = 8;

__host__ __device__ __forceinline__ int lds_byte(int r, int c) { const int st = (r >> 4) * 2 + (c >> 5), rr = r & 15, cc = c & 31, ob = rr * 64 + cc * 2; return st * 1024 + (ob ^ (((ob >> 9) & 1) << 5)); }
__host__ __device__ __forceinline__ void stage_rc(int b, int& R, int& C) { const int st = b / 1024, sb = b % 1024, swz = sb ^ (((sb >> 9) & 1) << 5); R = (st >> 1) * 16 + swz / 64; C = (st & 1) * 32 + (swz % 64) / 2; }
__host__ __device__ __forceinline__ int perm32(int rho) { const int n = rho >> 4, i = rho & 15; return 8 * (i >> 2) + 4 * n + (i & 3); }

__device__ __forceinline__ void glds16s(unsigned voff, unsigned long long sbase, unsigned lds_dst) { unsigned keep;
    asm volatile("s_mov_b32 %0, m0\n\ts_mov_b32 m0, %2\n\ts_nop 0\n\tglobal_load_lds_dwordx4 %1, %3\n\ts_mov_b32 m0, %0" : "=&s"(keep) : "v"(voff), "s"(lds_dst), "s"(sbase) : "memory"); }
struct Unit { int pm, pn, pc, koff, nt, mode; };
struct Gemm { const bf16_t* A; const bf16_t* Bt; int M, N, K, ld, sw, sx; };

struct StaticOrder {
    int nM, nN, nwg, G, c;
    __host__ __device__ void init(int M, int N, int G_, int c_) { nM = M / BM; nN = N / BM; nwg = nM * nN; G = G_; c = c_; }
    __host__ __device__ bool next(int i, Unit& u) const {
        const long L = (long)i * G + c; if (L >= nwg) return false;
        int wgid = (int)L; { const int q = nwg / NXCD, r = nwg % NXCD, xcd = wgid % NXCD, off = wgid / NXCD; wgid = (xcd < r ? xcd * (q + 1) : r * (q + 1) + (xcd - r) * q) + off; }
        const int nig = WGM * nN, gid = wgid / nig, fm = gid * WGM, gsz = (nM - fm) < WGM ? (nM - fm) : WGM;
        u.pm = fm + ((wgid % nig) % gsz); u.pn = (wgid % nig) / gsz; u.pc = u.pn; u.koff = 0; u.nt = 0; u.mode = 0; return true;
    }
};
struct GroupedOrder {
    int RT, NC, G, c; int pend[8];
    __device__ bool next(int i, Unit& u) const {
        const long L = (G % 8 == 0) ? ((long)(i * 8 + (c & 7)) * (G >> 3) + (c >> 3)) : ((long)i * G + c);
        if (L >= (long)RT * NC) return false;
        const int per = 8 * NC, blk = (int)(L / per), rem = (int)(L % per), rows = (RT - 8 * blk) < 8 ? (RT - 8 * blk) : 8;
        const int ct = rem / rows, rt = 8 * blk + rem % rows;
        int e = 0;
#pragma unroll
        for (int k = 0; k < 7; ++k) e += (rt * 256 >= pend[k]) ? 1 : 0;
        u.pm = rt; u.pn = e * NC + ct; u.pc = ct; u.koff = 0; u.nt = 0; u.mode = 0; return true;
    }
};
struct GroupedOrderK {
    int RT, NC, G, c, NSL, SNT; int pend[8];
    __device__ bool next(int i, Unit& u) const {
        const long L = (long)(i * 8 + (c & 7)) * (G >> 3) + (c >> 3);
        const int full = 2 * G / NC, RTF = RT < full ? RT : full;
        int rt, ct; u.koff = 0; u.nt = 0; u.mode = 0;
        if (L < (long)RTF * NC) {
            const int per = 8 * NC, blk = (int)(L / per), rem = (int)(L % per), rows = (RTF - 8 * blk) < 8 ? (RTF - 8 * blk) : 8;
            ct = rem / rows; rt = 8 * blk + rem % rows;
        } else {
            const long idx = L - (long)RTF * NC; if (idx >= (long)(RT - RTF) * NC * NSL) return false;
            const int su = (int)(idx / NSL), ks = (int)(idx % NSL);
            rt = RTF + su / NC; ct = su % NC; u.koff = ks * SNT * BK * 2; u.nt = SNT; u.mode = 1 + ks;
        }
        int e = 0;
#pragma unroll
        for (int k = 0; k < 7; ++k) e += (rt * 256 >= pend[k]) ? 1 : 0;
        u.pm = rt; u.pn = e * NC + ct; u.pc = ct; return true;
    }
};

typedef __bf16 bf16x2v __attribute__((ext_vector_type(2)));
__device__ __forceinline__ unsigned cvt_pk_bf16(float lo, float hi) { f32x2 v = {lo, hi}; bf16x2v b = __builtin_convertvector(v, bf16x2v); return __builtin_bit_cast(unsigned, b); }

__device__ __forceinline__ float row_rstd(const float* ssq, int row) {
    const f32x4* sp = (const f32x4*)(ssq + (size_t)row * 16);
    const f32x4 a = sp[0], b = sp[1], c = sp[2], d = sp[3];
    const float s = ((a[0] + a[1]) + (a[2] + a[3])) + ((b[0] + b[1]) + (b[2] + b[3])) + ((c[0] + c[1]) + (c[2] + c[3])) + ((d[0] + d[1]) + (d[2] + d[3]));
    return 1.0f / sqrtf(s * (1.0f / 1024.0f) + 1e-6f);
}
struct EpiQKV {
    static constexpr bool PERM = true;
    bf16_t* O; int ldc; const PG8_LAS float* rtab; const float* rope; int ropeMod, ropeLim; unsigned char* vt8; unsigned char* o8; int hm;
    __device__ __forceinline__ void operator()(const f32x4 (&acc)[2][2][4][2], const Unit& u, int ui, int wr, int wc, int fr, int fq) const {
        const int row0 = u.pm * BM + wr * 64 + fr;
        const int colh = wc * 32 + 8 * fq;
        const bool ropelane = ((wc & 1) == 0) && (fq < 2);
        const PG8_LAS float* rt = rtab + ui * 256 + wr * 64 + fr;
#pragma unroll
        for (int ai = 0; ai < 2; ++ai) {
            f32x4 cs[4], sn[4]; float rs[4];
#pragma unroll
            for (int m = 0; m < 4; ++m) {
                rs[m] = rt[ai * HALF + m * 16];
                cs[m] = (f32x4){1.f, 1.f, 1.f, 1.f}; sn[m] = (f32x4){0.f, 0.f, 0.f, 0.f};
                if (ropelane) { const float* rp = rope + (size_t)(row0 + ai * HALF + m * 16) * 16 + 4 * fq; cs[m] = *(const f32x4*)rp; sn[m] = *(const f32x4*)(rp + 8); }
            }
#pragma unroll
            for (int m = 0; m < 4; ++m) {
                const int row = row0 + ai * HALF + m * 16;
                const float r_ = rs[m]; const f32x4 c_ = cs[m], s_ = sn[m];
#pragma unroll
                for (int bj = 0; bj < 2; ++bj) {
                    const int colbase = u.pc * BM + bj * HALF;
                    f32x4 v0 = acc[ai][bj][m][0] * r_, v1 = acc[ai][bj][m][1] * r_;
                    if (ropelane && (colbase % ropeMod) < ropeLim) {
                        f32x4 w0, w1;
                        w0[0] = v0[0] * c_[0] - v0[1] * s_[0]; w0[1] = v0[1] * c_[0] + v0[0] * s_[0];
                        w0[2] = v0[2] * c_[1] - v0[3] * s_[1]; w0[3] = v0[3] * c_[1] + v0[2] * s_[1];
                        w1[0] = v1[0] * c_[2] - v1[1] * s_[2]; w1[1] = v1[1] * c_[2] + v1[0] * s_[2];
                        w1[2] = v1[2] * c_[3] - v1[3] * s_[3]; w1[3] = v1[3] * c_[3] + v1[2] * s_[3];
                        v0 = w0; v1 = w1;
                    }
                    if (o8) {
                        const float qs = ((colbase % 3072) < 1024) ? 16.0f : 1.0f;
                        u32x2 w8; w8.x = pk_fp8x4(v0[0] * qs, v0[1] * qs, v0[2] * qs, v0[3] * qs); w8.y = pk_fp8x4(v1[0] * qs, v1[1] * qs, v1[2] * qs, v1[3] * qs);
                        size_t off = (size_t)row * ldc + colbase + colh;
                        if (hm) { const int col = colbase + colh, blk = col >> 10, sh = 2 * ((blk * 11) >> 5), head = (col & 1023) >> 6, bb = row >> 13, t = row & (SEQ - 1);
                            off = (size_t)blk * ((size_t)NTOK * 1024) + (size_t)((bb * 16 + head) * SEQ + ((t & ((1 << sh) - 1)) << (13 - sh)) + (t >> sh)) * 64 + (col & 63); }
                        *(u32x2*)(o8 + off) = w8;
                    } else if (vt8 && colbase >= 2048) {
                        u32x2 w8; w8.x = pk_fp8x4(v0[0], v0[1], v0[2], v0[3]); w8.y = pk_fp8x4(v1[0], v1[1], v1[2], v1[3]);
                        *(u32x2*)(vt8 + (size_t)row * 1024 + (colbase - 2048) + colh) = w8;
                    } else {
                    u32x4 w; w.x = cvt_pk_bf16(v0[0], v0[1]); w.y = cvt_pk_bf16(v0[2], v0[3]); w.z = cvt_pk_bf16(v1[0], v1[1]); w.w = cvt_pk_bf16(v1[2], v1[3]);
                    *(u32x4*)(O + (size_t)row * ldc + colbase + colh) = w;
                    }
                }
            }
        }
    }
};
struct EpiSwiGLU {
    static constexpr bool PERM = true;
    bf16_t* O; int ldc; const PG8_LAS float* rtab;
    __device__ __forceinline__ void operator()(const f32x4 (&acc)[2][2][4][2], const Unit& u, int ui, int wr, int wc, int fr, int fq) const {
        const int row0 = u.pm * BM + wr * 64 + fr;
        const int col = u.pc * HALF + wc * 32 + 8 * fq;
#pragma unroll
        for (int ai = 0; ai < 2; ++ai)
#pragma unroll
            for (int m = 0; m < 4; ++m) {
                const int row = row0 + ai * HALF + m * 16;
                const float rs = rtab ? rtab[ui * 256 + wr * 64 + fr + ai * HALF + m * 16] : 1.0f;
                float h[8];
#pragma unroll
                for (int n = 0; n < 2; ++n)
#pragma unroll
                    for (int i = 0; i < 4; ++i) {
                        const float a = acc[ai][0][m][n][i] * rs, b = acc[ai][1][m][n][i] * rs;
                        h[n * 4 + i] = a * __builtin_amdgcn_rcpf(1.0f + __expf(-a)) * b;
                    }
                u32x4 w; w.x = cvt_pk_bf16(h[0], h[1]); w.y = cvt_pk_bf16(h[2], h[3]); w.z = cvt_pk_bf16(h[4], h[5]); w.w = cvt_pk_bf16(h[6], h[7]);
                *(u32x4*)(O + (size_t)row * ldc + col) = w;
            }
    }
};
struct EpiSwiGLU8 {
    static constexpr bool PERM = true;
    unsigned char* O; int ldc;
    __device__ __forceinline__ void operator()(const f32x4 (&acc)[2][2][4][2], const Unit& u, int ui, int wr, int wc, int fr, int fq) const {
        const int row0 = u.pm * BM + wr * 64 + fr;
        const int col = u.pc * HALF + wc * 32 + 8 * fq;
#pragma unroll
        for (int ai = 0; ai < 2; ++ai)
#pragma unroll
            for (int m = 0; m < 4; ++m) {
                const int row = row0 + ai * HALF + m * 16;
                float h[8];
#pragma unroll
                for (int n = 0; n < 2; ++n)
#pragma unroll
                    for (int i = 0; i < 4; ++i) { const float a = acc[ai][0][m][n][i], b = acc[ai][1][m][n][i]; h[n * 4 + i] = a * __builtin_amdgcn_rcpf(1.0f + __expf(-a)) * b * H8_SCALE; }
                u32x2 w; w.x = pk_fp8x4(h[0], h[1], h[2], h[3]); w.y = pk_fp8x4(h[4], h[5], h[6], h[7]);
                *(u32x2*)(O + (size_t)row * ldc + col) = w;
            }
    }
};
struct EpiRes {
    static constexpr bool PERM = false;
    bf16_t* XB; float* ssq; int ldc; unsigned char* X8;
    __device__ __forceinline__ void operator()(const f32x4 (&acc)[2][2][4][2], const Unit& u, int ui, int wr, int wc, int fr, int fq) const {
        const int row0 = u.pm * BM + wr * 64 + fr;
        const int col0 = u.pc * BM + wc * 32 + 4 * fq;
#pragma unroll
        for (int ai = 0; ai < 2; ++ai) {
            u32x2 rv[4][2][2];
#pragma unroll
            for (int m = 0; m < 4; ++m)
#pragma unroll
                for (int bj = 0; bj < 2; ++bj)
#pragma unroll
                    for (int n = 0; n < 2; ++n) rv[m][bj][n] = *(const u32x2*)(XB + (size_t)(row0 + ai * HALF + m * 16) * ldc + col0 + bj * HALF + n * 16);
#pragma unroll
            for (int m = 0; m < 4; ++m) {
                const int row = row0 + ai * HALF + m * 16;
                float q = 0.f;
#pragma unroll
                for (int bj = 0; bj < 2; ++bj)
#pragma unroll
                    for (int n = 0; n < 2; ++n) {
                        const size_t off = (size_t)row * ldc + col0 + bj * HALF + n * 16;
                        const u32x2 rr = rv[m][bj][n]; const f32x4 a = acc[ai][bj][m][n];
                        const float v0 = bflo(rr.x) + a[0], v1 = bfhi(rr.x) + a[1], v2 = bflo(rr.y) + a[2], v3 = bfhi(rr.y) + a[3];
                        q += (v0 * v0 + v1 * v1) + (v2 * v2 + v3 * v3);
                        u32x2 w; w.x = cvt_pk_bf16(v0, v1); w.y = cvt_pk_bf16(v2, v3); *(u32x2*)(XB + off) = w;
                        if (X8) *(unsigned*)(X8 + off) = pk_fp8x4(v0, v1, v2, v3);
                    }
                q += __shfl_xor(q, 16); q += __shfl_xor(q, 32);
                if (fq == 0) ssq[(size_t)row * 16 + u.pc * 4 + wc] = q;
            }
        }
    }
};
struct EpiPlain {
    static constexpr bool PERM = true;
    bf16_t* O; int ldc;
    __device__ __forceinline__ void operator()(const f32x4 (&acc)[2][2][4][2], const Unit& u, int ui, int wr, int wc, int fr, int fq) const {
        const int row0 = u.pm * BM + wr * 64 + fr;
        const int col0 = u.pc * BM + wc * 32 + 8 * fq;
#pragma unroll
        for (int ai = 0; ai < 2; ++ai)
#pragma unroll
            for (int m = 0; m < 4; ++m) {
                bf16_t* rowp = O + (size_t)(row0 + ai * HALF + m * 16) * ldc + col0;
#pragma unroll
                for (int bj = 0; bj < 2; ++bj) {
                    const f32x4 v0 = acc[ai][bj][m][0], v1 = acc[ai][bj][m][1];
                    u32x4 w; w.x = cvt_pk_bf16(v0[0], v0[1]); w.y = cvt_pk_bf16(v0[2], v0[3]); w.z = cvt_pk_bf16(v1[0], v1[1]); w.w = cvt_pk_bf16(v1[2], v1[3]);
                    *(u32x4*)(rowp + bj * HALF) = w;
                }
            }
    }
};

struct EpiPlainK {
    static constexpr bool PERM = true;
    bf16_t* O; int ldc; float* part; int rtf, nsl;
    __device__ __forceinline__ void operator()(const f32x4 (&acc)[2][2][4][2], const Unit& u, int ui, int wr, int wc, int fr, int fq) const {
        if (u.mode == 0) {
            const int row0 = u.pm * BM + wr * 64 + fr; const int col0 = u.pc * BM + wc * 32 + 8 * fq;
#pragma unroll
            for (int ai = 0; ai < 2; ++ai)
#pragma unroll
                for (int m = 0; m < 4; ++m) {
                    bf16_t* rowp = O + (size_t)(row0 + ai * HALF + m * 16) * ldc + col0;
#pragma unroll
                    for (int bj = 0; bj < 2; ++bj) {
                        const f32x4 v0 = acc[ai][bj][m][0], v1 = acc[ai][bj][m][1];
                        u32x4 w; w.x = cvt_pk_bf16(v0[0], v0[1]); w.y = cvt_pk_bf16(v0[2], v0[3]); w.z = cvt_pk_bf16(v1[0], v1[1]); w.w = cvt_pk_bf16(v1[2], v1[3]);
                        *(u32x4*)(rowp + bj * HALF) = w;
                    }
                }
        } else {
            float* pb = part + (size_t)(((u.pm - rtf) * 4 + u.pc) * nsl + (u.mode - 1)) * 65536 + (size_t)(wr * 64 + fr) * 256 + wc * 32 + 8 * fq;
#pragma unroll
            for (int ai = 0; ai < 2; ++ai)
#pragma unroll
                for (int m = 0; m < 4; ++m)
#pragma unroll
                    for (int bj = 0; bj < 2; ++bj) { float* p = pb + (size_t)(ai * HALF + m * 16) * 256 + bj * HALF; *(f32x4*)p = acc[ai][bj][m][0]; *(f32x4*)(p + 4) = acc[ai][bj][m][1]; }
        }
    }
};

typedef int v8i_t __attribute__((ext_vector_type(8)));
typedef int v4i_t __attribute__((ext_vector_type(4)));
__device__ __forceinline__ v8i_t cat32(bf16x8 lo, bf16x8 hi) { const v4i_t a = __builtin_bit_cast(v4i_t, lo), b = __builtin_bit_cast(v4i_t, hi); return __builtin_shufflevector(a, b, 0, 1, 2, 3, 4, 5, 6, 7); }
template <class Epi, class Sched, bool FP8 = false>
__device__ __forceinline__ void gemm_phase(PG8_LAS unsigned char* lds, const Gemm g, const Sched& S, const Epi& E) {
    const int tid = threadIdx.x, wid = __builtin_amdgcn_readfirstlane(tid >> 6), lane = tid & 63, wr = wid >> 2, wc = wid & 3, fr = lane & 15, fq = lane >> 4;
    const int sw_ = g.sw, sx_ = g.sx;
    const int K = g.ld ? g.ld : g.K, ntd = g.K / BK;
    unsigned voffA[2], voffB[2];
#pragma unroll
    for (int i = 0; i < 2; ++i) { int R, C; stage_rc(tid * 16 + i * 8192, R, C); const int Rb = Epi::PERM ? ((R & ~31) + perm32(R & 31)) : R;
        voffA[i] = (unsigned)(R * K + C) * 2u; voffB[i] = (unsigned)(Rb * K + C) * 2u; }
    const size_t kstep = (size_t)(BK * 2);
    const size_t hstep = (size_t)HALF * K * 2;
    const size_t tstep = 2 * hstep;
    const unsigned ldsw = (unsigned)wid * 1024u; const unsigned ldsb = (unsigned)(uintptr_t)lds;
    const int aoff = lds_byte(wr * 64 + fr, fq * 8), boff = lds_byte(wc * 32 + fr, fq * 8);
#define PG8_SA(b, h) (((b) * 2 + (h)) * HTB)
#define PG8_SB(b, h) ((4 + (b) * 2 + (h)) * HTB)
#define PG8_STAGE(bufoff, gbase, voff) do { _Pragma("unroll") for (int _i = 0; _i < 2; ++_i) { \
        if constexpr (FP8) glds16s((voff)[_i], (unsigned long long)(gbase), (unsigned)__builtin_amdgcn_readfirstlane((int)(ldsb + (bufoff) + ldsw + _i * 8192))); \
        else __builtin_amdgcn_global_load_lds((const unsigned*)((const char*)(gbase) + (voff)[_i]), (PG8_LAS unsigned*)(lds + (bufoff) + ldsw + _i * 8192), 16, 0, 0); } } while (0)
#define PG8_LDA(dst, b, h) do { if constexpr (FP8) { _Pragma("unroll") for (int m = 0; m < 4; ++m) dst##8[m] = __builtin_shufflevector(*(const PG8_LAS v4i_t*)(lds + PG8_SA(b, h) + aoff + m * 2048), *(const PG8_LAS v4i_t*)(lds + PG8_SA(b, h) + aoff + m * 2048 + 1024), 0, 1, 2, 3, 4, 5, 6, 7); } \
        else { _Pragma("unroll") for (int m = 0; m < 4; ++m) _Pragma("unroll") for (int k = 0; k < 2; ++k) dst[m][k] = *(const PG8_LAS bf16x8*)(lds + PG8_SA(b, h) + aoff + m * 2048 + k * 1024); } } while (0)
#define PG8_LDB(dst, b, h) do { if constexpr (FP8) { _Pragma("unroll") for (int n = 0; n < 2; ++n) dst##8[n] = __builtin_shufflevector(*(const PG8_LAS v4i_t*)(lds + PG8_SB(b, h) + boff + n * 2048), *(const PG8_LAS v4i_t*)(lds + PG8_SB(b, h) + boff + n * 2048 + 1024), 0, 1, 2, 3, 4, 5, 6, 7); } \
        else { _Pragma("unroll") for (int n = 0; n < 2; ++n) _Pragma("unroll") for (int k = 0; k < 2; ++k) dst[n][k] = *(const PG8_LAS bf16x8*)(lds + PG8_SB(b, h) + boff + n * 2048 + k * 1024); } } while (0)
#define PG8_MMA(ai, bj, At, Bt) do { __builtin_amdgcn_s_setprio(1); \
        if constexpr (FP8) { _Pragma("unroll") for (int m = 0; m < 4; ++m) _Pragma("unroll") for (int n = 0; n < 2; ++n) \
            asm volatile("v_mfma_scale_f32_16x16x128_f8f6f4 %0, %1, %2, %0, %3, %4 op_sel_hi:[0,0,0]" : "+v"(acc[ai][bj][m][n]) : "v"(Bt##8[n]), "v"(At##8[m]), "v"(sw_), "v"(sx_)); } \
        else { _Pragma("unroll") for (int m = 0; m < 4; ++m) _Pragma("unroll") for (int n = 0; n < 2; ++n) _Pragma("unroll") for (int k = 0; k < 2; ++k) acc[ai][bj][m][n] = __builtin_amdgcn_mfma_f32_16x16x32_bf16(Bt[n][k], At[m][k], acc[ai][bj][m][n], 0, 0, 0); } \
        __builtin_amdgcn_s_setprio(0); } while (0)
#define PG8_WAIT_V(n) asm volatile("s_waitcnt vmcnt(" #n ")" ::: "memory")
#define PG8_WAIT_L(n) asm volatile("s_waitcnt lgkmcnt(" #n ")" ::: "memory")
#define PG8_BAR __builtin_amdgcn_s_barrier()
#define PG8_SCHED __builtin_amdgcn_sched_barrier(0)
    Unit cur, nxt; int ui = 0;
    if (!S.next(0, cur)) return;
    f32x4 acc[2][2][4][2];
#pragma unroll
    for (int a = 0; a < 2; ++a)
#pragma unroll
        for (int b = 0; b < 2; ++b)
#pragma unroll
            for (int m = 0; m < 4; ++m)
#pragma unroll
                for (int n = 0; n < 2; ++n) acc[a][b][m][n] = (f32x4){0.f, 0.f, 0.f, 0.f};
    bf16x8 At[4][2], B0[2][2], B1[2][2]; v8i_t At8[4], B08[2], B18[2];
    const char* cA = (const char*)g.A + (size_t)cur.pm * tstep + cur.koff; const char* cB = (const char*)g.Bt + (size_t)cur.pn * tstep + cur.koff;
    PG8_STAGE(PG8_SB(0, 0), cB, voffB); PG8_STAGE(PG8_SB(0, 1), cB + hstep, voffB); PG8_STAGE(PG8_SA(0, 0), cA, voffA); PG8_STAGE(PG8_SA(0, 1), cA + hstep, voffA);
    if (wr == 1) PG8_BAR;
    PG8_WAIT_V(2); PG8_BAR;
    PG8_STAGE(PG8_SB(1, 0), cB + kstep, voffB); PG8_STAGE(PG8_SA(1, 0), cA + kstep, voffA); PG8_STAGE(PG8_SB(1, 1), cB + hstep + kstep, voffB);
    PG8_WAIT_V(6); PG8_BAR;
    for (;;) {
        const bool has_next = S.next(ui + 1, nxt);
        const char* nA = has_next ? (const char*)g.A + (size_t)nxt.pm * tstep + nxt.koff : cA; const char* nB = has_next ? (const char*)g.Bt + (size_t)nxt.pn * tstep + nxt.koff : cB;
        const int nt = cur.nt ? cur.nt : ntd;
#pragma nounroll
        for (int t = 0; t < nt; t += 2) {
            const bool last = (t == nt - 2);
            const char* a1 = cA + (size_t)(t + 1) * kstep;
            const char* a2 = last ? nA : cA + (size_t)(t + 2) * kstep; const char* b2 = last ? nB : cB + (size_t)(t + 2) * kstep;
            const char* a3 = a2 + kstep; const char* b3 = b2 + kstep;
            PG8_LDB(B0, 0, 0); PG8_LDB(B1, 0, 1); PG8_SCHED; PG8_LDA(At, 0, 0); PG8_STAGE(PG8_SA(1, 1), a1 + hstep, voffA);
            PG8_WAIT_V(8); PG8_WAIT_L(0); PG8_BAR; PG8_MMA(0, 0, At, B0); PG8_MMA(0, 1, At, B1); PG8_BAR; PG8_SCHED;
            PG8_LDA(At, 0, 1); PG8_STAGE(PG8_SB(0, 0), b2, voffB); PG8_STAGE(PG8_SB(0, 1), b2 + hstep, voffB); PG8_STAGE(PG8_SA(0, 0), a2, voffA);
            PG8_WAIT_V(8); PG8_WAIT_L(0); PG8_BAR; PG8_MMA(1, 0, At, B0); PG8_MMA(1, 1, At, B1); PG8_BAR; PG8_SCHED;
            PG8_LDB(B0, 1, 0); PG8_LDB(B1, 1, 1); PG8_SCHED; PG8_LDA(At, 1, 0); PG8_STAGE(PG8_SA(0, 1), a2 + hstep, voffA);
            PG8_WAIT_V(8); PG8_WAIT_L(0); PG8_BAR; PG8_MMA(0, 0, At, B0); PG8_MMA(0, 1, At, B1); PG8_BAR; PG8_SCHED;
            PG8_LDA(At, 1, 1); PG8_STAGE(PG8_SB(1, 0), b3, voffB); PG8_STAGE(PG8_SB(1, 1), b3 + hstep, voffB); PG8_STAGE(PG8_SA(1, 0), a3, voffA);
            PG8_WAIT_V(8); PG8_WAIT_L(0); PG8_BAR; PG8_MMA(1, 0, At, B0); PG8_MMA(1, 1, At, B1); PG8_BAR; PG8_SCHED;
        }
        if (wr == 0) PG8_BAR;
        if constexpr (FP8) asm volatile("s_nop 15\n\ts_nop 15" ::: "memory");
        { int le_ = lane; asm volatile("" : "+v"(le_)); E(acc, cur, ui, wr, wc, le_ & 15, le_ >> 4); }
        if (!has_next) break;
#pragma unroll
        for (int a = 0; a < 2; ++a)
#pragma unroll
            for (int b = 0; b < 2; ++b)
#pragma unroll
                for (int m = 0; m < 4; ++m)
#pragma unroll
                    for (int n = 0; n < 2; ++n) acc[a][b][m][n] = (f32x4){0.f, 0.f, 0.f, 0.f};
        cur = nxt; cA = nA; cB = nB; ++ui;
        if (wr == 1) PG8_BAR;
    }
    PG8_WAIT_V(0);
    PG8_BAR;
#undef PG8_SA
#undef PG8_SB
#undef PG8_STAGE
#undef PG8_LDA
#undef PG8_LDB
#undef PG8_MMA
#undef PG8_WAIT_V
#undef PG8_WAIT_L
#undef PG8_BAR
#undef PG8_SCHED
}
}

#define XB_TMO      128
#define XB_XCNT(j)  (256  + 64 * (j))
#define XB_XSUB(j)  (1280 + 64 * (j))
#define XB_XGEN(j)  (2304 + 64 * (j))
#define XB_TOP      3328
#define XB_TOPGEN   3392
#define XCD_BAR_WORDS 3456
#define XB_SPIN_CAP (1u << 24)

__device__ __forceinline__ unsigned xb_ld(unsigned* p)              { return __hip_atomic_load(p, __ATOMIC_RELAXED, __HIP_MEMORY_SCOPE_AGENT); }
__device__ __forceinline__ unsigned xb_add(unsigned* p, unsigned v) { return __hip_atomic_fetch_add(p, v, __ATOMIC_RELAXED, __HIP_MEMORY_SCOPE_AGENT); }
__device__ __forceinline__ unsigned xb_xcc_id() { return (unsigned)__builtin_amdgcn_s_getreg((3 << 11) | 20) & 0xFu; }
#define XB_SPIN(cond, bar) do { unsigned _sp = 0; while (cond) { __builtin_amdgcn_s_sleep(1); \
    if ((++_sp & 255u) == 0u) { if (xb_ld(&(bar)[XB_TMO])) break; if (_sp > XB_SPIN_CAP) { atomicAdd(&(bar)[XB_TMO], 1u); break; } } } } while (0)

struct XcdBarrier { unsigned* bar; unsigned x; volatile LAS unsigned* st; };

__device__ __forceinline__ XcdBarrier xcd_barrier_post(unsigned* bar, volatile LAS unsigned* st) {
    XcdBarrier b; b.bar = bar; b.x = xb_xcc_id(); b.st = st;
    if (threadIdx.x == 0) (void)xb_add(&bar[XB_XCNT(b.x)], 1u);
    return b;
}
__device__ __forceinline__ void xcd_barrier_complete(unsigned* bar, unsigned x, unsigned& nloc, unsigned& nx) {
    const unsigned G = gridDim.x * gridDim.y * gridDim.z;
    unsigned sum, cnt, mine, sp = 0u;
    for (;;) {
        sum = 0u; cnt = 0u; mine = 0u;
#pragma unroll
        for (unsigned j = 0; j < 16; ++j) { const unsigned c = xb_ld(&bar[XB_XCNT(j)]); sum += c; cnt += (c > 0u) ? 1u : 0u; mine = (j == x) ? c : mine; }
        if (sum == G) break;
        __builtin_amdgcn_s_sleep(1);
        if ((++sp & 255u) == 0u) { if (xb_ld(&bar[XB_TMO])) break; if (sp > XB_SPIN_CAP) { atomicAdd(&bar[XB_TMO], 1u); break; } }
    }
    nloc = mine > 0u ? mine : 1u; nx = cnt > 0u ? cnt : 1u;
}
__device__ __forceinline__ void xcd_barrier(const XcdBarrier& b) {
    asm volatile("s_waitcnt vmcnt(0)" ::: "memory");
    __syncthreads();
    if (threadIdx.x == 0) {
        unsigned* bar = b.bar;
        __builtin_amdgcn_s_waitcnt(0);
        unsigned nloc = b.st[0], nx = b.st[1];
        if (nloc == 0u) { xcd_barrier_complete(bar, b.x, nloc, nx); b.st[0] = nloc; b.st[1] = nx; }
        const unsigned old = xb_add(&bar[XB_XSUB(b.x)], 1u);
        const unsigned gen = old / nloc;
        if (old + 1u == (gen + 1u) * nloc) {
            __builtin_amdgcn_fence(__ATOMIC_RELEASE, "agent");
            asm volatile("s_waitcnt vmcnt(0)" ::: "memory");
            const unsigned og = xb_add(&bar[XB_TOP], 1u);
            const unsigned tg = og / nx;
            if (og + 1u == (tg + 1u) * nx) xb_add(&bar[XB_TOPGEN], 1u);
            else XB_SPIN(xb_ld(&bar[XB_TOPGEN]) == tg, bar);
            __builtin_amdgcn_fence(__ATOMIC_ACQUIRE, "agent");
            xb_add(&bar[XB_XGEN(b.x)], 1u);
            asm volatile("s_waitcnt vmcnt(0)" ::: "memory");
        } else {
            XB_SPIN(xb_ld(&bar[XB_XGEN(b.x)]) == gen, bar);
            __builtin_amdgcn_fence(__ATOMIC_ACQUIRE, "agent");
            asm volatile("s_waitcnt vmcnt(0)" ::: "memory");
        }
    }
    __syncthreads();
}

struct Ctx {
    LAS unsigned char* lds;
    unsigned char* ws;
    const void* const* in;
    float* out;
    int tid, lane, wave, G, bid;
};
#define IN_F(i) ((const float*)C.in[i])
#define WSP(T, off) ((T*)(C.ws + (off)))

struct WJob { const float* W0; const float* W1; bf16_t* WT; const float* gain; int K, ldw, Nout, kind, nE, fp8; size_t sW, sWT; };
__device__ __forceinline__ int permsrc(int j) { return j < 16 ? ((j >> 1) + 8 * (j & 1)) : j; }
__device__ __forceinline__ void map_col(int kind, int np, int& src, int& which, float& scale) {
    which = 0; scale = 1.f; src = np;
    if (kind == 1) { const int blk = (np >> 10) % 3; const int hd = np & 63; if (blk < 2) src = np - hd + permsrc(hd); if (blk == 0) scale = C2; }
    else if (kind == 3) { const int hd = np & 63; if (np < 1152) src = np - hd + permsrc(hd); if (np < 1024) scale = C2; }
    else if (kind == 4) { const int tile = np >> 8, w = np & 255; src = tile * 128 + (w & 127); which = w >> 7; }
}
struct TItem { const float* src; float scale; int e, k0, n0; };
__device__ __forceinline__ TItem titem(const WJob& J, int item, int lane) {
    TItem T; const int nblk = J.Nout / 32, per = (J.K / 64) * nblk;
    T.e = item / per; const int r = item % per, kb = r / nblk, nb = r % nblk; T.k0 = 64 * kb; T.n0 = 32 * nb;
    int src, which; map_col(J.kind, T.n0 + (lane & 31), src, which, T.scale);
    const unsigned long long a0_ = (unsigned long long)J.W0, a1_ = (unsigned long long)(J.W1 ? J.W1 : J.W0);
    T.src = (const float*)(a0_ + (a1_ - a0_) * (unsigned long long)which) + (size_t)T.e * J.sW + (size_t)(T.k0 + (lane >> 5)) * J.ldw + src;
    return T;
}
__device__ __forceinline__ void tload(const WJob& J, const TItem& T, float (&v)[32]) {
#pragma unroll
    for (int i = 0; i < 32; ++i) v[i] = __builtin_nontemporal_load(T.src + (size_t)(2 * i) * J.ldw);
}
__device__ __forceinline__ void tstore(const WJob& J, const TItem& T, const float (&v)[32], LAS float* scr, int lane) {
#pragma unroll
    for (int i = 0; i < 32; ++i) scr[(2 * i + (lane >> 5)) * 33 + (lane & 31)] = v[i] * T.scale;
    LDS_WAIT(); asm volatile("" ::: "memory");
    const int c = lane & 7;
    f32x4 g0 = (f32x4){1.f, 1.f, 1.f, 1.f}, g1 = g0;
    if (J.gain) { g0 = *(const f32x4*)(J.gain + T.k0 + 8 * c); g1 = *(const f32x4*)(J.gain + T.k0 + 8 * c + 4); }
    if (J.fp8) {
        unsigned char* WT8 = (unsigned char*)J.WT + (size_t)T.e * J.sWT;
        g0 = g0 * W8_SCALE; g1 = g1 * W8_SCALE;
#pragma unroll
        for (int j = 0; j < 4; ++j) { const int n = (lane >> 3) + 8 * j; const LAS float* s = scr + (8 * c) * 33 + n;
            u32x2 o; o.x = pk_fp8x4(s[0 * 33] * g0[0], s[1 * 33] * g0[1], s[2 * 33] * g0[2], s[3 * 33] * g0[3]); o.y = pk_fp8x4(s[4 * 33] * g1[0], s[5 * 33] * g1[1], s[6 * 33] * g1[2], s[7 * 33] * g1[3]);
            *(u32x2*)(WT8 + (size_t)(T.n0 + n) * J.K + T.k0 + 8 * c) = o; }
    } else {
    bf16_t* WT = J.WT + (size_t)T.e * J.sWT;
#pragma unroll
    for (int j = 0; j < 4; ++j) { const int n = (lane >> 3) + 8 * j; const LAS float* s = scr + (8 * c) * 33 + n;
        u32x4 o; o.x = pk2(s[0 * 33] * g0[0], s[1 * 33] * g0[1]); o.y = pk2(s[2 * 33] * g0[2], s[3 * 33] * g0[3]); o.z = pk2(s[4 * 33] * g1[0], s[5 * 33] * g1[1]); o.w = pk2(s[6 * 33] * g1[2], s[7 * 33] * g1[3]);
        *(u32x4*)(WT + (size_t)(T.n0 + n) * J.K + T.k0 + 8 * c) = o; }
    }
    LDS_WAIT(); asm volatile("" ::: "memory");
}
__device__ __forceinline__ WJob make_job(const Ctx& C, int j) {
    WJob J; J.W1 = nullptr; J.gain = nullptr; J.nE = 1; J.sW = 0; J.sWT = 0; J.kind = 0; J.fp8 = (j == 0 || j == 12 || j == 6 || j == 7 || j >= 14 || j == 1 || j == 9 || j == 13) ? 1 : 0;
    switch (j) {
    case 0:  J.W0 = IN_F(3);  J.WT = WSP(bf16_t, WS_WQKV0); J.gain = IN_F(2);  J.K = 1024; J.ldw = 9216; J.Nout = 9216; J.kind = 1; break;
    case 1:  J.W0 = IN_F(4);  J.WT = WSP(bf16_t, WS_WO0);   J.K = 1024; J.ldw = 1024; J.Nout = 1024; break;
    case 2:  J.W0 = IN_F(6);  J.W1 = IN_F(7); J.WT = WSP(bf16_t, WS_W13_0); J.gain = IN_F(5); J.K = 1024; J.ldw = FF; J.Nout = 2 * FF; J.kind = 4; break;
    case 3:  J.W0 = IN_F(8);  J.WT = WSP(bf16_t, WS_W2_0);  J.K = FF; J.ldw = 1024; J.Nout = 1024; break;
    case 4:  J.W0 = IN_F(10); J.WT = WSP(bf16_t, WS_WQKV1); J.gain = IN_F(9);  J.K = 1024; J.ldw = 3072; J.Nout = 3072; J.kind = 1; break;
    case 5:  J.W0 = IN_F(16); J.WT = WSP(bf16_t, WS_WO1);   J.K = 1024; J.ldw = 1024; J.Nout = 1024; break;
    case 6:  J.W0 = IN_F(19); J.W1 = IN_F(20); J.WT = WSP(bf16_t, WS_WM13); J.gain = IN_F(17); J.K = 1024; J.ldw = FFE; J.Nout = 2 * FFE; J.kind = 4; J.nE = 8; J.sW = (size_t)1024 * FFE; J.sWT = (size_t)2 * FFE * 1024; break;
    case 7:  J.W0 = IN_F(21); J.WT = WSP(bf16_t, WS_WM2);   J.K = FFE; J.ldw = 1024; J.Nout = 1024; J.nE = 8; J.sW = (size_t)FFE * 1024; J.sWT = (size_t)1024 * FFE; break;
    case 8:  J.W0 = IN_F(23); J.WT = WSP(bf16_t, WS_WQKV2); J.gain = IN_F(22); J.K = 1024; J.ldw = 1280; J.Nout = 1280; J.kind = 3; break;
    case 9:  J.W0 = IN_F(25); J.WT = WSP(bf16_t, WS_WO2);   J.K = 1024; J.ldw = 1024; J.Nout = 1024; break;
    case 10: J.W0 = IN_F(27); J.W1 = IN_F(28); J.WT = WSP(bf16_t, WS_W13_2); J.gain = IN_F(26); J.K = 1024; J.ldw = FF; J.Nout = 2 * FF; J.kind = 4; break;
    case 11: J.W0 = IN_F(29); J.WT = WSP(bf16_t, WS_W2_2);  J.K = FF; J.ldw = 1024; J.Nout = 1024; break;
    case 12: J.W0 = IN_F(31); J.WT = WSP(bf16_t, WS_WQKV3); J.gain = IN_F(30); J.K = 1024; J.ldw = 9216; J.Nout = 9216; J.kind = 1; break;
    case 13: J.W0 = IN_F(32); J.WT = WSP(bf16_t, WS_WO3);   J.K = 1024; J.ldw = 1024; J.Nout = 1024; break;
    case 14: J.W0 = IN_F(35); J.W1 = IN_F(36); J.WT = WSP(bf16_t, WS_WM13); J.gain = IN_F(33); J.K = 1024; J.ldw = FFE; J.Nout = 2 * FFE; J.kind = 4; J.nE = 8; J.sW = (size_t)1024 * FFE; J.sWT = (size_t)2 * FFE * 1024; break;
    default: J.W0 = IN_F(37); J.WT = WSP(bf16_t, WS_WM2);   J.K = FFE; J.ldw = 1024; J.Nout = 1024; J.nE = 8; J.sW = (size_t)FFE * 1024; J.sWT = (size_t)1024 * FFE; break;
    }
    return J;
}
template <int j>
__device__ __forceinline__ void convert_one(const Ctx& C) {
    LAS float* scr = (LAS float*)(C.lds + C.wave * 16384);
    const int gw = C.bid * 8 + C.wave, NGW = C.G * 8;
    const WJob J = make_job(C, j);
    const int nitems = J.nE * (J.K / 64) * (J.Nout / 32);
    if (gw >= nitems) return;
    TItem T = titem(J, gw, C.lane); float v[32]; tload(J, T, v);
    for (int it = gw; it < nitems; it += NGW) {
        const int nx = it + NGW; TItem Tn = T; float w[32];
        if (nx < nitems) { Tn = titem(J, nx, C.lane); tload(J, Tn, w); }
        tstore(J, T, v, scr, C.lane);
        if (nx < nitems) { T = Tn;
#pragma unroll
            for (int i = 0; i < 32; ++i) v[i] = w[i]; }
    }
}
__device__ __forceinline__ void convert_weights_first(const Ctx& C) {
    convert_one<0>(C); convert_one<1>(C); convert_one<2>(C); convert_one<3>(C); convert_one<4>(C); convert_one<5>(C); convert_one<6>(C);
    convert_one<7>(C); convert_one<8>(C); convert_one<9>(C); convert_one<10>(C); convert_one<11>(C); convert_one<12>(C); convert_one<13>(C);
}
__device__ __forceinline__ void convert_weights_second(const Ctx& C) { convert_one<14>(C); convert_one<15>(C); }
__device__ __forceinline__ void rope_table(const Ctx& C) {
    const int* pos = (const int*)C.in[1];
    float* tab = WSP(float, WS_ROPE);
    for (int i = C.bid * 512 + C.tid; i < NTOK * 8; i += C.G * 512) {
        const int tok = i >> 3, f = i & 7;
        const float inv = powf(500000.0f, -(float)f * 0.125f);
        const float ang = (float)pos[tok] * inv;
        const double a = (double)ang;
        const double k = rint(a * 0.15915494309189535);
        const float r = (float)(a - k * 6.283185307179586);
        tab[(size_t)tok * 16 + f] = cosf(r); tab[(size_t)tok * 16 + 8 + f] = sinf(r);
    }
}
__device__ __forceinline__ void write_ssq_row(float* ssq, int row, float tot, int lane) { if (lane < 16) ssq[(size_t)row * 16 + lane] = (lane == 0) ? tot : 0.f; }
__device__ __forceinline__ void x_to_bf16(const Ctx& C) {
    const float* x = IN_F(0); bf16_t* xb = WSP(bf16_t, WS_XB); float* ssq = WSP(float, WS_SSQ); unsigned char* x8 = WSP(unsigned char, WS_X8);
    const int gw = C.bid * 8 + C.wave, NGW = C.G * 8;
    for (int m = gw; m < NTOK; m += NGW) {
        const f32x4* xr = (const f32x4*)(x + (size_t)m * DM) + C.lane; u32x2* o = (u32x2*)(xb + (size_t)m * DM) + C.lane; unsigned* o8 = (unsigned*)(x8 + (size_t)m * DM) + C.lane;
        float s = 0.f;
#pragma unroll
        for (int j = 0; j < 4; ++j) { const f32x4 v = xr[64 * j]; s += (v[0] * v[0] + v[1] * v[1]) + (v[2] * v[2] + v[3] * v[3]); u32x2 w; w.x = pk2(v[0], v[1]); w.y = pk2(v[2], v[3]); o[64 * j] = w; o8[64 * j] = pk_fp8x4(v[0], v[1], v[2], v[3]); }
        write_ssq_row(ssq, m, wave_sum(s), C.lane);
    }
}

__device__ __forceinline__ void load_q64(const bf16_t* qp, float (&q)[64]) {
#pragma unroll
    for (int c = 0; c < 8; ++c) { const u32x4 w = *(const u32x4*)(qp + 8 * c);
        q[8 * c + 0] = bflo(w.x); q[8 * c + 1] = bfhi(w.x); q[8 * c + 2] = bflo(w.y); q[8 * c + 3] = bfhi(w.y); q[8 * c + 4] = bflo(w.z); q[8 * c + 5] = bfhi(w.z); q[8 * c + 6] = bflo(w.w); q[8 * c + 7] = bfhi(w.w); }
}
__device__ __forceinline__ float dot64(const float (&q)[64], const bf16_t* kp) {
    float s = 0.f;
#pragma unroll
    for (int c = 0; c < 8; ++c) { const u32x4 w = *(const u32x4*)(kp + 8 * c);
        s += q[8 * c + 0] * bflo(w.x); s += q[8 * c + 1] * bfhi(w.x); s += q[8 * c + 2] * bflo(w.y); s += q[8 * c + 3] * bfhi(w.y);
        s += q[8 * c + 4] * bflo(w.z); s += q[8 * c + 5] * bfhi(w.z); s += q[8 * c + 6] * bflo(w.w); s += q[8 * c + 7] * bfhi(w.w); }
    return s;
}
__device__ __forceinline__ void naive_band(const bf16_t* qp, const bf16_t* K, const bf16_t* V, size_t kstride, int jlo, int jhi, float m0, float l0, int lane, float& o_out, float& m_out, float& l_out) {
    float q[64]; load_q64(qp, q);
    float m = m0, l = l0, o = 0.f;
    for (int j0 = jlo; j0 <= jhi; j0 += 64) {
        const int j = j0 + lane; const bool valid = j <= jhi; const int jj = valid ? j : jhi;
        float s = dot64(q, K + (size_t)jj * kstride); if (!valid) s = -INFINITY;
        const float mn = fmaxf(m, wave_max(s)); const float alpha = exp2f(m - mn); const float p = exp2f(s - mn);
        l = l * alpha + wave_sum(p); o *= alpha; m = mn;
        const int cnt = (jhi - j0 + 1) < 64 ? (jhi - j0 + 1) : 64;
        for (int t = 0; t < cnt; ++t) { const float pj = __shfl(p, t); o += pj * bf2f(V[(size_t)(j0 + t) * kstride + lane]); }
    }
    o_out = o; m_out = m; l_out = l;
}
__device__ __forceinline__ void naive_attn_A(const Ctx& C) {
    const bf16_t* QKV = WSP(bf16_t, WS_BIG + BIG_QKV); bf16_t* OG = WSP(bf16_t, WS_BIG + BIG_OG); float* LSE = WSP(float, WS_LSE);
    const int gw = C.bid * 8 + C.wave, NGW = C.G * 8;
    for (int it = gw; it < NTOK * 16 * 3; it += NGW) {
        const int gi = it % 3, h = (it / 3) % 16, tok = it / 48;
        const int dil = gi == 0 ? 1 : (gi == 1 ? 4 : 16);
        const int b = tok / SEQ, s = tok % SEQ, r = s % dil, i = s / dil, L = SEQ / dil;
        const int jlo = i - 64 < 0 ? 0 : i - 64, jhi = i + 64 > L - 1 ? L - 1 : i + 64;
        const bf16_t* base = QKV + (size_t)(b * SEQ + r) * NQKV_A + gi * 3072 + h * 64;
        float o, m, l;
        naive_band(QKV + (size_t)tok * NQKV_A + gi * 3072 + h * 64, base + 1024, base + 2048, (size_t)dil * NQKV_A, jlo, jhi, -1e30f, 0.f, C.lane, o, m, l);
        OG[((size_t)gi * NTOK + tok) * DM + h * 64 + C.lane] = (bf16_t)f2bf(o / l);
        if (C.lane == 0) LSE[((size_t)gi * NTOK + tok) * 16 + h] = m + log2f(l);
    }
}
__device__ __forceinline__ void naive_attn_C(const Ctx& C) {
    const bf16_t* QKV = WSP(bf16_t, WS_BIG + BIG_QKV); bf16_t* O = WSP(bf16_t, WS_O); const float* sink = IN_F(24);
    const int gw = C.bid * 8 + C.wave, NGW = C.G * 8;
    for (int it = gw; it < NTOK * 16; it += NGW) {
        const int h = it % 16, tok = it / 16, g = h / 8;
        const int b = tok / SEQ, s = tok % SEQ;
        const int jlo = s - 128 < 0 ? 0 : s - 128, jhi = s + 128 > SEQ - 1 ? SEQ - 1 : s + 128;
        const bf16_t* base = QKV + (size_t)(b * SEQ) * NQKV_C;
        float o, m, l;
        naive_band(QKV + (size_t)tok * NQKV_C + h * 64, base + 1024 + g * 64, base + 1152 + g * 64, (size_t)NQKV_C, jlo, jhi, sink[h] * LOG2E, 1.f, C.lane, o, m, l);
        O[(size_t)tok * DM + h * 64 + C.lane] = (bf16_t)f2bf(o / l);
    }
}
__device__ __forceinline__ float diff_lambda(const Ctx& C) {
    const float a = IN_F(11)[C.lane] * IN_F(12)[C.lane], b = IN_F(13)[C.lane] * IN_F(14)[C.lane];
    return expf(wave_sum(a)) - expf(wave_sum(b)) + LAMBDA_INIT;
}
__device__ __forceinline__ void naive_attn_B(const Ctx& C) {
    const bf16_t* QKV = WSP(bf16_t, WS_BIG + BIG_QKV); bf16_t* O = WSP(bf16_t, WS_O); const float* subln = IN_F(15);
    const float lam = diff_lambda(C);
    const int gw = C.bid * 8 + C.wave, NGW = C.G * 8, lane = C.lane;
    for (int it = gw; it < NTOK * 8; it += NGW) {
        const int h = it % 8, tok = it / 8, b = tok / SEQ;
        float q0[64], q1[64]; load_q64(QKV + (size_t)tok * NQKV_B + (2 * h) * 64, q0); load_q64(QKV + (size_t)tok * NQKV_B + (2 * h + 1) * 64, q1);
        const bf16_t* Kb = QKV + (size_t)(b * SEQ) * NQKV_B + 1024 + (2 * h) * 64; const bf16_t* Vb = QKV + (size_t)(b * SEQ) * NQKV_B + 2048 + h * 128;
        float m0 = -1e30f, l0 = 0.f, m1 = -1e30f, l1 = 0.f, oa0 = 0.f, ob0 = 0.f, oa1 = 0.f, ob1 = 0.f;
        for (int j0 = 0; j0 < SEQ; j0 += 64) {
            const bf16_t* kr = Kb + (size_t)(j0 + lane) * NQKV_B;
            const float s0 = dot64(q0, kr), s1 = dot64(q1, kr + 64);
            const float mn0 = fmaxf(m0, wave_max(s0)), mn1 = fmaxf(m1, wave_max(s1));
            const float a0 = exp2f(m0 - mn0), a1 = exp2f(m1 - mn1), p0 = exp2f(s0 - mn0), p1 = exp2f(s1 - mn1);
            l0 = l0 * a0 + wave_sum(p0); l1 = l1 * a1 + wave_sum(p1); oa0 *= a0; ob0 *= a0; oa1 *= a1; ob1 *= a1; m0 = mn0; m1 = mn1;
#pragma unroll 8
            for (int t = 0; t < 64; ++t) {
                const bf16_t* vr = Vb + (size_t)(j0 + t) * NQKV_B;
                const float va = bf2f(vr[lane]), vb = bf2f(vr[lane + 64]);
                const float pa = __shfl(p0, t), pb = __shfl(p1, t);
                oa0 += pa * va; ob0 += pa * vb; oa1 += pb * va; ob1 += pb * vb;
            }
        }
        const float f0 = 1.0f / l0, f1 = lam / l1;
        const float ya = oa0 * f0 - oa1 * f1, yb = ob0 * f0 - ob1 * f1;
        const float ms = wave_sum(ya * ya + yb * yb) * (1.0f / 128.0f);
        const float rs = (1.0f / sqrtf(ms + SUBLN_EPS)) * (1.0f - LAMBDA_INIT);
        O[(size_t)tok * DM + h * 128 + lane] = (bf16_t)f2bf(ya * rs * subln[lane]);
        O[(size_t)tok * DM + h * 128 + 64 + lane] = (bf16_t)f2bf(yb * rs * subln[lane + 64]);
    }
}

namespace att {
typedef float f32x16 __attribute__((ext_vector_type(16)));
typedef short s16x4 __attribute__((ext_vector_type(4)));
typedef short v4i16_t __attribute__((ext_vector_type(4)));
typedef __bf16 bf16x2_t __attribute__((ext_vector_type(2)));
#define ADI __device__ __forceinline__
#define MFMA32(a, b, c) __builtin_amdgcn_mfma_f32_32x32x16_bf16((a), (b), (c), 0, 0, 0)
ADI int crow(int i, int hh) { return (i & 3) + 8 * (i >> 2) + 4 * hh; }
ADI float hmax(float v) { auto rr = __builtin_amdgcn_permlane32_swap(__float_as_uint(v), __float_as_uint(v), false, false); return fmaxf(__uint_as_float(rr[0]), __uint_as_float(rr[1])); }
ADI float hsum(float v) { auto rr = __builtin_amdgcn_permlane32_swap(__float_as_uint(v), __float_as_uint(v), false, false); return __uint_as_float(rr[0]) + __uint_as_float(rr[1]); }
ADI unsigned cvtpk(float lo, float hi) { f32x2 v = {lo, hi}; bf16x2_t b = __builtin_convertvector(v, bf16x2_t); return __builtin_bit_cast(unsigned, b); }
template <int S> ADI bf16x8 pack8(const f32x16& x) { u32x4 p; p[0] = cvtpk(x[8 * S], x[8 * S + 1]); p[1] = cvtpk(x[8 * S + 2], x[8 * S + 3]); p[2] = cvtpk(x[8 * S + 4], x[8 * S + 5]); p[3] = cvtpk(x[8 * S + 6], x[8 * S + 7]); return __builtin_bit_cast(bf16x8, p); }
ADI s16x4 vtr(const LAS unsigned char* p) { return __builtin_bit_cast(s16x4, __builtin_amdgcn_ds_read_tr16_b64_v4i16((LAS v4i16_t*)p)); }
ADI bf16x8 cat8(s16x4 lo, s16x4 hi) { return (bf16x8){lo[0], lo[1], lo[2], lo[3], hi[0], hi[1], hi[2], hi[3]}; }
ADI float fexp2(float x) { return __builtin_amdgcn_exp2f(x); }
ADI float max3f(float a, float b, float c) { return __builtin_fmaxf(__builtin_fmaxf(a, b), c); }

ADI void qk_tile(f32x16& s0, f32x16& s1, const LAS unsigned char* kt, const bf16x8 (&q)[4], int kro, int kx6) {
    s0 = f32x16{}; s1 = f32x16{};
#pragma unroll
    for (int d0 = 0; d0 < 4; ++d0) {
        const int ko = kro + (kx6 ^ (d0 << 5));
        const bf16x8 a0 = *(const LAS bf16x8*)(kt + ko); const bf16x8 a1 = *(const LAS bf16x8*)(kt + 4096 + ko);
        s0 = MFMA32(a0, q[d0], s0); s1 = MFMA32(a1, q[d0], s1);
    }
}
ADI void qk_tile_init(f32x16& s0, f32x16& s1, const f32x16& init, const LAS unsigned char* kt, const bf16x8 (&q)[4], int kro, int kx6) {
    s0 = init; s1 = init;
#pragma unroll
    for (int d0 = 0; d0 < 4; ++d0) {
        const int ko = kro + (kx6 ^ (d0 << 5));
        const bf16x8 a0 = *(const LAS bf16x8*)(kt + ko); const bf16x8 a1 = *(const LAS bf16x8*)(kt + 4096 + ko);
        s0 = MFMA32(a0, q[d0], s0); s1 = MFMA32(a1, q[d0], s1);
    }
}
ADI void qk_tile_lq(f32x16& s0, f32x16& s1, const LAS unsigned char* kt, const LAS unsigned char* qf, int kro, int kx6) {
    s0 = f32x16{}; s1 = f32x16{};
#pragma unroll
    for (int d0 = 0; d0 < 4; ++d0) {
        const int ko = kro + (kx6 ^ (d0 << 5));
        const bf16x8 a0 = *(const LAS bf16x8*)(kt + ko); const bf16x8 a1 = *(const LAS bf16x8*)(kt + 4096 + ko);
        const bf16x8 qd = *(const LAS bf16x8*)(qf + d0 * 1024);
        s0 = MFMA32(a0, qd, s0); s1 = MFMA32(a1, qd, s1);
    }
}
template <int NB>
ADI void softmax_tile(f32x16& s0, f32x16& s1, float& m, float& l, f32x16 (&O)[NB], LAS float* scr, int r, int hh) {
    float mxa = max3f(s0[0], s0[1], s1[0]), mxb = max3f(s0[2], s0[3], s1[1]); mxa = max3f(mxa, s1[2], s1[3]);
#pragma unroll
    for (int i = 4; i < 16; i += 4) { mxa = max3f(mxa, s0[i], s0[i + 1]); mxb = max3f(mxb, s0[i + 2], s0[i + 3]); mxa = max3f(mxa, s1[i], s1[i + 1]); mxb = max3f(mxb, s1[i + 2], s1[i + 3]); }
    float mx = hmax(max3f(mxa, mxb, mxb));
    if (__any(mx > m + 8.0f)) {
        const float mn = fmaxf(m, mx), al = fexp2(m - mn); l *= al; m = mn;
        if (hh == 0) scr[r] = al;
#pragma unroll
        for (int g = 0; g < 4; ++g) { const f32x4 a4 = *(const LAS f32x4*)(scr + 8 * g + 4 * hh);
#pragma unroll
            for (int c = 0; c < NB; ++c) { O[c][4 * g] *= a4[0]; O[c][4 * g + 1] *= a4[1]; O[c][4 * g + 2] *= a4[2]; O[c][4 * g + 3] *= a4[3]; } }
    }
    float sa = 0.f, sb = 0.f, sc = 0.f, sd = 0.f;
#pragma unroll
    for (int i = 0; i < 16; i += 2) { s0[i] = fexp2(s0[i] - m); s1[i] = fexp2(s1[i] - m); s0[i + 1] = fexp2(s0[i + 1] - m); s1[i + 1] = fexp2(s1[i + 1] - m); sa += s0[i]; sb += s1[i]; sc += s0[i + 1]; sd += s1[i + 1]; }
    l += (sa + sb) + (sc + sd);
}

template <int NB>
ADI void softmax_max(const f32x16& s0, const f32x16& s1, float& m, float& l, f32x16 (&O)[NB], LAS float* scr, int r, int hh) {
    float mxa = max3f(s0[0], s0[1], s1[0]), mxb = max3f(s0[2], s0[3], s1[1]); mxa = max3f(mxa, s1[2], s1[3]);
#pragma unroll
    for (int i = 4; i < 16; i += 4) { mxa = max3f(mxa, s0[i], s0[i + 1]); mxb = max3f(mxb, s0[i + 2], s0[i + 3]); mxa = max3f(mxa, s1[i], s1[i + 1]); mxb = max3f(mxb, s1[i + 2], s1[i + 3]); }
    const float mx = hmax(max3f(mxa, mxb, mxb));
    if (__any(mx > m + 8.0f)) {
        const float mn = fmaxf(m, mx), al = fexp2(m - mn); l *= al; m = mn;
        if (hh == 0) scr[r] = al;
#pragma unroll
        for (int g = 0; g < 4; ++g) { const f32x4 a4 = *(const LAS f32x4*)(scr + 8 * g + 4 * hh);
#pragma unroll
            for (int c = 0; c < NB; ++c) { O[c][4 * g] *= a4[0]; O[c][4 * g + 1] *= a4[1]; O[c][4 * g + 2] *= a4[2]; O[c][4 * g + 3] *= a4[3]; } }
    }
}
template <int S> ADI bf16x8 exp_pack8(f32x16& x, float m, float& sa, float& sb) {
#pragma unroll
    for (int i = 0; i < 8; i += 2) { x[8 * S + i] = fexp2(x[8 * S + i] - m); x[8 * S + i + 1] = fexp2(x[8 * S + i + 1] - m); sa += x[8 * S + i]; sb += x[8 * S + i + 1]; }
    return pack8<S>(x);
}
ADI void glds16(const void* gsrc, unsigned lds_dst) { unsigned keep;
    asm volatile("s_mov_b32 %0, m0\n\ts_mov_b32 m0, %2\n\ts_nop 0\n\tglobal_load_lds_dwordx4 %1, off\n\ts_mov_b32 m0, %0" : "=&s"(keep) : "v"(gsrc), "s"(lds_dst) : "memory"); }
#define ATT_GLDS(gp, lp) glds16((gp), (unsigned)__builtin_amdgcn_readfirstlane((int)(lp)))
typedef int v8i_a __attribute__((ext_vector_type(8)));
typedef int v4i_a __attribute__((ext_vector_type(4)));
typedef int v2i_a __attribute__((ext_vector_type(2)));
ADI void diff_unit(LAS unsigned char* lds, const unsigned char* QKV8, bf16_t* Oout, const float* subln, float lam, int b, int h, int qb, int tid, int lane, int wave) {
    const int r = lane & 31, hh = lane >> 5, comp = wave & 1, qt = wave >> 1;
    const size_t rowbase = (size_t)b * SEQ;
    v8i_a q8;
    {
        const unsigned char* qrow = QKV8 + (rowbase + qb * 128 + qt * 32 + r) * NQKV_B + (2 * h + comp) * 64 + 32 * hh;
        const v4i_a qa = *(const v4i_a*)qrow, qb_ = *(const v4i_a*)(qrow + 16);
        q8 = __builtin_shufflevector(qa, qb_, 0, 1, 2, 3, 4, 5, 6, 7);
    }
    const bool isV = wave >= 4; const int w4 = wave & 3;
    const int srow = 16 * w4 + (lane >> 2);
    const int vkey = 16 * w4 + (lane >> 3), vf0 = (vkey >> 1) & 1;
    const unsigned char* src0 = isV ? QKV8 + (rowbase + vkey) * NQKV_B + 2048 + h * 128 + ((((lane >> 1) & 3) ^ vf0) << 5) + ((lane & 1) << 4)
                                    : QKV8 + (rowbase + srow) * NQKV_B + 1024 + (2 * h) * 64 + (((lane & 3) ^ ((srow >> 2) & 3)) << 4);
    const unsigned char* src1 = isV ? QKV8 + (rowbase + vkey + 8) * NQKV_B + 2048 + h * 128 + ((((lane >> 1) & 3) ^ (vf0 | 2)) << 5) + ((lane & 1) << 4)
                                    : src0 + 64;
    const unsigned lb = (unsigned)(uintptr_t)lds;
    const unsigned dk0 = lb + (isV ? 8192 + (2 * w4) * 1024 : w4 * 1024), dk1 = lb + (isV ? 8192 + (2 * w4 + 1) * 1024 : 4096 + w4 * 1024);
#define DIFF_DMA(tt) do { const unsigned so_ = ((tt) & 3) * 16384; const size_t go_ = (size_t)(tt) * 64 * NQKV_B; \
        ATT_GLDS(src0 + go_, dk0 + so_); ATT_GLDS(src1 + go_, dk1 + so_); } while (0)
    const int kx = (r >> 2) & 3;
    const int kro0 = comp * 4096 + r * 64 + (((2 * hh) ^ kx) << 4), kro1 = comp * 4096 + r * 64 + (((2 * hh + 1) ^ kx) << 4);
    const int ts_ = lane & 15, tblk = (lane >> 4) & 1;
    const int te = ts_ >> 1, tcol = ts_ & 1;
    const int tkey = (te & 3) + 8 * (te >> 2) + 4 * hh;
    const int tfx = (te >> 1) & 3;
    const int vro = 8192 + tkey * 128 + 16 * tblk + 8 * tcol;
    LAS float* scr = (LAS float*)(lds + 132096 + wave * 256);
    f32x16 O[4];
#pragma unroll
    for (int c = 0; c < 4; ++c) O[c] = f32x16{};
    float m4 = 0.f, l = 0.f;
    f32x16 negm = f32x16{};
    constexpr int NT = SEQ / 64;
    const int sP = 0x7b7b7b7b, sV = 0x7f7f7f7f, sK = 0x7f7f7f7f, sQ = 0x7b7b7b7b;
    DIFF_DMA(0); DIFF_DMA(1);
    asm volatile("s_waitcnt vmcnt(2)\n\ts_barrier" ::: "memory");
    if (wave >= 4) __builtin_amdgcn_s_setprio(1);
    for (int t = 0; t < NT; ++t) {
        if (t + 2 < NT) DIFF_DMA(t + 2);
        const LAS unsigned char* st = lds + (t & 3) * 16384;
        f32x16 s0, s1;
        {
            const v4i_a a0 = *(const LAS v4i_a*)(st + kro0), a1 = *(const LAS v4i_a*)(st + kro1), b0 = *(const LAS v4i_a*)(st + 2048 + kro0), b1 = *(const LAS v4i_a*)(st + 2048 + kro1);
            const v8i_a k0 = __builtin_shufflevector(a0, a1, 0, 1, 2, 3, 4, 5, 6, 7), k1 = __builtin_shufflevector(b0, b1, 0, 1, 2, 3, 4, 5, 6, 7);
            asm volatile("s_nop 3\n\tv_mfma_scale_f32_32x32x64_f8f6f4 %0, %2, %4, %5, %6, %7 op_sel_hi:[0,0,0]\n\tv_mfma_scale_f32_32x32x64_f8f6f4 %1, %3, %4, %5, %6, %7 op_sel_hi:[0,0,0]\n\ts_nop 15\n\ts_nop 7"
                         : "=&v"(s0), "=&v"(s1) : "v"(k0), "v"(k1), "v"(q8), "v"(negm), "v"(sK), "v"(sQ));
        }
        {
            float mxa = max3f(s0[0], s0[1], s1[0]), mxb = max3f(s0[2], s0[3], s1[1]); mxa = max3f(mxa, s1[2], s1[3]);
#pragma unroll
            for (int i = 4; i < 16; i += 4) { mxa = max3f(mxa, s0[i], s0[i + 1]); mxb = max3f(mxb, s0[i + 2], s0[i + 3]); mxa = max3f(mxa, s1[i], s1[i + 1]); mxb = max3f(mxb, s1[i + 2], s1[i + 3]); }
            const float mx = hmax(max3f(mxa, mxb, mxb));
            if (t == 0 || __any(mx > 8.0f)) {
                const float dl = (t == 0) ? (mx - 4.0f) : fmaxf(mx - 4.0f, 0.f);
                const float al = (t == 0) ? 0.f : fexp2(-dl); l *= al; m4 += dl;
#pragma unroll
                for (int i = 0; i < 16; ++i) { s0[i] -= dl; s1[i] -= dl; negm[i] = -m4; }
                if (hh == 0) scr[r] = al;
#pragma unroll
                for (int g = 0; g < 4; ++g) { const f32x4 a4 = *(const LAS f32x4*)(scr + 8 * g + 4 * hh);
#pragma unroll
                    for (int c = 0; c < 4; ++c) { O[c][4 * g] *= a4[0]; O[c][4 * g + 1] *= a4[1]; O[c][4 * g + 2] *= a4[2]; O[c][4 * g + 3] *= a4[3]; } }
            }
        }
        float sa = 0.f, sb = 0.f, sc = 0.f, sd = 0.f;
#pragma unroll
        for (int i = 0; i < 16; i += 2) { s0[i] = fexp2(s0[i]); s1[i] = fexp2(s1[i]); s0[i + 1] = fexp2(s0[i + 1]); s1[i + 1] = fexp2(s1[i + 1]); sa += s0[i]; sb += s1[i]; sc += s0[i + 1]; sd += s1[i + 1]; }
        l += ((sa + sb) + (sc + sd)) * 0.0625f;
        v8i_a P8;
#pragma unroll
        for (int g = 0; g < 4; ++g) { P8[g] = (int)pk_fp8x4_nc(s0[4 * g], s0[4 * g + 1], s0[4 * g + 2], s0[4 * g + 3]); P8[4 + g] = (int)pk_fp8x4_nc(s1[4 * g], s1[4 * g + 1], s1[4 * g + 2], s1[4 * g + 3]); }
#pragma unroll
        for (int c = 0; c < 4; ++c) {
            const LAS unsigned char* vp = st + vro + ((c ^ tfx) << 5);
            const v2i_a t0 = __builtin_amdgcn_ds_read_tr8_b64_v2i32((LAS v2i_a*)(vp)), t1 = __builtin_amdgcn_ds_read_tr8_b64_v2i32((LAS v2i_a*)(vp + 16 * 128));
            const v2i_a t2 = __builtin_amdgcn_ds_read_tr8_b64_v2i32((LAS v2i_a*)(vp + 32 * 128)), t3 = __builtin_amdgcn_ds_read_tr8_b64_v2i32((LAS v2i_a*)(vp + 48 * 128));
            const v8i_a V8 = (v8i_a){t0[0], t0[1], t1[0], t1[1], t2[0], t2[1], t3[0], t3[1]};
            asm volatile("s_nop 3\n\tv_mfma_scale_f32_32x32x64_f8f6f4 %0, %1, %2, %0, %3, %4 op_sel_hi:[0,0,0]" : "+v"(O[c]) : "v"(P8), "v"(V8), "v"(sP), "v"(sV));
        }
        if (t + 2 < NT) asm volatile("s_waitcnt vmcnt(2) lgkmcnt(0)\n\ts_barrier" ::: "memory"); else asm volatile("s_waitcnt vmcnt(0) lgkmcnt(0)\n\ts_barrier" ::: "memory");
    }
#undef DIFF_DMA
    __builtin_amdgcn_s_setprio(0);
    asm volatile("s_nop 15\n\ts_nop 15" ::: "memory");
    l = hsum(l);
    if (hh == 0) scr[r] = (comp == 0 ? 1.0f : lam) / l;
    LAS float* xch = (LAS float*)(lds + qt * 16384) + lane;
#pragma unroll
    for (int g = 0; g < 4; ++g) { const f32x4 a4 = *(const LAS f32x4*)(scr + 8 * g + 4 * hh);
#pragma unroll
        for (int c = 0; c < 4; ++c) { O[c][4 * g] *= a4[0]; O[c][4 * g + 1] *= a4[1]; O[c][4 * g + 2] *= a4[2]; O[c][4 * g + 3] *= a4[3]; } }
    if (comp == 1) {
#pragma unroll
        for (int c = 0; c < 4; ++c)
#pragma unroll
            for (int i = 0; i < 16; ++i) xch[(c * 16 + i) * 64] = O[c][i];
    }
    __syncthreads();
    if (comp == 0) {
        float sg[4];
#pragma unroll
        for (int c = 0; c < 4; ++c) sg[c] = subln[32 * c + r] * (1.0f - LAMBDA_INIT);
#pragma unroll
        for (int i = 0; i < 16; ++i) {
            float y[4]; float ss = 0.f;
#pragma unroll
            for (int c = 0; c < 4; ++c) { y[c] = O[c][i] - xch[(c * 16 + i) * 64]; ss += y[c] * y[c]; }
            ss += __shfl_xor(ss, 1); ss += __shfl_xor(ss, 2); ss += __shfl_xor(ss, 4); ss += __shfl_xor(ss, 8); ss += __shfl_xor(ss, 16);
            const float rs = 1.0f / sqrtf(ss * (1.0f / 128.0f) + SUBLN_EPS);
            bf16_t* op = Oout + (rowbase + qb * 128 + qt * 32 + crow(i, hh)) * DM + h * 128 + r;
#pragma unroll
            for (int c = 0; c < 4; ++c) op[32 * c] = (bf16_t)f2bf(y[c] * rs * sg[c]);
        }
    }
    __syncthreads();
}

struct BandW { const bf16_t* qrow; int qi0, tlo, thi; float m0, l0; bf16_t* out; size_t ostride; float* lse; size_t lstride; };
template <bool LSE_OUT>
ADI void band_unit(LAS unsigned char* lds, const bf16_t* Kb, const bf16_t* Vb, size_t kstride, int L, int jstart, int ntiles, int halfw, const BandW& W, int tid, int lane, int wave) {
    const int r = lane & 31, hh = lane >> 5;
    bf16x8 q[4];
#pragma unroll
    for (int d0 = 0; d0 < 4; ++d0) q[d0] = *(const bf16x8*)(W.qrow + 16 * d0 + 8 * hh);
    const int srow = tid >> 3, sch = tid & 7;
    const int kdst = srow * 128 + ((sch ^ ((srow >> 1) & 7)) << 4);
    const int vdst = 8192 + srow * 128 + ((sch ^ (((srow >> 1) & 1) << 2)) << 4);
    const int xs = (r >> 1) & 7;
    const int kro = r * 128 + ((hh ^ (xs & 1)) << 4), kx6 = (xs & 6) << 4;
    const int blk = (lane >> 4) & 1, qq = (lane & 15) >> 2, pp = lane & 3;
    const int vro = 8192 + (4 * hh + qq) * 128 + ((2 * blk + (pp >> 1)) << 4) + 8 * (pp & 1), vq6 = ((qq >> 1) & 1) << 6;
    LAS float* scr = (LAS float*)(lds + 132096 + wave * 256);
    f32x16 O[2]; O[0] = f32x16{}; O[1] = f32x16{};
    float m = W.m0, l = W.l0;
    const int qi = W.qi0 + r;
    {
        int j = jstart + srow; j = j < 0 ? 0 : (j > L - 1 ? L - 1 : j);
        const u32x4 ka = *(const u32x4*)(Kb + (size_t)j * kstride + sch * 8), va = *(const u32x4*)(Vb + (size_t)j * kstride + sch * 8);
        *(LAS u32x4*)(lds + kdst) = ka; *(LAS u32x4*)(lds + vdst) = va;
    }
    __syncthreads();
    for (int t = 0; t < ntiles; ++t) {
        const LAS unsigned char* st = lds + (t & 1) * 16384;
        const bool active = (t >= W.tlo) && (t <= W.thi);
        bf16x8 P[4];
        if (active) {
            f32x16 s0, s1;
            qk_tile(s0, s1, st, q, kro, kx6);
            const int jb = jstart + 64 * t + 4 * hh;
#pragma unroll
            for (int i = 0; i < 16; ++i) {
                const int j0 = jb + (i & 3) + 8 * (i >> 2), j1 = j0 + 32;
                if (!(((unsigned)j0 < (unsigned)L) && ((unsigned)(j0 - qi + halfw) <= (unsigned)(2 * halfw)))) s0[i] = -INFINITY;
                if (!(((unsigned)j1 < (unsigned)L) && ((unsigned)(j1 - qi + halfw) <= (unsigned)(2 * halfw)))) s1[i] = -INFINITY;
            }
            softmax_tile<2>(s0, s1, m, l, O, scr, r, hh);
            P[0] = pack8<0>(s0); P[1] = pack8<1>(s0); P[2] = pack8<0>(s1); P[3] = pack8<1>(s1);
        }
        int j = jstart + 64 * ((t + 1 < ntiles) ? t + 1 : t) + srow; j = j < 0 ? 0 : (j > L - 1 ? L - 1 : j);
        const u32x4 ka = *(const u32x4*)(Kb + (size_t)j * kstride + sch * 8), va = *(const u32x4*)(Vb + (size_t)j * kstride + sch * 8);
        if (active) {
#pragma unroll
            for (int c = 0; c < 2; ++c)
#pragma unroll
                for (int kc = 0; kc < 4; ++kc) {
                    const LAS unsigned char* vp = st + vro + (vq6 ^ (c << 6)) + kc * 2048;
                    const bf16x8 vf = cat8(vtr(vp), vtr(vp + 1024));
                    O[c] = MFMA32(P[kc], vf, O[c]);
                }
        }
        LAS unsigned char* sn = lds + ((t + 1) & 1) * 16384;
        *(LAS u32x4*)(sn + kdst) = ka; *(LAS u32x4*)(sn + vdst) = va;
        __syncthreads();
    }
    l = hsum(l);
    if (hh == 0) scr[r] = 1.0f / l;
    if (LSE_OUT) { if (hh == 0) W.lse[(size_t)(W.qi0 + r) * W.lstride] = m + log2f(l); }
#pragma unroll
    for (int g = 0; g < 4; ++g) { const f32x4 a4 = *(const LAS f32x4*)(scr + 8 * g + 4 * hh);
#pragma unroll
        for (int k = 0; k < 4; ++k) { bf16_t* op = W.out + (size_t)(W.qi0 + 8 * g + 4 * hh + k) * W.ostride + r;
            op[0] = (bf16_t)f2bf(O[0][4 * g + k] * a4[k]); op[32] = (bf16_t)f2bf(O[1][4 * g + k] * a4[k]); } }
}

struct BandDesc { const bf16_t* Kb; const bf16_t* Vb; size_t kstride; int L, jstart; const bf16_t* qrow; int qi0, tlo, thi; float m0, l0; bf16_t* out; size_t ostride; float* lse; size_t lstride; };
template <int NTL, int HALFW, bool LSE_OUT, class F>
ADI void band_stream(LAS unsigned char* lds, int nunits, const F& get, int tid, int lane, int wave) {
    const int r = lane & 31, hh = lane >> 5;
    const unsigned lbase = (unsigned)(uintptr_t)lds;
    const int srow = 8 * wave + (lane >> 3), kchs = ((lane & 7) ^ ((srow >> 1) & 7)) * 8, vchs = ((lane & 7) ^ (((srow >> 1) & 1) << 2)) * 8;
    const int xs = (r >> 1) & 7;
    const int kro = r * 128 + ((hh ^ (xs & 1)) << 4), kx6 = (xs & 6) << 4;
    const int blk = (lane >> 4) & 1, qq = (lane & 15) >> 2, pp = lane & 3;
    const int vro = 8192 + (4 * hh + qq) * 128 + ((2 * blk + (pp >> 1)) << 4) + 8 * (pp & 1), vq6 = ((qq >> 1) & 1) << 6;
    LAS float* scr = (LAS float*)(lds + 132096 + wave * 256);
    const int total = nunits * NTL;
#define BAND_TILE_DMA(sp) do { const int sp_ = (sp) < total ? (sp) : total - 1; const int k_ = sp_ / NTL, t_ = sp_ % NTL; const BandDesc D_ = get(k_); \
        int j_ = D_.jstart + 64 * t_ + srow; j_ = j_ < 0 ? 0 : (j_ > D_.L - 1 ? D_.L - 1 : j_); const unsigned st_ = lbase + ((sp) & 3) * 16384 + wave * 1024; \
        ATT_GLDS(D_.Kb + (size_t)j_ * D_.kstride + kchs, st_); ATT_GLDS(D_.Vb + (size_t)j_ * D_.kstride + vchs, st_ + 8192); } while (0)
#define BAND_Q_DMA(ku, d0) do { const int ku_ = (ku) < nunits ? (ku) : nunits - 1; const BandDesc D_ = get(ku_); \
        ATT_GLDS(D_.qrow + 16 * (d0) + 8 * hh, lbase + 65536 + ((ku) & 1) * 32768 + wave * 4096 + (d0) * 1024); } while (0)
    BAND_Q_DMA(0, 0); BAND_Q_DMA(0, 1); BAND_Q_DMA(0, 2); BAND_Q_DMA(0, 3);
    BAND_TILE_DMA(0); BAND_TILE_DMA(1);
    asm volatile("s_waitcnt vmcnt(2)\n\ts_barrier" ::: "memory");
    bf16x8 q[4]; f32x16 O[2]; float m = 0.f, l = 0.f;
    O[0] = f32x16{}; O[1] = f32x16{};
#pragma unroll
    for (int d0 = 0; d0 < 4; ++d0) q[d0] = bf16x8{};
    int k = 0, t = 0;
    for (int s = 0; s < total; ++s) {
        BAND_TILE_DMA(s + 2); BAND_Q_DMA(k + 1, (t < 4 ? t : 3));
        const BandDesc D = get(k);
        if (t == 0) {
            const LAS unsigned char* qs = lds + 65536 + (k & 1) * 32768 + wave * 4096 + lane * 16;
#pragma unroll
            for (int d0 = 0; d0 < 4; ++d0) q[d0] = *(const LAS bf16x8*)(qs + d0 * 1024);
            O[0] = f32x16{}; O[1] = f32x16{}; m = D.m0; l = D.l0;
        }
        const LAS unsigned char* st = lds + (s & 3) * 16384;
        if (t >= D.tlo && t <= D.thi) {
            f32x16 s0, s1;
            qk_tile(s0, s1, st, q, kro, kx6);
            const int ts = D.jstart + 64 * t;
            if (!(ts >= D.qi0 + 31 - HALFW && ts + 63 <= D.qi0 + HALFW && ts >= 0 && ts + 63 < D.L)) {
                const int jb = ts + 4 * hh, qi = D.qi0 + r;
#pragma unroll
                for (int i = 0; i < 16; ++i) {
                    const int j0 = jb + (i & 3) + 8 * (i >> 2), j1 = j0 + 32;
                    if (!(((unsigned)j0 < (unsigned)D.L) && ((unsigned)(j0 - qi + HALFW) <= (unsigned)(2 * HALFW)))) s0[i] = -INFINITY;
                    if (!(((unsigned)j1 < (unsigned)D.L) && ((unsigned)(j1 - qi + HALFW) <= (unsigned)(2 * HALFW)))) s1[i] = -INFINITY;
                }
            }
            softmax_tile<2>(s0, s1, m, l, O, scr, r, hh);
            bf16x8 P[4]; P[0] = pack8<0>(s0); P[1] = pack8<1>(s0); P[2] = pack8<0>(s1); P[3] = pack8<1>(s1);
#pragma unroll
            for (int c = 0; c < 2; ++c)
#pragma unroll
                for (int kc = 0; kc < 4; ++kc) {
                    const LAS unsigned char* vp = st + vro + (vq6 ^ (c << 6)) + kc * 2048;
                    const bf16x8 vf = cat8(vtr(vp), vtr(vp + 1024));
                    O[c] = MFMA32(P[kc], vf, O[c]);
                }
        }
        if (t == NTL - 1 && D.tlo <= D.thi) {
            const float lt = hsum(l);
            if (hh == 0) scr[r] = 1.0f / lt;
            if (LSE_OUT) { if (hh == 0) D.lse[(size_t)(D.qi0 + r) * D.lstride] = m + log2f(lt); }
#pragma unroll
            for (int g = 0; g < 4; ++g) { const f32x4 a4 = *(const LAS f32x4*)(scr + 8 * g + 4 * hh);
#pragma unroll
                for (int kk = 0; kk < 4; ++kk) { bf16_t* op = D.out + (size_t)(D.qi0 + 8 * g + 4 * hh + kk) * D.ostride + r;
                    op[0] = (bf16_t)f2bf(O[0][4 * g + kk] * a4[kk]); op[32] = (bf16_t)f2bf(O[1][4 * g + kk] * a4[kk]); } }
        }
        asm volatile("s_waitcnt vmcnt(3) lgkmcnt(0)\n\ts_barrier" ::: "memory");
        if (++t == NTL) { t = 0; ++k; }
    }
    asm volatile("s_waitcnt vmcnt(0)\n\ts_barrier" ::: "memory");
#undef BAND_TILE_DMA
#undef BAND_Q_DMA
}

template <int NB>
ADI void softmax_tile8(f32x16& s0, f32x16& s1, float& m, float& l, f32x16 (&O)[NB], LAS float* scr, int r, int hh) {
    float mxa = max3f(s0[0], s0[1], s1[0]), mxb = max3f(s0[2], s0[3], s1[1]); mxa = max3f(mxa, s1[2], s1[3]);
#pragma unroll
    for (int i = 4; i < 16; i += 4) { mxa = max3f(mxa, s0[i], s0[i + 1]); mxb = max3f(mxb, s0[i + 2], s0[i + 3]); mxa = max3f(mxa, s1[i], s1[i + 1]); mxb = max3f(mxb, s1[i + 2], s1[i + 3]); }
    float mx = hmax(max3f(mxa, mxb, mxb));
    if (__any(mx > m + 4.0f)) {
        const float mn = fmaxf(m, mx), al = fexp2(m - mn); l *= al; m = mn;
        if (hh == 0) scr[r] = al;
#pragma unroll
        for (int g = 0; g < 4; ++g) { const f32x4 a4 = *(const LAS f32x4*)(scr + 8 * g + 4 * hh);
#pragma unroll
            for (int c = 0; c < NB; ++c) { O[c][4 * g] *= a4[0]; O[c][4 * g + 1] *= a4[1]; O[c][4 * g + 2] *= a4[2]; O[c][4 * g + 3] *= a4[3]; } }
    }
    const float m4 = m - 4.0f;
    float sa = 0.f, sb = 0.f, sc = 0.f, sd = 0.f;
#pragma unroll
    for (int i = 0; i < 16; i += 2) { s0[i] = fexp2(s0[i] - m4); s1[i] = fexp2(s1[i] - m4); s0[i + 1] = fexp2(s0[i + 1] - m4); s1[i + 1] = fexp2(s1[i + 1] - m4); sa += s0[i]; sb += s1[i]; sc += s0[i + 1]; sd += s1[i + 1]; }
    l += ((sa + sb) + (sc + sd)) * 0.0625f;
}

struct BandDesc8 { const unsigned char* Kb; const unsigned char* Vb; size_t kstride; int L, jstart; const unsigned char* qrow; int qi0, tlo, thi; float m0, l0; bf16_t* out; size_t ostride; float* lse; size_t lstride; };
template <int NTL, int HALFW, class F, bool OUT8 = false>
ADI void band_stream8(LAS unsigned char* lds, int nunits, const F& get, int tid, int lane, int wave) {
    static_assert(2 * NTL * 8192 + 32768 <= 132096, "LDS");
    const int r = lane & 31, hh = lane >> 5;
    const unsigned lbase = (unsigned)(uintptr_t)lds;
    const bool isV = wave >= 4;
    const int srow = 16 * (wave & 3) + (lane >> 2);
    const int soff = isV ? (((((lane >> 1) & 1) ^ ((srow >> 3) & 1)) << 5) + ((lane & 1) << 4)) : (((lane & 3) ^ ((srow >> 2) & 3)) << 4);
    const int kx = (r >> 2) & 3;
    const int kro0 = r * 64 + (((2 * hh) ^ kx) << 4), kro1 = r * 64 + (((2 * hh + 1) ^ kx) << 4);
    const int ts_ = lane & 15, tblk = (lane >> 4) & 1, te = ts_ >> 1, tcol = ts_ & 1;
    const int tkey = (te & 3) + 8 * (te >> 2) + 4 * hh, tfx = (te >> 2) & 1;
    const int vro = 4096 + tkey * 64 + 16 * tblk + 8 * tcol;
    LAS float* scr = (LAS float*)(lds + 132096 + wave * 256);
    const int sK = 0x7f7f7f7f, sQ = 0x7b7b7b7b, sP = 0x7b7b7b7b, sV = 0x7f7f7f7f;
#define B8_UNIT_DMA(ku) do { if ((ku) < nunits) { const BandDesc8 D_ = get(ku); \
        _Pragma("unroll") for (int ti_ = 0; ti_ < NTL; ++ti_) { int j_ = D_.jstart + 64 * ti_ + srow; j_ = j_ < 0 ? 0 : (j_ > D_.L - 1 ? D_.L - 1 : j_); \
            ATT_GLDS((isV ? D_.Vb : D_.Kb) + (size_t)j_ * D_.kstride + soff, lbase + ((ku) & 1) * (NTL * 8192) + ti_ * 8192 + wave * 1024); } \
        ATT_GLDS(D_.qrow + 32 * hh, lbase + 2 * NTL * 8192 + ((ku) & 1) * 16384 + wave * 2048); \
        ATT_GLDS(D_.qrow + 32 * hh + 16, lbase + 2 * NTL * 8192 + ((ku) & 1) * 16384 + wave * 2048 + 1024); } } while (0)
    B8_UNIT_DMA(0);
    asm volatile("s_waitcnt vmcnt(0)\n\ts_barrier" ::: "memory");
    for (int k = 0; k < nunits; ++k) {
        B8_UNIT_DMA(k + 1);
        const BandDesc8 D = get(k);
        const int tlo = __builtin_amdgcn_readfirstlane(D.tlo), thi = __builtin_amdgcn_readfirstlane(D.thi);
        if (tlo <= thi) {
            v8i_a q8; f32x16 O[2]; float m = D.m0, l = D.l0;
            {
                const LAS unsigned char* qs = lds + 2 * NTL * 8192 + (k & 1) * 16384 + wave * 2048 + lane * 16;
                const v4i_a qa = *(const LAS v4i_a*)qs, qb = *(const LAS v4i_a*)(qs + 1024);
                q8 = __builtin_shufflevector(qa, qb, 0, 1, 2, 3, 4, 5, 6, 7);
            }
            O[0] = f32x16{}; O[1] = f32x16{};
#pragma unroll 1
            for (int t = tlo; t <= thi; ++t) {
                const LAS unsigned char* st = lds + (k & 1) * (NTL * 8192) + t * 8192;
                f32x16 s0, s1;
                {
                    const v4i_a a0 = *(const LAS v4i_a*)(st + kro0), a1 = *(const LAS v4i_a*)(st + kro1), b0 = *(const LAS v4i_a*)(st + 2048 + kro0), b1 = *(const LAS v4i_a*)(st + 2048 + kro1);
                    const v8i_a k0 = __builtin_shufflevector(a0, a1, 0, 1, 2, 3, 4, 5, 6, 7), k1 = __builtin_shufflevector(b0, b1, 0, 1, 2, 3, 4, 5, 6, 7);
                    asm volatile("v_mfma_scale_f32_32x32x64_f8f6f4 %0, %2, %4, 0, %5, %6 op_sel_hi:[0,0,0]\n\tv_mfma_scale_f32_32x32x64_f8f6f4 %1, %3, %4, 0, %5, %6 op_sel_hi:[0,0,0]\n\ts_nop 15\n\ts_nop 7"
                                 : "=&v"(s0), "=&v"(s1) : "v"(k0), "v"(k1), "v"(q8), "v"(sK), "v"(sQ));
                }
                const int ts = D.jstart + 64 * t;
                if (!(ts >= D.qi0 + 31 - HALFW && ts + 63 <= D.qi0 + HALFW && ts >= 0 && ts + 63 < D.L)) {
                    const int jb = ts + 4 * hh, qi = D.qi0 + r;
#pragma unroll
                    for (int i = 0; i < 16; ++i) {
                        const int j0 = jb + (i & 3) + 8 * (i >> 2), j1 = j0 + 32;
                        if (!(((unsigned)j0 < (unsigned)D.L) && ((unsigned)(j0 - qi + HALFW) <= (unsigned)(2 * HALFW)))) s0[i] = -INFINITY;
                        if (!(((unsigned)j1 < (unsigned)D.L) && ((unsigned)(j1 - qi + HALFW) <= (unsigned)(2 * HALFW)))) s1[i] = -INFINITY;
                    }
                }
                softmax_tile8<2>(s0, s1, m, l, O, scr, r, hh);
                v8i_a P8;
#pragma unroll
                for (int g = 0; g < 4; ++g) { P8[g] = (int)pk_fp8x4_nc(s0[4 * g], s0[4 * g + 1], s0[4 * g + 2], s0[4 * g + 3]); P8[4 + g] = (int)pk_fp8x4_nc(s1[4 * g], s1[4 * g + 1], s1[4 * g + 2], s1[4 * g + 3]); }
#pragma unroll
                for (int c = 0; c < 2; ++c) {
                    const LAS unsigned char* vp = st + vro + ((c ^ tfx) << 5);
                    const v2i_a t0 = __builtin_amdgcn_ds_read_tr8_b64_v2i32((LAS v2i_a*)(vp)), t1 = __builtin_amdgcn_ds_read_tr8_b64_v2i32((LAS v2i_a*)(vp + 16 * 64));
                    const v2i_a t2 = __builtin_amdgcn_ds_read_tr8_b64_v2i32((LAS v2i_a*)(vp + 32 * 64)), t3 = __builtin_amdgcn_ds_read_tr8_b64_v2i32((LAS v2i_a*)(vp + 48 * 64));
                    const v8i_a V8 = (v8i_a){t0[0], t0[1], t1[0], t1[1], t2[0], t2[1], t3[0], t3[1]};
                    asm volatile("s_nop 3\n\tv_mfma_scale_f32_32x32x64_f8f6f4 %0, %1, %2, %0, %3, %4 op_sel_hi:[0,0,0]" : "+v"(O[c]) : "v"(P8), "v"(V8), "v"(sP), "v"(sV));
                }
            }
            asm volatile("s_nop 15\n\ts_nop 15" ::: "memory");
            const float lt = hsum(l);
            if (hh == 0) scr[r] = 1.0f / lt;
            asm volatile("s_waitcnt vmcnt(0)" ::: "memory");
            if (hh == 0 && D.lse != nullptr) D.lse[(size_t)(D.qi0 + r) * D.lstride] = m + log2f(lt);
#pragma unroll
            for (int g = 0; g < 4; ++g) { const f32x4 a4 = *(const LAS f32x4*)(scr + 8 * g + 4 * hh);
#pragma unroll
                for (int kk = 0; kk < 4; ++kk) {
                    if constexpr (OUT8) { unsigned char* op = (unsigned char*)D.out + (size_t)(D.qi0 + 8 * g + 4 * hh + kk) * D.ostride + r;
                        op[0] = fp8_byte(O[0][4 * g + kk] * a4[kk]); op[32] = fp8_byte(O[1][4 * g + kk] * a4[kk]); }
                    else { bf16_t* op = D.out + (size_t)(D.qi0 + 8 * g + 4 * hh + kk) * D.ostride + r;
                    op[0] = (bf16_t)f2bf(O[0][4 * g + kk] * a4[kk]); op[32] = (bf16_t)f2bf(O[1][4 * g + kk] * a4[kk]); } } }
        } else {
            asm volatile("s_waitcnt vmcnt(0)" ::: "memory");
        }
        asm volatile("s_waitcnt lgkmcnt(0)\n\ts_barrier" ::: "memory");
    }
    asm volatile("s_waitcnt vmcnt(0)\n\ts_barrier" ::: "memory");
#undef B8_UNIT_DMA
}
}

__device__ __forceinline__ void attn_B(const Ctx& C) {
    const bf16_t* QKV = WSP(bf16_t, WS_BIG + BIG_QKV); bf16_t* O = WSP(bf16_t, WS_O); const float* subln = IN_F(15);
    const float lam = diff_lambda(C);
    const int vcu = (C.G % 8 == 0) ? (C.bid % 8) * (C.G / 8) + C.bid / 8 : C.bid;
    for (int u = vcu; u < 1024; u += C.G) {
        const int k = u / C.G, v = u % C.G; int bh, qb;
        if (C.G == 256) { bh = v >> 4; qb = (v & 15) * 4 + k; } else { bh = u >> 6; qb = u & 63; }
        att::diff_unit(C.lds, (const unsigned char*)QKV, O, subln, lam, bh >> 3, bh & 7, qb, C.tid, C.lane, C.wave);
    }
}

struct GetA {
    const bf16_t* QKV; bf16_t* OG; float* LSE; int vcu, G, wave, r;
    __device__ __forceinline__ att::BandDesc operator()(int k) const {
        const int U = vcu + k * G; att::BandDesc D;
        const bool ok = U < 3072; const int Uc = ok ? U : 0;
        const int v = Uc & 31, t3 = Uc >> 5, gi = t3 % 3, bh = t3 / 3, b = bh >> 4, h = bh & 15;
        const int sh = 2 * gi, dil = 1 << sh, Lg = SEQ >> sh, nqb = 32 >> sh, res = v >> (5 - sh), i0 = (v & (nqb - 1)) << 8;
        const size_t tok0 = (size_t)b * SEQ + res;
        const bf16_t* base = QKV + tok0 * NQKV_A + gi * 3072 + h * 64;
        D.Kb = base + 1024; D.Vb = base + 2048; D.kstride = (size_t)dil * NQKV_A; D.L = Lg; D.jstart = i0 - 64;
        D.qi0 = i0 + 32 * wave; D.tlo = ok ? (wave >> 1) : 1; D.thi = ok ? ((32 * wave + 159) >> 6) : 0; D.m0 = -1e30f; D.l0 = 0.f;
        D.qrow = base + (size_t)(D.qi0 + r) * dil * NQKV_A;
        D.out = OG + ((size_t)gi * NTOK + tok0) * DM + h * 64; D.ostride = (size_t)dil * DM;
        D.lse = LSE + ((size_t)gi * NTOK + tok0) * 16 + h; D.lstride = (size_t)dil * 16;
        return D;
    }
};
struct GetA8 {
    const unsigned char* QKV8; bf16_t* OG; float* LSE; int vcu, G, wave, r;
    __device__ __forceinline__ att::BandDesc8 operator()(int k) const {
        const int U = vcu + k * G; att::BandDesc8 D;
        const bool ok = U < 3072; const int Uc = ok ? U : 0;
        const int v = Uc & 31, t3 = Uc >> 5, gi = t3 % 3, bh = t3 / 3, b = bh >> 4, h = bh & 15;
        const int sh = 2 * gi, dil = 1 << sh, Lg = SEQ >> sh, nqb = 32 >> sh, res = v >> (5 - sh), i0 = (v & (nqb - 1)) << 8;
        const size_t tok0 = (size_t)b * SEQ + res;
        const unsigned char* base = QKV8 + (size_t)(3 * gi) * ((size_t)NTOK * 1024) + (size_t)((b * 16 + h) * SEQ + res * Lg) * 64;
        D.Kb = base + (size_t)NTOK * 1024; D.Vb = base + (size_t)2 * NTOK * 1024; D.kstride = 64; D.L = Lg; D.jstart = i0 - 64;
        D.qi0 = i0 + 32 * wave; D.tlo = ok ? (wave >> 1) : 1; D.thi = ok ? ((32 * wave + 159) >> 6) : 0; D.m0 = -1e30f; D.l0 = 0.f;
        D.qrow = base + (size_t)(D.qi0 + r) * 64;
        D.out = OG + ((size_t)gi * NTOK + tok0) * DM + h * 64; D.ostride = (size_t)dil * DM;
        D.lse = LSE + ((size_t)gi * NTOK + tok0) * 16 + h; D.lstride = (size_t)dil * 16;
        return D;
    }
};
__device__ __forceinline__ void attn_A8(const Ctx& C) {
    GetA8 g; g.QKV8 = WSP(unsigned char, WS_BIG + BIG_QKV); g.OG = WSP(bf16_t, WS_BIG + BIG_OG); g.LSE = WSP(float, WS_LSE);
    g.vcu = (C.G % 8 == 0) ? (C.bid % 8) * (C.G / 8) + C.bid / 8 : C.bid; g.G = C.G; g.wave = C.wave; g.r = C.lane & 31;
    att::band_stream8<6, 64, GetA8>(C.lds, (3072 + C.G - 1) / C.G, g, C.tid, C.lane, C.wave);
}
__device__ __forceinline__ void attn_A(const Ctx& C) {
    GetA g; g.QKV = WSP(bf16_t, WS_BIG + BIG_QKV); g.OG = WSP(bf16_t, WS_BIG + BIG_OG); g.LSE = WSP(float, WS_LSE);
    g.vcu = (C.G % 8 == 0) ? (C.bid % 8) * (C.G / 8) + C.bid / 8 : C.bid; g.G = C.G; g.wave = C.wave; g.r = C.lane & 31;
    att::band_stream<6, 64, true, GetA>(C.lds, (3072 + C.G - 1) / C.G, g, C.tid, C.lane, C.wave);
}
struct GetC {
    const bf16_t* QKV; bf16_t* O; float sk0, sk1; int vcu, G, wave, r, hh;
    __device__ __forceinline__ att::BandDesc operator()(int k) const {
        const int U = vcu + k * G; att::BandDesc D;
        const bool ok = U < 1024; const int Uc = ok ? U : 0;
        const int qblk = Uc & 255, bg = Uc >> 8, b = bg >> 1, g = bg & 1, i0 = qblk * 32, head = 8 * g + wave;
        const bf16_t* base = QKV + (size_t)b * SEQ * NQKV_C;
        D.Kb = base + 1024 + g * 64; D.Vb = base + 1152 + g * 64; D.kstride = (size_t)NQKV_C; D.L = SEQ; D.jstart = i0 - 128;
        D.qi0 = i0; D.tlo = ok ? 0 : 1; D.thi = ok ? 4 : 0; D.m0 = (g ? sk1 : sk0) * LOG2E; D.l0 = hh == 0 ? 1.f : 0.f;
        D.qrow = base + (size_t)(i0 + r) * NQKV_C + head * 64;
        D.out = O + (size_t)b * SEQ * DM + head * 64; D.ostride = DM; D.lse = nullptr; D.lstride = 0;
        return D;
    }
};
struct GetC8 {
    const unsigned char* QKV8; bf16_t* O; float sk0, sk1; int vcu, G, wave, r, hh;
    __device__ __forceinline__ att::BandDesc8 operator()(int k) const {
        const int U = vcu + k * G; att::BandDesc8 D;
        const bool ok = U < 1024; const int Uc = ok ? U : 0;
        const int qblk = Uc & 255, bg = Uc >> 8, b = bg >> 1, g = bg & 1, i0 = qblk * 32, head = 8 * g + wave;
        const unsigned char* base = QKV8 + (size_t)b * SEQ * NQKV_C;
        D.Kb = base + 1024 + g * 64; D.Vb = base + 1152 + g * 64; D.kstride = (size_t)NQKV_C; D.L = SEQ; D.jstart = i0 - 128;
        D.qi0 = i0; D.tlo = ok ? 0 : 1; D.thi = ok ? 4 : 0; D.m0 = (g ? sk1 : sk0) * LOG2E; D.l0 = hh == 0 ? 1.f : 0.f;
        D.qrow = base + (size_t)(i0 + r) * NQKV_C + head * 64;
        D.out = (bf16_t*)((unsigned char*)O + (size_t)b * SEQ * DM + head * 64); D.ostride = DM; D.lse = nullptr; D.lstride = 0;
        return D;
    }
};
__device__ __forceinline__ void attn_C8(const Ctx& C) {
    GetC8 g; g.QKV8 = WSP(unsigned char, WS_BIG + BIG_QKV); g.O = WSP(bf16_t, WS_O); g.sk0 = IN_F(24)[C.wave]; g.sk1 = IN_F(24)[8 + C.wave];
    g.vcu = (C.G % 8 == 0) ? (C.bid % 8) * (C.G / 8) + C.bid / 8 : C.bid; g.G = C.G; g.wave = C.wave; g.r = C.lane & 31; g.hh = C.lane >> 5;
    asm volatile("s_waitcnt vmcnt(0)" ::: "memory");
    att::band_stream8<5, 128, GetC8, true>(C.lds, (1024 + C.G - 1) / C.G, g, C.tid, C.lane, C.wave);
}
__device__ __forceinline__ void attn_C(const Ctx& C) {
    GetC g; g.QKV = WSP(bf16_t, WS_BIG + BIG_QKV); g.O = WSP(bf16_t, WS_O); g.sk0 = IN_F(24)[C.wave]; g.sk1 = IN_F(24)[8 + C.wave];
    g.vcu = (C.G % 8 == 0) ? (C.bid % 8) * (C.G / 8) + C.bid / 8 : C.bid; g.G = C.G; g.wave = C.wave; g.r = C.lane & 31; g.hh = C.lane >> 5;
    asm volatile("s_waitcnt vmcnt(0)" ::: "memory");
    att::band_stream<5, 128, false, GetC>(C.lds, (1024 + C.G - 1) / C.G, g, C.tid, C.lane, C.wave);
}

__device__ __forceinline__ void combine_A(const Ctx& C) {
    const bf16_t* OG = WSP(bf16_t, WS_BIG + BIG_OG); const float* LSE = WSP(float, WS_LSE); bf16_t* O = WSP(bf16_t, WS_O);
    const int gw = C.bid * 8 + C.wave, NGW = C.G * 8, lane = C.lane, h = lane >> 2;
    for (int tok = gw; tok < NTOK; tok += NGW) {
        const float L0 = LSE[((size_t)0 * NTOK + tok) * 16 + h], L1 = LSE[((size_t)1 * NTOK + tok) * 16 + h], L2 = LSE[((size_t)2 * NTOK + tok) * 16 + h];
        const float M = fmaxf(L0, fmaxf(L1, L2));
        float w0 = exp2f(L0 - M), w1 = exp2f(L1 - M), w2 = exp2f(L2 - M); const float inv = 1.0f / (w0 + w1 + w2); w0 *= inv; w1 *= inv; w2 *= inv;
        u32x4 o8;
#pragma unroll
        for (int c = 0; c < 2; ++c) {
            const size_t off = (size_t)tok * DM + lane * 16 + c * 8;
            const u32x4 a = *(const u32x4*)(OG + off), b = *(const u32x4*)(OG + (size_t)NTOK * DM + off), d = *(const u32x4*)(OG + (size_t)2 * NTOK * DM + off);
            float f[8];
#pragma unroll
            for (int i = 0; i < 4; ++i) { f[2 * i] = w0 * bflo(a[i]) + w1 * bflo(b[i]) + w2 * bflo(d[i]); f[2 * i + 1] = w0 * bfhi(a[i]) + w1 * bfhi(b[i]) + w2 * bfhi(d[i]); }
            o8[2 * c] = pk_fp8x4(f[0], f[1], f[2], f[3]); o8[2 * c + 1] = pk_fp8x4(f[4], f[5], f[6], f[7]);
        }
        *(u32x4*)((unsigned char*)O + (size_t)tok * DM + lane * 16) = o8;
    }
}

template <int N, int MASK>
__device__ __forceinline__ void halve_step(float (&v)[64], int lane) {
    const bool up = (lane & MASK) != 0;
#pragma unroll
    for (int i = 0; i < N / 2; ++i) { const float keep = up ? v[i + N / 2] : v[i], send = up ? v[i] : v[i + N / 2]; v[i] = keep + __shfl_xor(send, MASK); }
}
__device__ __forceinline__ void moe_router(const Ctx& C, const float* gain, const float* router) {
    const bf16_t* X = WSP(bf16_t, WS_XB);
    LAS float* grt = (LAS float*)C.lds;
    LAS int* tE = (LAS int*)(C.lds + 32768); LAS float* tG0 = (LAS float*)(C.lds + 32768 + 256); LAS float* tG1 = (LAS float*)(C.lds + 32768 + 512);
    for (int i = C.tid; i < 8192; i += 512) { const int k = i >> 3, e = i & 7; grt[e * 1024 + k] = gain[k] * router[i]; }
    __syncthreads();
    int* gE = WSP(int, WS_TOK + TOK_E); float* gG0 = WSP(float, WS_TOK + TOK_G0); float* gG1 = WSP(float, WS_TOK + TOK_G1); int* gR = WSP(int, WS_TOK + TOK_RANK); int* hist = WSP(int, WS_TOK + TOK_HIST);
    const int lane = C.lane;
    for (int chunk = C.bid; chunk < NTOK / 64; chunk += C.G) {
        float v[64]; float sv[64];
        u32x2 raw[8][4];
#pragma unroll
        for (int j = 0; j < 8; ++j) { const u32x2* xr = (const u32x2*)(X + (size_t)(chunk * 64 + C.wave * 8 + j) * DM) + lane;
#pragma unroll
            for (int jj = 0; jj < 4; ++jj) raw[j][jj] = xr[64 * jj]; }
        asm volatile("" ::: "memory");
#pragma unroll
        for (int j = 0; j < 8; ++j) {
            f32x4 x[4]; float ss = 0.f;
#pragma unroll
            for (int jj = 0; jj < 4; ++jj) { const u32x2 w = raw[j][jj]; x[jj] = (f32x4){bflo(w.x), bfhi(w.x), bflo(w.y), bfhi(w.y)}; ss += (x[jj][0] * x[jj][0] + x[jj][1] * x[jj][1]) + (x[jj][2] * x[jj][2] + x[jj][3] * x[jj][3]); }
            sv[j] = ss;
#pragma unroll
            for (int e = 0; e < 8; ++e) { float a = 0.f;
#pragma unroll
                for (int jj = 0; jj < 4; ++jj) { const f32x4 w = *(const LAS f32x4*)(grt + e * 1024 + (64 * jj + lane) * 4); a += x[jj][0] * w[0]; a += x[jj][1] * w[1]; a += x[jj][2] * w[2]; a += x[jj][3] * w[3]; }
                v[j * 8 + e] = a; }
        }
        halve_step<64, 32>(v, lane); halve_step<32, 16>(v, lane); halve_step<16, 8>(v, lane); halve_step<8, 4>(v, lane); halve_step<4, 2>(v, lane); halve_step<2, 1>(v, lane);
        halve_step<8, 32>(sv, lane); halve_step<4, 16>(sv, lane); halve_step<2, 8>(sv, lane);
        float ss = sv[0]; ss += __shfl_xor(ss, 1); ss += __shfl_xor(ss, 2); ss += __shfl_xor(ss, 4);
        const float rstd = 1.0f / sqrtf(ss * (1.0f / 1024.0f) + NORM_EPS);
        const float val = v[0]; const int idx = lane & 7;
        float v0 = val; int e0 = idx;
#pragma unroll
        for (int o = 1; o < 8; o <<= 1) { const float ov = __shfl_xor(v0, o); const int oi = __shfl_xor(e0, o); if (ov > v0 || (ov == v0 && oi < e0)) { v0 = ov; e0 = oi; } }
        float v1 = (idx == e0) ? -INFINITY : val; int e1 = idx;
#pragma unroll
        for (int o = 1; o < 8; o <<= 1) { const float ov = __shfl_xor(v1, o); const int oi = __shfl_xor(e1, o); if (ov > v1 || (ov == v1 && oi < e1)) { v1 = ov; e1 = oi; } }
        const float ex = expf((v1 - v0) * rstd), g0 = 1.0f / (1.0f + ex), g1 = ex / (1.0f + ex);
        if (idx == 0) { const int tl = C.wave * 8 + (lane >> 3); tE[tl] = e0 | (e1 << 8); tG0[tl] = g0; tG1[tl] = g1; }
        __syncthreads();
        if (C.wave == 0) {
            const int ee = tE[C.lane], f0 = ee & 255, f1 = ee >> 8; int r0 = 0, r1 = 0;
            const unsigned long long lt = (1ull << C.lane) - 1ull;
#pragma unroll
            for (int e = 0; e < 8; ++e) {
                const unsigned long long b0 = __ballot(f0 == e), b1 = __ballot(f1 == e);
                const int before = __popcll(b0 & lt) + __popcll(b1 & lt);
                if (f0 == e) r0 = before; if (f1 == e) r1 = before;
                if (C.lane == 0) hist[chunk * 8 + e] = __popcll(b0) + __popcll(b1);
            }
            const int tok = chunk * 64 + C.lane;
            gE[tok] = ee; gG0[tok] = tG0[C.lane]; gG1[tok] = tG1[C.lane]; gR[tok] = r0 | (r1 << 16);
        }
        __syncthreads();
    }
}
__device__ __forceinline__ void moe_gather(const Ctx& C) {
    const bf16_t* X = WSP(bf16_t, WS_XB); unsigned char* XBUF = WSP(unsigned char, WS_BIG + BIG_XBUF);
    const int* gE = WSP(int, WS_TOK + TOK_E); const int* gR = WSP(int, WS_TOK + TOK_RANK); const int* hist = WSP(int, WS_TOK + TOK_HIST);
    int* gD0 = WSP(int, WS_TOK + TOK_D0); int* gD1 = WSP(int, WS_TOK + TOK_D1); int* pendg = WSP(int, WS_TOK + TOK_PEND);
    LAS int* pre = (LAS int*)C.lds;
    LAS int* tot = (LAS int*)(C.lds + 8192);
    {
        const int e = C.wave; int h4[4]; int s = 0;
#pragma unroll
        for (int i = 0; i < 4; ++i) { h4[i] = hist[(4 * C.lane + i) * 8 + e]; s += h4[i]; }
        int inc = s;
#pragma unroll
        for (int o = 1; o < 64; o <<= 1) { const int t = __shfl_up(inc, o); if (C.lane >= o) inc += t; }
        int ex = inc - s;
#pragma unroll
        for (int i = 0; i < 4; ++i) { pre[(4 * C.lane + i) * 8 + e] = ex; ex += h4[i]; }
        if (C.lane == 63) tot[e] = inc;
    }
    __syncthreads();
    if (C.tid == 0) { int p = 0; for (int e = 0; e < 8; ++e) { tot[8 + e] = p; p += ((tot[e] + 255) >> 8) << 8; tot[16 + e] = p; } }
    __syncthreads();
    if (C.bid == 0 && C.tid < 8) pendg[C.tid] = tot[16 + C.tid];
    if (C.bid == 0 && C.tid == 8) pendg[8] = tot[23] >> 8;
    for (int chunk = C.bid; chunk < NTOK / 64; chunk += C.G) {
        for (int tl = C.wave * 8; tl < C.wave * 8 + 8; ++tl) {
            const int tok = chunk * 64 + tl;
            const int ee = gE[tok], e0 = ee & 255, e1 = ee >> 8, rr = gR[tok];
            const int d0 = tot[8 + e0] + pre[chunk * 8 + e0] + (rr & 0xffff), d1 = tot[8 + e1] + pre[chunk * 8 + e1] + (rr >> 16);
            if (C.lane == 0) { gD0[tok] = d0; gD1[tok] = d1; }
            const u32x2* xr = (const u32x2*)(X + (size_t)tok * DM) + C.lane;
            f32x4 v[4]; float ss = 0.f;
#pragma unroll
            for (int j = 0; j < 4; ++j) { const u32x2 w = xr[64 * j]; v[j] = (f32x4){bflo(w.x), bfhi(w.x), bflo(w.y), bfhi(w.y)}; ss += (v[j][0] * v[j][0] + v[j][1] * v[j][1]) + (v[j][2] * v[j][2] + v[j][3] * v[j][3]); }
            const float rstd = 1.0f / sqrtf(wave_sum(ss) * (1.0f / 1024.0f) + NORM_EPS);
            unsigned* o0 = (unsigned*)(XBUF + (size_t)d0 * DM) + C.lane; unsigned* o1 = (unsigned*)(XBUF + (size_t)d1 * DM) + C.lane;
#pragma unroll
            for (int j = 0; j < 4; ++j) { const unsigned w = pk_fp8x4(v[j][0] * rstd, v[j][1] * rstd, v[j][2] * rstd, v[j][3] * rstd); o0[64 * j] = w; o1[64 * j] = w; }
        }
    }
    if (C.bid < 8) {
        const int e = C.bid, r0 = tot[8 + e] + tot[e], r1 = tot[16 + e];
        for (int i = C.tid; i < (r1 - r0) * 64; i += 512) *((u32x4*)(XBUF + (size_t)r0 * DM) + i) = (u32x4){0u, 0u, 0u, 0u};
    }
}
template <bool FINAL>
__device__ __forceinline__ void moe_combine(const Ctx& C, const float* gfinal) {
    bf16_t* XB = WSP(bf16_t, WS_XB); float* ssq = WSP(float, WS_SSQ); const bf16_t* Y = WSP(bf16_t, WS_BIG + BIG_YBUF);
    const float* gG0 = WSP(float, WS_TOK + TOK_G0); const float* gG1 = WSP(float, WS_TOK + TOK_G1); const int* gD0 = WSP(int, WS_TOK + TOK_D0); const int* gD1 = WSP(int, WS_TOK + TOK_D1);
    const int gw = C.bid * 8 + C.wave, NGW = C.G * 8;
    for (int tok = gw; tok < NTOK; tok += NGW) {
        const float g0 = gG0[tok], g1 = gG1[tok]; const int d0 = gD0[tok], d1 = gD1[tok];
        const u32x2* xr = (const u32x2*)(XB + (size_t)tok * DM) + C.lane;
        const u32x2* y0 = (const u32x2*)(Y + (size_t)d0 * DM) + C.lane; const u32x2* y1 = (const u32x2*)(Y + (size_t)d1 * DM) + C.lane;
        f32x4 v[4]; float ss = 0.f;
#pragma unroll
        for (int j = 0; j < 4; ++j) { const u32x2 xw = xr[64 * j]; const f32x4 x = (f32x4){bflo(xw.x), bfhi(xw.x), bflo(xw.y), bfhi(xw.y)}; const u32x2 a = y0[64 * j], b = y1[64 * j];
            v[j][0] = x[0] + g0 * bflo(a.x) + g1 * bflo(b.x); v[j][1] = x[1] + g0 * bfhi(a.x) + g1 * bfhi(b.x);
            v[j][2] = x[2] + g0 * bflo(a.y) + g1 * bflo(b.y); v[j][3] = x[3] + g0 * bfhi(a.y) + g1 * bfhi(b.y);
            ss += (v[j][0] * v[j][0] + v[j][1] * v[j][1]) + (v[j][2] * v[j][2] + v[j][3] * v[j][3]); }
        const float tot = wave_sum(ss);
        if (FINAL) {
            const float rstd = 1.0f / sqrtf(tot * (1.0f / 1024.0f) + NORM_EPS);
            f32x4* o = (f32x4*)(C.out + (size_t)tok * DM) + C.lane; const f32x4* gf = (const f32x4*)gfinal + C.lane;
#pragma unroll
            for (int j = 0; j < 4; ++j) { const f32x4 g = gf[64 * j]; o[64 * j] = v[j] * rstd * g; }
        } else {
            u32x2* bo = (u32x2*)(XB + (size_t)tok * DM) + C.lane;
#pragma unroll
            for (int j = 0; j < 4; ++j) { u32x2 w; w.x = pk2(v[j][0], v[j][1]); w.y = pk2(v[j][2], v[j][3]); bo[64 * j] = w; }
            write_ssq_row(ssq, tok, tot, C.lane);
        }
    }
}

constexpr int RTAB_OFF = 134144, RTAB_UNITS = 13;
template <class Epi, bool FP8 = false>
__device__ __forceinline__ void dense_gemm(const Ctx& C, const bf16_t* A, const bf16_t* Bt, int M, int N, int K, const Epi& E, const float* ssq = nullptr, int sx = SC_ONE) {
    pg8::Gemm g{A, Bt, M, N, FP8 ? K / 2 : K, 0, SC_W8, sx}; pg8::StaticOrder S; S.init(M, N, C.G, C.bid);
    if (ssq) {
        LAS float* tab = (LAS float*)(C.lds + RTAB_OFF); pg8::Unit u;
        for (int i = C.tid >> 8; i < RTAB_UNITS && S.next(i, u); i += 2) tab[i * 256 + (C.tid & 255)] = pg8::row_rstd(ssq, u.pm * 256 + (C.tid & 255));
        __syncthreads();
    }
    pg8::gemm_phase<Epi, pg8::StaticOrder, FP8>(C.lds, g, S, E);
}
template <class Epi>
__device__ __forceinline__ void moe_gemm(const Ctx& C, const bf16_t* A, const bf16_t* Bt, int NC, int K, const Epi& E) {
    const int* pendg = WSP(int, WS_TOK + TOK_PEND);
    pg8::GroupedOrder S; S.NC = NC; S.G = C.G; S.c = C.bid;
#pragma unroll
    for (int e = 0; e < 8; ++e) S.pend[e] = __builtin_amdgcn_readfirstlane(pendg[e]);
    S.RT = __builtin_amdgcn_readfirstlane(pendg[8]);
    pg8::Gemm g{A, Bt, S.RT * 256, NC * 256, K / 2, 0, SC_W8, SC_ONE};
    pg8::gemm_phase<Epi, pg8::GroupedOrder, true>(C.lds, g, S, E);
}

constexpr int DOWN_NSL = 7, DOWN_SNT = 4;
__device__ __forceinline__ void moe_gemm_down(const Ctx& C, const bf16_t* A, const bf16_t* Bt, bf16_t* Y, float* part) {
    const int* pendg = WSP(int, WS_TOK + TOK_PEND);
    pg8::GroupedOrderK S; S.NC = 4; S.G = C.G; S.c = C.bid; S.NSL = DOWN_NSL; S.SNT = DOWN_SNT;
#pragma unroll
    for (int e = 0; e < 8; ++e) S.pend[e] = __builtin_amdgcn_readfirstlane(pendg[e]);
    S.RT = __builtin_amdgcn_readfirstlane(pendg[8]);
    const int full = 2 * C.G / 4, rtf = S.RT < full ? S.RT : full;
    pg8::Gemm g{A, Bt, S.RT * 256, 1024, FFE / 2, 0, SC_W8, SC_H8};
    pg8::EpiPlainK E{Y, DM, part, rtf, DOWN_NSL};
    pg8::gemm_phase<pg8::EpiPlainK, pg8::GroupedOrderK, true>(C.lds, g, S, E);
}
__device__ __forceinline__ void moe_down_reduce(const Ctx& C, bf16_t* Y, const float* part) {
    const int* pendg = WSP(int, WS_TOK + TOK_PEND);
    const int RT = pendg[8], full = 2 * C.G / 4, rtf = RT < full ? RT : full;
    const int nitems = (RT - rtf) * 256 * 128;
    for (int it = C.bid * 512 + C.tid; it < nitems; it += C.G * 512) {
        const int cg = it & 127, row = it >> 7, trel = row >> 8, lr = row & 255, ct = cg >> 5, lc = (cg & 31) * 8;
        const float* p = part + (size_t)((trel * 4 + ct) * DOWN_NSL) * 65536 + (size_t)lr * 256 + lc;
        f32x4 a = (f32x4){0.f, 0.f, 0.f, 0.f}, b = a;
#pragma unroll
        for (int ks = 0; ks < DOWN_NSL; ++ks) { a += *(const f32x4*)(p + (size_t)ks * 65536); b += *(const f32x4*)(p + (size_t)ks * 65536 + 4); }
        u32x4 w; w.x = pk2(a[0], a[1]); w.y = pk2(a[2], a[3]); w.z = pk2(b[0], b[1]); w.w = pk2(b[2], b[3]);
        *(u32x4*)(Y + (size_t)((rtf + trel) * 256 + lr) * DM + ct * 256 + lc) = w;
    }
}

constexpr int N_PHASES = 29;
struct Args { const void* in[39]; float* out; unsigned char* ws; int ph_lo, ph_hi; };

__global__ void __launch_bounds__(512, 2) fwd_kernel(Args args) {
    extern __shared__ __attribute__((aligned(16))) unsigned char lds_raw[];
    Ctx C0;
    C0.lds = (LAS unsigned char*)lds_raw; C0.ws = args.ws; C0.in = args.in; C0.out = args.out;
    C0.tid = threadIdx.x; C0.lane = C0.tid & 63; C0.wave = __builtin_amdgcn_readfirstlane(C0.tid >> 6); C0.G = gridDim.x; C0.bid = blockIdx.x;
    const Ctx& C = C0;
    volatile LAS unsigned* MISC = (volatile LAS unsigned*)(C.lds + MISC_OFF);
    for (int u = C.tid; u < (LDS_BYTES - RING_BYTES) / 4; u += 512) ((LAS unsigned*)(C.lds + RING_BYTES))[u] = 0u;
    __syncthreads();
    XcdBarrier bar; bar.bar = WSP(unsigned, WS_CTL) + CW_BAR; bar.x = 0; bar.st = nullptr;
    if (MK_SINGLE) bar = xcd_barrier_post(WSP(unsigned, WS_CTL) + CW_BAR, MISC + 8);
    const int lo = args.ph_lo, hi = args.ph_hi;
#define IN(k) (lo <= (k) && (k) < hi)
#define SEAM(k) do { if (IN(k) && IN((k) + 1)) xcd_barrier(bar); else __syncthreads(); } while (0)
#define PHASE(k, ...) if (IN(k)) { Ctx C = C0; { int t_ = (int)threadIdx.x; asm volatile("" : "+v"(t_)); C.tid = t_; C.lane = t_ & 63; } { __VA_ARGS__ } if (PROBE_PHASE == (k)) { xcd_barrier(bar); { __VA_ARGS__ } } } SEAM(k);

    const LAS float* const RTAB = (const LAS float*)(C.lds + RTAB_OFF);
    bf16_t* const XB = WSP(bf16_t, WS_XB); float* const SSQ = WSP(float, WS_SSQ); const float* const ROPE = WSP(float, WS_ROPE);
    bf16_t* const QKV = WSP(bf16_t, WS_BIG + BIG_QKV); bf16_t* const OB = WSP(bf16_t, WS_O); bf16_t* const HB = WSP(bf16_t, WS_BIG + BIG_H);
    bf16_t* const XBUF = WSP(bf16_t, WS_BIG + BIG_XBUF); bf16_t* const YBUF = WSP(bf16_t, WS_BIG + BIG_YBUF); bf16_t* const HBUF = WSP(bf16_t, WS_BIG + BIG_HBUF);

    PHASE(0, convert_weights_first(C); rope_table(C); x_to_bf16(C);)
    PHASE(1, pg8::EpiQKV E{QKV, NQKV_A, RTAB, ROPE, 3072, 2048, nullptr, (unsigned char*)QKV, 1}; dense_gemm<pg8::EpiQKV, true>(C, WSP(bf16_t, WS_X8), WSP(bf16_t, WS_WQKV0), NTOK, NQKV_A, DM, E, SSQ, SC_ONE);)
    PHASE(2, attn_A8(C);)
    PHASE(3, combine_A(C);)
    PHASE(4, pg8::EpiRes E{XB, SSQ, DM, nullptr}; dense_gemm<pg8::EpiRes, true>(C, OB, WSP(bf16_t, WS_WO0), NTOK, DM, DM, E, nullptr, SC_ONE);)
    PHASE(5, pg8::EpiSwiGLU E{HB, FF, RTAB}; dense_gemm(C, XB, WSP(bf16_t, WS_W13_0), NTOK, 2 * FF, DM, E, SSQ);)
    PHASE(6, pg8::EpiRes E{XB, SSQ, DM, nullptr}; dense_gemm(C, HB, WSP(bf16_t, WS_W2_0), NTOK, DM, FF, E);)
    PHASE(7, pg8::EpiQKV E{QKV, NQKV_B, RTAB, ROPE, 3072, 2048, nullptr, (unsigned char*)QKV}; dense_gemm(C, XB, WSP(bf16_t, WS_WQKV1), NTOK, NQKV_B, DM, E, SSQ);)
    PHASE(8, attn_B(C);)
    PHASE(9, pg8::EpiRes E{XB, SSQ, DM, nullptr}; dense_gemm(C, OB, WSP(bf16_t, WS_WO1), NTOK, DM, DM, E);)
    PHASE(10, moe_router(C, IN_F(17), IN_F(18));)
    PHASE(11, moe_gather(C);)
    PHASE(12, pg8::EpiSwiGLU8 E{(unsigned char*)HBUF, FFE}; moe_gemm(C, XBUF, WSP(bf16_t, WS_WM13), 2 * FFE / 256, DM, E);)
    PHASE(13, moe_gemm_down(C, HBUF, WSP(bf16_t, WS_WM2), YBUF, WSP(float, WS_BIG + BIG_XBUF));)
    PHASE(14, moe_down_reduce(C, YBUF, WSP(float, WS_BIG + BIG_XBUF)); xcd_barrier(bar); moe_combine<false>(C, nullptr); convert_weights_second(C);)
    PHASE(15, pg8::EpiQKV E{QKV, NQKV_C, RTAB, ROPE, 4096, 1152, nullptr, (unsigned char*)QKV}; dense_gemm(C, XB, WSP(bf16_t, WS_WQKV2), NTOK, NQKV_C, DM, E, SSQ);)
    PHASE(16, attn_C8(C);)
    PHASE(17, pg8::EpiRes E{XB, SSQ, DM, nullptr}; dense_gemm<pg8::EpiRes, true>(C, OB, WSP(bf16_t, WS_WO2), NTOK, DM, DM, E, nullptr, SC_ONE);)
    PHASE(18, pg8::EpiSwiGLU E{HB, FF, RTAB}; dense_gemm(C, XB, WSP(bf16_t, WS_W13_2), NTOK, 2 * FF, DM, E, SSQ);)
    PHASE(19, pg8::EpiRes E{XB, SSQ, DM, WSP(unsigned char, WS_X8)}; dense_gemm(C, HB, WSP(bf16_t, WS_W2_2), NTOK, DM, FF, E);)
    PHASE(20, pg8::EpiQKV E{QKV, NQKV_A, RTAB, ROPE, 3072, 2048, nullptr, (unsigned char*)QKV, 1}; dense_gemm<pg8::EpiQKV, true>(C, WSP(bf16_t, WS_X8), WSP(bf16_t, WS_WQKV3), NTOK, NQKV_A, DM, E, SSQ, SC_ONE);)
    PHASE(21, attn_A8(C);)
    PHASE(22, combine_A(C);)
    PHASE(23, pg8::EpiRes E{XB, SSQ, DM, nullptr}; dense_gemm<pg8::EpiRes, true>(C, OB, WSP(bf16_t, WS_WO3), NTOK, DM, DM, E, nullptr, SC_ONE);)
    PHASE(24, moe_router(C, IN_F(33), IN_F(34));)
    PHASE(25, moe_gather(C);)
    PHASE(26, pg8::EpiSwiGLU8 E{(unsigned char*)HBUF, FFE}; moe_gemm(C, XBUF, WSP(bf16_t, WS_WM13), 2 * FFE / 256, DM, E);)
    PHASE(27, moe_gemm_down(C, HBUF, WSP(bf16_t, WS_WM2), YBUF, WSP(float, WS_BIG + BIG_XBUF));)
    if (IN(28)) { Ctx C = C0; { int t_ = (int)threadIdx.x; asm volatile("" : "+v"(t_)); C.tid = t_; C.lane = t_ & 63; } moe_down_reduce(C, YBUF, WSP(float, WS_BIG + BIG_XBUF)); xcd_barrier(bar); moe_combine<true>(C, IN_F(38)); }
#undef IN
#undef SEAM
#undef PHASE
}

extern "C" void kernel_launch(void* const* d_in, const int* in_sizes, int n_in, void* d_out, int out_size, void* d_ws, size_t ws_size, hipStream_t stream) {
    static int grid = 0;
    if (grid == 0) {
        if (n_in != 39 || out_size != NTOK * DM || ws_size < WS_END) { fprintf(stderr, "kernel_launch: unexpected shapes (n_in %d out %d ws %zu)\n", n_in, out_size, ws_size); grid = -1; return; }
        int dev = 0, cus = 0, per_cu = 0;
        if (hipGetDevice(&dev) != hipSuccess || hipDeviceGetAttribute(&cus, hipDeviceAttributeMultiprocessorCount, dev) != hipSuccess) { grid = -1; return; }
        if (hipFuncSetAttribute((const void*)fwd_kernel, hipFuncAttributeMaxDynamicSharedMemorySize, LDS_BYTES) != hipSuccess) { grid = -1; return; }
        if (hipOccupancyMaxActiveBlocksPerMultiprocessor(&per_cu, (const void*)fwd_kernel, 512, LDS_BYTES) != hipSuccess || per_cu < 1) { fprintf(stderr, "kernel_launch: occupancy query says %d\n", per_cu); }
        (void)hipGetLastError();
        grid = cus;
    }
    if (grid < 0) return;
    if (hipMemsetAsync((char*)d_ws + WS_CTL, 0, CTL_ZERO_BYTES, stream) != hipSuccess) return;
    Args a{};
    for (int i = 0; i < 39; ++i) a.in[i] = d_in[i];
    a.out = (float*)d_out; a.ws = (unsigned char*)d_ws;
#if MK_SINGLE
    a.ph_lo = 0; a.ph_hi = N_PHASES;
    hipLaunchKernelGGL(fwd_kernel, dim3(grid), dim3(512), LDS_BYTES, stream, a);
#else
    for (int p = 0; p < N_PHASES; ++p) { a.ph_lo = p; a.ph_hi = p + 1; hipLaunchKernelGGL(fwd_kernel, dim3(grid), dim3(512), LDS_BYTES, stream, a); }
#endif
}
```

```cpp
#include <hip/hip_runtime.h>
#include <cstdio>
#include <cstdint>
#include <cmath>

#ifndef MK_SINGLE
#define MK_SINGLE 1
#endif
#ifndef PROBE_PHASE
#define PROBE_PHASE -1
#endif

#define LAS __attribute__((address_space(3)))
#define GAS __attribute__((address_space(1)))
typedef unsigned short bf16_t;
typedef short bf16x8 __attribute__((ext_vector_type(8)));
typedef float f32x4 __attribute__((ext_vector_type(4)));
typedef float f32x2 __attribute__((ext_vector_type(2)));
typedef unsigned u32x4 __attribute__((ext_vector_type(4)));
typedef unsigned u32x2 __attribute__((ext_vector_type(2)));

constexpr int NTOK = 16384, SEQ = 8192, DM = 1024;
constexpr int NQKV_A = 9216, NQKV_B = 3072, NQKV_C = 1280;
constexpr int FF = 2816, FFE = 3584, NEXP = 8;
constexpr int MOE_ROWS = 32768 + 2048;
constexpr float LOG2E = 1.4426950408889634f;
constexpr float C2 = 0.125f * 1.4426950408889634f;
constexpr float NORM_EPS = 1e-6f, SUBLN_EPS = 1e-5f;
constexpr float LAMBDA_INIT = 0.35550906759096926f;

constexpr size_t MiB = 1u << 20;
constexpr size_t WS_CTL = 0, CTL_ZERO_BYTES = 1 * MiB;
constexpr size_t WS_ROPE = 1 * MiB;
constexpr size_t WS_SSQ = 2 * MiB;
constexpr size_t WS_TOK = 3 * MiB;
constexpr size_t WS_LSE = 4 * MiB;
constexpr size_t WS_WQKV0 = 8 * MiB, WS_WO0 = 26 * MiB, WS_W13_0 = 28 * MiB, WS_W2_0 = 39 * MiB;
constexpr size_t WS_WQKV1 = 45 * MiB, WS_WO1 = 51 * MiB;
constexpr size_t WS_WQKV2 = 53 * MiB, WS_WO2 = 56 * MiB, WS_W13_2 = 58 * MiB, WS_W2_2 = 69 * MiB;
constexpr size_t WS_WQKV3 = 75 * MiB, WS_WO3 = 93 * MiB;
constexpr size_t WS_WM13 = 96 * MiB, WS_WM2 = 208 * MiB;
constexpr size_t WS_X = 264 * MiB, WS_XB = 328 * MiB, WS_O = 360 * MiB, WS_BIG = 392 * MiB, WS_END = 776 * MiB;
constexpr size_t WS_VT8 = WS_X + 16 * MiB;
constexpr size_t WS_X8 = WS_X;
constexpr size_t BIG_QKV = 0, BIG_OG = 288 * MiB, BIG_H = 0, BIG_XBUF = 0, BIG_YBUF = 68 * MiB, BIG_HBUF = 136 * MiB;
constexpr size_t TOK_E = 0, TOK_G0 = 64 * 1024, TOK_G1 = 128 * 1024, TOK_RANK = 192 * 1024, TOK_D0 = 256 * 1024, TOK_D1 = 320 * 1024, TOK_HIST = 512 * 1024, TOK_PEND = 600 * 1024;
constexpr int CW_BAR = 4096;

constexpr int RING_BYTES = 131072;
constexpr int MISC_OFF = RING_BYTES + 320;
constexpr int LDS_BYTES = 147456;

__device__ __forceinline__ unsigned f2bf(float f) { unsigned u = __builtin_bit_cast(unsigned, f); return (u + 0x7fffu + ((u >> 16) & 1u)) >> 16; }
__device__ __forceinline__ unsigned pk2(float lo, float hi) { return f2bf(lo) | (f2bf(hi) << 16); }
__device__ __forceinline__ float bf2f(unsigned short b) { return __builtin_bit_cast(float, (unsigned)b << 16); }
__device__ __forceinline__ float bflo(unsigned w) { return __builtin_bit_cast(float, w << 16); }
__device__ __forceinline__ float bfhi(unsigned w) { return __builtin_bit_cast(float, w & 0xffff0000u); }
__device__ __forceinline__ float wave_sum(float v) {
#pragma unroll
    for (int o = 1; o < 64; o <<= 1) v += __shfl_xor(v, o);
    return v;
}
__device__ __forceinline__ float wave_max(float v) {
#pragma unroll
    for (int o = 1; o < 64; o <<= 1) v = fmaxf(v, __shfl_xor(v, o));
    return v;
}
#define LDS_WAIT() asm volatile("s_waitcnt lgkmcnt(0)" ::: "memory")
__device__ __forceinline__ unsigned pk_fp8x4(float a, float b, float c, float d) {
    a = fminf(fmaxf(a, -448.f), 448.f); b = fminf(fmaxf(b, -448.f), 448.f); c = fminf(fmaxf(c, -448.f), 448.f); d = fminf(fmaxf(d, -448.f), 448.f);
    int p = __builtin_bit_cast(int, a); p = __builtin_amdgcn_cvt_pk_fp8_f32(a, b, p, false); p = __builtin_amdgcn_cvt_pk_fp8_f32(c, d, p, true); return (unsigned)p;
}
__device__ __forceinline__ unsigned pk_fp8x4_nc(float a, float b, float c, float d) {
    int p; asm volatile("" : "=v"(p));
    p = __builtin_amdgcn_cvt_pk_fp8_f32(a, b, p, false); p = __builtin_amdgcn_cvt_pk_fp8_f32(c, d, p, true); return (unsigned)p;
}
__device__ __forceinline__ unsigned char fp8_byte(float x) { x = fminf(fmaxf(x, -448.f), 448.f); return (unsigned char)__builtin_amdgcn_cvt_pk_fp8_f32(x, x, 0, false); }
constexpr float W8_SCALE = 64.0f, H8_SCALE = 8.0f;
constexpr int SC_ONE = 0x7f7f7f7f, SC_W8 = 0x79797979, SC_H8 = 0x7c7c7c7c;

namespace pg8 {
#define PG8_LAS __attribute__((address_space(3)))
constexpr int BM = 256, BK = 64, HALF = 128, HTB = HALF * BK * 2, STAGE_BYTES = 8 * HTB, NXCD = 8, WGM = 8;

__host__ __device__ __forceinline__ int lds_byte(int r, int c) { const int st = (r >> 4) * 2 + (c >> 5), rr = r & 15, cc = c & 31, ob = rr * 64 + cc * 2; return st * 1024 + (ob ^ (((ob >> 9) & 1) << 5)); }
__host__ __device__ __forceinline__ void stage_rc(int b, int& R, int& C) { const int st = b / 1024, sb = b % 1024, swz = sb ^ (((sb >> 9) & 1) << 5); R = (st >> 1) * 16 + swz / 64; C = (st & 1) * 32 + (swz % 64) / 2; }
__host__ __device__ __forceinline__ int perm32(int rho) { const int n = rho >> 4, i = rho & 15; return 8 * (i >> 2) + 4 * n + (i & 3); }

__device__ __forceinline__ void glds16s(unsigned voff, unsigned long long sbase, unsigned lds_dst) { unsigned keep;
    asm volatile("s_mov_b32 %0, m0\n\ts_mov_b32 m0, %2\n\ts_nop 0\n\tglobal_load_lds_dwordx4 %1, %3\n\ts_mov_b32 m0, %0" : "=&s"(keep) : "v"(voff), "s"(lds_dst), "s"(sbase) : "memory"); }
struct Unit { int pm, pn, pc, koff, nt, mode; };
struct Gemm { const bf16_t* A; const bf16_t* Bt; int M, N, K, ld, sw, sx; };

struct StaticOrder {
    int nM, nN, nwg, G, c;
    __host__ __device__ void init(int M, int N, int G_, int c_) { nM = M / BM; nN = N / BM; nwg = nM * nN; G = G_; c = c_; }
    __host__ __device__ bool next(int i, Unit& u) const {
        const long L = (long)i * G + c; if (L >= nwg) return false;
        int wgid = (int)L; { const int q = nwg / NXCD, r = nwg % NXCD, xcd = wgid % NXCD, off = wgid / NXCD; wgid = (xcd < r ? xcd * (q + 1) : r * (q + 1) + (xcd - r) * q) + off; }
        const int nig = WGM * nN, gid = wgid / nig, fm = gid * WGM, gsz = (nM - fm) < WGM ? (nM - fm) : WGM;
        u.pm = fm + ((wgid % nig) % gsz); u.pn = (wgid % nig) / gsz; u.pc = u.pn; u.koff = 0; u.nt = 0; u.mode = 0; return true;
    }
};
struct GroupedOrder {
    int RT, NC, G, c; int pend[8];
    __device__ bool next(int i, Unit& u) const {
        const long L = (G % 8 == 0) ? ((long)(i * 8 + (c & 7)) * (G >> 3) + (c >> 3)) : ((long)i * G + c);
        if (L >= (long)RT * NC) return false;
        const int per = 8 * NC, blk = (int)(L / per), rem = (int)(L % per), rows = (RT - 8 * blk) < 8 ? (RT - 8 * blk) : 8;
        const int ct = rem / rows, rt = 8 * blk + rem % rows;
        int e = 0;
#pragma unroll
        for (int k = 0; k < 7; ++k) e += (rt * 256 >= pend[k]) ? 1 : 0;
        u.pm = rt; u.pn = e * NC + ct; u.pc = ct; u.koff = 0; u.nt = 0; u.mode = 0; return true;
    }
};
struct GroupedOrderK {
    int RT, NC, G, c, NSL, SNT; int pend[8];
    __device__ bool next(int i, Unit& u) const {
        const long L = (long)(i * 8 + (c & 7)) * (G >> 3) + (c >> 3);
        const int full = 2 * G / NC, RTF = RT < full ? RT : full;
        int rt, ct; u.koff = 0; u.nt = 0; u.mode = 0;
        if (L < (long)RTF * NC) {
            const int per = 8 * NC, blk = (int)(L / per), rem = (int)(L % per), rows = (RTF - 8 * blk) < 8 ? (RTF - 8 * blk) : 8;
            ct = rem / rows; rt = 8 * blk + rem % rows;
        } else {
            const long idx = L - (long)RTF * NC; if (idx >= (long)(RT - RTF) * NC * NSL) return false;
            const int su = (int)(idx / NSL), ks = (int)(idx % NSL);
            rt = RTF + su / NC; ct = su % NC; u.koff = ks * SNT * BK * 2; u.nt = SNT; u.mode = 1 + ks;
        }
        int e = 0;
#pragma unroll
        for (int k = 0; k < 7; ++k) e += (rt * 256 >= pend[k]) ? 1 : 0;
        u.pm = rt; u.pn = e * NC + ct; u.pc = ct; return true;
    }
};

typedef __bf16 bf16x2v __attribute__((ext_vector_type(2)));
__device__ __forceinline__ unsigned cvt_pk_bf16(float lo, float hi) { f32x2 v = {lo, hi}; bf16x2v b = __builtin_convertvector(v, bf16x2v); return __builtin_bit_cast(unsigned, b); }

__device__ __forceinline__ float row_rstd(const float* ssq, int row) {
    const f32x4* sp = (const f32x4*)(ssq + (size_t)row * 16);
    const f32x4 a = sp[0], b = sp[1], c = sp[2], d = sp[3];
    const float s = ((a[0] + a[1]) + (a[2] + a[3])) + ((b[0] + b[1]) + (b[2] + b[3])) + ((c[0] + c[1]) + (c[2] + c[3])) + ((d[0] + d[1]) + (d[2] + d[3]));
    return 1.0f / sqrtf(s * (1.0f / 1024.0f) + 1e-6f);
}
struct EpiQKV {
    static constexpr bool PERM = true;
    bf16_t* O; int ldc; const PG8_LAS float* rtab; const float* rope; int ropeMod, ropeLim; unsigned char* vt8; unsigned char* o8; int hm;
    __device__ __forceinline__ void operator()(const f32x4 (&acc)[2][2][4][2], const Unit& u, int ui, int wr, int wc, int fr, int fq) const {
        const int row0 = u.pm * BM + wr * 64 + fr;
        const int colh = wc * 32 + 8 * fq;
        const bool ropelane = ((wc & 1) == 0) && (fq < 2);
        const PG8_LAS float* rt = rtab + ui * 256 + wr * 64 + fr;
#pragma unroll
        for (int ai = 0; ai < 2; ++ai) {
            f32x4 cs[4], sn[4]; float rs[4];
#pragma unroll
            for (int m = 0; m < 4; ++m) {
                rs[m] = rt[ai * HALF + m * 16];
                cs[m] = (f32x4){1.f, 1.f, 1.f, 1.f}; sn[m] = (f32x4){0.f, 0.f, 0.f, 0.f};
                if (ropelane) { const float* rp = rope + (size_t)(row0 + ai * HALF + m * 16) * 16 + 4 * fq; cs[m] = *(const f32x4*)rp; sn[m] = *(const f32x4*)(rp + 8); }
            }
#pragma unroll
            for (int m = 0; m < 4; ++m) {
                const int row = row0 + ai * HALF + m * 16;
                const float r_ = rs[m]; const f32x4 c_ = cs[m], s_ = sn[m];
#pragma unroll
                for (int bj = 0; bj < 2; ++bj) {
                    const int colbase = u.pc * BM + bj * HALF;
                    f32x4 v0 = acc[ai][bj][m][0] * r_, v1 = acc[ai][bj][m][1] * r_;
                    if (ropelane && (colbase % ropeMod) < ropeLim) {
                        f32x4 w0, w1;
                        w0[0] = v0[0] * c_[0] - v0[1] * s_[0]; w0[1] = v0[1] * c_[0] + v0[0] * s_[0];
                        w0[2] = v0[2] * c_[1] - v0[3] * s_[1]; w0[3] = v0[3] * c_[1] + v0[2] * s_[1];
                        w1[0] = v1[0] * c_[2] - v1[1] * s_[2]; w1[1] = v1[1] * c_[2] + v1[0] * s_[2];
                        w1[2] = v1[2] * c_[3] - v1[3] * s_[3]; w1[3] = v1[3] * c_[3] + v1[2] * s_[3];
                        v0 = w0; v1 = w1;
                    }
                    if (o8) {
                        const float qs = ((colbase % 3072) < 1024) ? 16.0f : 1.0f;
                        u32x2 w8; w8.x = pk_fp8x4(v0[0] * qs, v0[1] * qs, v0[2] * qs, v0[3] * qs); w8.y = pk_fp8x4(v1[0] * qs, v1[1] * qs, v1[2] * qs, v1[3] * qs);
                        size_t off = (size_t)row * ldc + colbase + colh;
                        if (hm) { const int col = colbase + colh, blk = col >> 10, sh = 2 * ((blk * 11) >> 5), head = (col & 1023) >> 6, bb = row >> 13, t = row & (SEQ - 1);
                            off = (size_t)blk * ((size_t)NTOK * 1024) + (size_t)((bb * 16 + head) * SEQ + ((t & ((1 << sh) - 1)) << (13 - sh)) + (t >> sh)) * 64 + (col & 63); }
                        *(u32x2*)(o8 + off) = w8;
                    } else if (vt8 && colbase >= 2048) {
                        u32x2 w8; w8.x = pk_fp8x4(v0[0], v0[1], v0[2], v0[3]); w8.y = pk_fp8x4(v1[0], v1[1], v1[2], v1[3]);
                        *(u32x2*)(vt8 + (size_t)row * 1024 + (colbase - 2048) + colh) = w8;
                    } else {
                    u32x4 w; w.x = cvt_pk_bf16(v0[0], v0[1]); w.y = cvt_pk_bf16(v0[2], v0[3]); w.z = cvt_pk_bf16(v1[0], v1[1]); w.w = cvt_pk_bf16(v1[2], v1[3]);
                    *(u32x4*)(O + (size_t)row * ldc + colbase + colh) = w;
                    }
                }
            }
        }
    }
};
struct EpiSwiGLU {
    static constexpr bool PERM = true;
    bf16_t* O; int ldc; const PG8_LAS float* rtab;
    __device__ __forceinline__ void operator()(const f32x4 (&acc)[2][2][4][2], const Unit& u, int ui, int wr, int wc, int fr, int fq) const {
        const int row0 = u.pm * BM + wr * 64 + fr;
        const int col = u.pc * HALF + wc * 32 + 8 * fq;
#pragma unroll
        for (int ai = 0; ai < 2; ++ai)
#pragma unroll
            for (int m = 0; m < 4; ++m) {
                const int row = row0 + ai * HALF + m * 16;
                const float rs = rtab ? rtab[ui * 256 + wr * 64 + fr + ai * HALF + m * 16] : 1.0f;
                float h[8];
#pragma unroll
                for (int n = 0; n < 2; ++n)
#pragma unroll
                    for (int i = 0; i < 4; ++i) {
                        const float a = acc[ai][0][m][n][i] * rs, b = acc[ai][1][m][n][i] * rs;
                        h[n * 4 + i] = a * __builtin_amdgcn_rcpf(1.0f + __expf(-a)) * b;
                    }
                u32x4 w; w.x = cvt_pk_bf16(h[0], h[1]); w.y = cvt_pk_bf16(h[2], h[3]); w.z = cvt_pk_bf16(h[4], h[5]); w.w = cvt_pk_bf16(h[6], h[7]);
                *(u32x4*)(O + (size_t)row * ldc + col) = w;
            }
    }
};
struct EpiSwiGLU8 {
    static constexpr bool PERM = true;
    unsigned char* O; int ldc;
    __device__ __forceinline__ void operator()(const f32x4 (&acc)[2][2][4][2], const Unit& u, int ui, int wr, int wc, int fr, int fq) const {
        const int row0 = u.pm * BM + wr * 64 + fr;
        const int col = u.pc * HALF + wc * 32 + 8 * fq;
#pragma unroll
        for (int ai = 0; ai < 2; ++ai)
#pragma unroll
            for (int m = 0; m < 4; ++m) {
                const int row = row0 + ai * HALF + m * 16;
                float h[8];
#pragma unroll
                for (int n = 0; n < 2; ++n)
#pragma unroll
                    for (int i = 0; i < 4; ++i) { const float a = acc[ai][0][m][n][i], b = acc[ai][1][m][n][i]; h[n * 4 + i] = a * __builtin_amdgcn_rcpf(1.0f + __expf(-a)) * b * H8_SCALE; }
                u32x2 w; w.x = pk_fp8x4(h[0], h[1], h[2], h[3]); w.y = pk_fp8x4(h[4], h[5], h[6], h[7]);
                *(u32x2*)(O + (size_t)row * ldc + col) = w;
            }
    }
};
struct EpiRes {
    static constexpr bool PERM = false;
    bf16_t* XB; float* ssq; int ldc; unsigned char* X8;
    __device__ __forceinline__ void operator()(const f32x4 (&acc)[2][2][4][2], const Unit& u, int ui, int wr, int wc, int fr, int fq) const {
        const int row0 = u.pm * BM + wr * 64 + fr;
        const int col0 = u.pc * BM + wc * 32 + 4 * fq;
#pragma unroll
        for (int ai = 0; ai < 2; ++ai) {
            u32x2 rv[4][2][2];
#pragma unroll
            for (int m = 0; m < 4; ++m)
#pragma unroll
                for (int bj = 0; bj < 2; ++bj)
#pragma unroll
                    for (int n = 0; n < 2; ++n) rv[m][bj][n] = *(const u32x2*)(XB + (size_t)(row0 + ai * HALF + m * 16) * ldc + col0 + bj * HALF + n * 16);
#pragma unroll
            for (int m = 0; m < 4; ++m) {
                const int row = row0 + ai * HALF + m * 16;
                float q = 0.f;
#pragma unroll
                for (int bj = 0; bj < 2; ++bj)
#pragma unroll
                    for (int n = 0; n < 2; ++n) {
                        const size_t off = (size_t)row * ldc + col0 + bj * HALF + n * 16;
                        const u32x2 rr = rv[m][bj][n]; const f32x4 a = acc[ai][bj][m][n];
                        const float v0 = bflo(rr.x) + a[0], v1 = bfhi(rr.x) + a[1], v2 = bflo(rr.y) + a[2], v3 = bfhi(rr.y) + a[3];
                        q += (v0 * v0 + v1 * v1) + (v2 * v2 + v3 * v3);
                        u32x2 w; w.x = cvt_pk_bf16(v0, v1); w.y = cvt_pk_bf16(v2, v3); *(u32x2*)(XB + off) = w;
                        if (X8) *(unsigned*)(X8 + off) = pk_fp8x4(v0, v1, v2, v3);
                    }
                q += __shfl_xor(q, 16); q += __shfl_xor(q, 32);
                if (fq == 0) ssq[(size_t)row * 16 + u.pc * 4 + wc] = q;
            }
        }
    }
};
struct EpiPlain {
    static constexpr bool PERM = true;
    bf16_t* O; int ldc;
    __device__ __forceinline__ void operator()(const f32x4 (&acc)[2][2][4][2], const Unit& u, int ui, int wr, int wc, int fr, int fq) const {
        const int row0 = u.pm * BM + wr * 64 + fr;
        const int col0 = u.pc * BM + wc * 32 + 8 * fq;
#pragma unroll
        for (int ai = 0; ai < 2; ++ai)
#pragma unroll
            for (int m = 0; m < 4; ++m) {
                bf16_t* rowp = O + (size_t)(row0 + ai * HALF + m * 16) * ldc + col0;
#pragma unroll
                for (int bj = 0; bj < 2; ++bj) {
                    const f32x4 v0 = acc[ai][bj][m][0], v1 = acc[ai][bj][m][1];
                    u32x4 w; w.x = cvt_pk_bf16(v0[0], v0[1]); w.y = cvt_pk_bf16(v0[2], v0[3]); w.z = cvt_pk_bf16(v1[0], v1[1]); w.w = cvt_pk_bf16(v1[2], v1[3]);
                    *(u32x4*)(rowp + bj * HALF) = w;
                }
            }
    }
};

struct EpiPlainK {
    static constexpr bool PERM = true;
    bf16_t* O; int ldc; float* part; int rtf, nsl;
    __device__ __forceinline__ void operator()(const f32x4 (&acc)[2][2][4][2], const Unit& u, int ui, int wr, int wc, int fr, int fq) const {
        if (u.mode == 0) {
            const int row0 = u.pm * BM + wr * 64 + fr; const int col0 = u.pc * BM + wc * 32 + 8 * fq;
#pragma unroll
            for (int ai = 0; ai < 2; ++ai)
#pragma unroll
                for (int m = 0; m < 4; ++m) {
                    bf16_t* rowp = O + (size_t)(row0 + ai * HALF + m * 16) * ldc + col0;
#pragma unroll
                    for (int bj = 0; bj < 2; ++bj) {
                        const f32x4 v0 = acc[ai][bj][m][0], v1 = acc[ai][bj][m][1];
                        u32x4 w; w.x = cvt_pk_bf16(v0[0], v0[1]); w.y = cvt_pk_bf16(v0[2], v0[3]); w.z = cvt_pk_bf16(v1[0], v1[1]); w.w = cvt_pk_bf16(v1[2], v1[3]);
                        *(u32x4*)(rowp + bj * HALF) = w;
                    }
                }
        } else {
            float* pb = part + (size_t)(((u.pm - rtf) * 4 + u.pc) * nsl + (u.mode - 1)) * 65536 + (size_t)(wr * 64 + fr) * 256 + wc * 32 + 8 * fq;
#pragma unroll
            for (int ai = 0; ai < 2; ++ai)
#pragma unroll
                for (int m = 0; m < 4; ++m)
#pragma unroll
                    for (int bj = 0; bj < 2; ++bj) { float* p = pb + (size_t)(ai * HALF + m * 16) * 256 + bj * HALF; *(f32x4*)p = acc[ai][bj][m][0]; *(f32x4*)(p + 4) = acc[ai][bj][m][1]; }
        }
    }
};

typedef int v8i_t __attribute__((ext_vector_type(8)));
typedef int v4i_t __attribute__((ext_vector_type(4)));
__device__ __forceinline__ v8i_t cat32(bf16x8 lo, bf16x8 hi) { const v4i_t a = __builtin_bit_cast(v4i_t, lo), b = __builtin_bit_cast(v4i_t, hi); return __builtin_shufflevector(a, b, 0, 1, 2, 3, 4, 5, 6, 7); }
template <class Epi, class Sched, bool FP8 = false>
__device__ __forceinline__ void gemm_phase(PG8_LAS unsigned char* lds, const Gemm g, const Sched& S, const Epi& E) {
    const int tid = threadIdx.x, wid = __builtin_amdgcn_readfirstlane(tid >> 6), lane = tid & 63, wr = wid >> 2, wc = wid & 3, fr = lane & 15, fq = lane >> 4;
    const int sw_ = g.sw, sx_ = g.sx;
    const int K = g.ld ? g.ld : g.K, ntd = g.K / BK;
    unsigned voffA[2], voffB[2];
#pragma unroll
    for (int i = 0; i < 2; ++i) { int R, C; stage_rc(tid * 16 + i * 8192, R, C); const int Rb = Epi::PERM ? ((R & ~31) + perm32(R & 31)) : R;
        voffA[i] = (unsigned)(R * K + C) * 2u; voffB[i] = (unsigned)(Rb * K + C) * 2u; }
    const size_t kstep = (size_t)(BK * 2);
    const size_t hstep = (size_t)HALF * K * 2;
    const size_t tstep = 2 * hstep;
    const unsigned ldsw = (unsigned)wid * 1024u; const unsigned ldsb = (unsigned)(uintptr_t)lds;
    const int aoff = lds_byte(wr * 64 + fr, fq * 8), boff = lds_byte(wc * 32 + fr, fq * 8);
#define PG8_SA(b, h) (((b) * 2 + (h)) * HTB)
#define PG8_SB(b, h) ((4 + (b) * 2 + (h)) * HTB)
#define PG8_STAGE(bufoff, gbase, voff) do { _Pragma("unroll") for (int _i = 0; _i < 2; ++_i) { \
        if constexpr (FP8) glds16s((voff)[_i], (unsigned long long)(gbase), (unsigned)__builtin_amdgcn_readfirstlane((int)(ldsb + (bufoff) + ldsw + _i * 8192))); \
        else __builtin_amdgcn_global_load_lds((const unsigned*)((const char*)(gbase) + (voff)[_i]), (PG8_LAS unsigned*)(lds + (bufoff) + ldsw + _i * 8192), 16, 0, 0); } } while (0)
#define PG8_LDA(dst, b, h) do { if constexpr (FP8) { _Pragma("unroll") for (int m = 0; m < 4; ++m) dst##8[m] = __builtin_shufflevector(*(const PG8_LAS v4i_t*)(lds + PG8_SA(b, h) + aoff + m * 2048), *(const PG8_LAS v4i_t*)(lds + PG8_SA(b, h) + aoff + m * 2048 + 1024), 0, 1, 2, 3, 4, 5, 6, 7); } \
        else { _Pragma("unroll") for (int m = 0; m < 4; ++m) _Pragma("unroll") for (int k = 0; k < 2; ++k) dst[m][k] = *(const PG8_LAS bf16x8*)(lds + PG8_SA(b, h) + aoff + m * 2048 + k * 1024); } } while (0)
#define PG8_LDB(dst, b, h) do { if constexpr (FP8) { _Pragma("unroll") for (int n = 0; n < 2; ++n) dst##8[n] = __builtin_shufflevector(*(const PG8_LAS v4i_t*)(lds + PG8_SB(b, h) + boff + n * 2048), *(const PG8_LAS v4i_t*)(lds + PG8_SB(b, h) + boff + n * 2048 + 1024), 0, 1, 2, 3, 4, 5, 6, 7); } \
        else { _Pragma("unroll") for (int n = 0; n < 2; ++n) _Pragma("unroll") for (int k = 0; k < 2; ++k) dst[n][k] = *(const PG8_LAS bf16x8*)(lds + PG8_SB(b, h) + boff + n * 2048 + k * 1024); } } while (0)
#define PG8_MMA(ai, bj, At, Bt) do { __builtin_amdgcn_s_setprio(1); \
        if constexpr (FP8) { _Pragma("unroll") for (int m = 0; m < 4; ++m) _Pragma("unroll") for (int n = 0; n < 2; ++n) \
            asm volatile("v_mfma_scale_f32_16x16x128_f8f6f4 %0, %1, %2, %0, %3, %4 op_sel_hi:[0,0,0]" : "+v"(acc[ai][bj][m][n]) : "v"(Bt##8[n]), "v"(At##8[m]), "v"(sw_), "v"(sx_)); } \
        else { _Pragma("unroll") for (int m = 0; m < 4; ++m) _Pragma("unroll") for (int n = 0; n < 2; ++n) _Pragma("unroll") for (int k = 0; k < 2; ++k) acc[ai][bj][m][n] = __builtin_amdgcn_mfma_f32_16x16x32_bf16(Bt[n][k], At[m][k], acc[ai][bj][m][n], 0, 0, 0); } \
        __builtin_amdgcn_s_setprio(0); } while (0)
#define PG8_WAIT_V(n) asm volatile("s_waitcnt vmcnt(" #n ")" ::: "memory")
#define PG8_WAIT_L(n) asm volatile("s_waitcnt lgkmcnt(" #n ")" ::: "memory")
#define PG8_BAR __builtin_amdgcn_s_barrier()
#define PG8_SCHED __builtin_amdgcn_sched_barrier(0)
    Unit cur, nxt; int ui = 0;
    if (!S.next(0, cur)) return;
    f32x4 acc[2][2][4][2];
#pragma unroll
    for (int a = 0; a < 2; ++a)
#pragma unroll
        for (int b = 0; b < 2; ++b)
#pragma unroll
            for (int m = 0; m < 4; ++m)
#pragma unroll
                for (int n = 0; n < 2; ++n) acc[a][b][m][n] = (f32x4){0.f, 0.f, 0.f, 0.f};
    bf16x8 At[4][2], B0[2][2], B1[2][2]; v8i_t At8[4], B08[2], B18[2];
    const char* cA = (const char*)g.A + (size_t)cur.pm * tstep + cur.koff; const char* cB = (const char*)g.Bt + (size_t)cur.pn * tstep + cur.koff;
    PG8_STAGE(PG8_SB(0, 0), cB, voffB); PG8_STAGE(PG8_SB(0, 1), cB + hstep, voffB); PG8_STAGE(PG8_SA(0, 0), cA, voffA); PG8_STAGE(PG8_SA(0, 1), cA + hstep, voffA);
    if (wr == 1) PG8_BAR;
    PG8_WAIT_V(2); PG8_BAR;
    PG8_STAGE(PG8_SB(1, 0), cB + kstep, voffB); PG8_STAGE(PG8_SA(1, 0), cA + kstep, voffA); PG8_STAGE(PG8_SB(1, 1), cB + hstep + kstep, voffB);
    PG8_WAIT_V(6); PG8_BAR;
    for (;;) {
        const bool has_next = S.next(ui + 1, nxt);
        const char* nA = has_next ? (const char*)g.A + (size_t)nxt.pm * tstep + nxt.koff : cA; const char* nB = has_next ? (const char*)g.Bt + (size_t)nxt.pn * tstep + nxt.koff : cB;
        const int nt = cur.nt ? cur.nt : ntd;
#pragma nounroll
        for (int t = 0; t < nt; t += 2) {
            const bool last = (t == nt - 2);
            const char* a1 = cA + (size_t)(t + 1) * kstep;
            const char* a2 = last ? nA : cA + (size_t)(t + 2) * kstep; const char* b2 = last ? nB : cB + (size_t)(t + 2) * kstep;
            const char* a3 = a2 + kstep; const char* b3 = b2 + kstep;
            PG8_LDB(B0, 0, 0); PG8_LDB(B1, 0, 1); PG8_SCHED; PG8_LDA(At, 0, 0); PG8_STAGE(PG8_SA(1, 1), a1 + hstep, voffA);
            PG8_WAIT_V(8); PG8_WAIT_L(0); PG8_BAR; PG8_MMA(0, 0, At, B0); PG8_MMA(0, 1, At, B1); PG8_BAR; PG8_SCHED;
            PG8_LDA(At, 0, 1); PG8_STAGE(PG8_SB(0, 0), b2, voffB); PG8_STAGE(PG8_SB(0, 1), b2 + hstep, voffB); PG8_STAGE(PG8_SA(0, 0), a2, voffA);
            PG8_WAIT_V(8); PG8_WAIT_L(0); PG8_BAR; PG8_MMA(1, 0, At, B0); PG8_MMA(1, 1, At, B1); PG8_BAR; PG8_SCHED;
            PG8_LDB(B0, 1, 0); PG8_LDB(B1, 1, 1); PG8_SCHED; PG8_LDA(At, 1, 0); PG8_STAGE(PG8_SA(0, 1), a2 + hstep, voffA);
            PG8_WAIT_V(8); PG8_WAIT_L(0); PG8_BAR; PG8_MMA(0, 0, At, B0); PG8_MMA(0, 1, At, B1); PG8_BAR; PG8_SCHED;
            PG8_LDA(At, 1, 1); PG8_STAGE(PG8_SB(1, 0), b3, voffB); PG8_STAGE(PG8_SB(1, 1), b3 + hstep, voffB); PG8_STAGE(PG8_SA(1, 0), a3, voffA);
            PG8_WAIT_V(8); PG8_WAIT_L(0); PG8_BAR; PG8_MMA(1, 0, At, B0); PG8_MMA(1, 1, At, B1); PG8_BAR; PG8_SCHED;
        }
        if (wr == 0) PG8_BAR;
        if constexpr (FP8) asm volatile("s_nop 15\n\ts_nop 15" ::: "memory");
        { int le_ = lane; asm volatile("" : "+v"(le_)); E(acc, cur, ui, wr, wc, le_ & 15, le_ >> 4); }
        if (!has_next) break;
#pragma unroll
        for (int a = 0; a < 2; ++a)
#pragma unroll
            for (int b = 0; b < 2; ++b)
#pragma unroll
                for (int m = 0; m < 4; ++m)
#pragma unroll
                    for (int n = 0; n < 2; ++n) acc[a][b][m][n] = (f32x4){0.f, 0.f, 0.f, 0.f};
        cur = nxt; cA = nA; cB = nB; ++ui;
        if (wr == 1) PG8_BAR;
    }
    PG8_WAIT_V(0);
    PG8_BAR;
#undef PG8_SA
#undef PG8_SB
#undef PG8_STAGE
#undef PG8_LDA
#undef PG8_LDB
#undef PG8_MMA
#undef PG8_WAIT_V
#undef PG8_WAIT_L
#undef PG8_BAR
#undef PG8_SCHED
}
}

#define XB_TMO      128
#define XB_XCNT(j)  (256  + 64 * (j))
#define XB_XSUB(j)  (1280 + 64 * (j))
#define XB_XGEN(j)  (2304 + 64 * (j))
#define XB_TOP      3328
#define XB_TOPGEN   3392
#define XCD_BAR_WORDS 3456
#define XB_SPIN_CAP (1u << 24)

__device__ __forceinline__ unsigned xb_ld(unsigned* p)              { return __hip_atomic_load(p, __ATOMIC_RELAXED, __HIP_MEMORY_SCOPE_AGENT); }
__device__ __forceinline__ unsigned xb_add(unsigned* p, unsigned v) { return __hip_atomic_fetch_add(p, v, __ATOMIC_RELAXED, __HIP_MEMORY_SCOPE_AGENT); }
__device__ __forceinline__ unsigned xb_xcc_id() { return (unsigned)__builtin_amdgcn_s_getreg((3 << 11) | 20) & 0xFu; }
#define XB_SPIN(cond, bar) do { unsigned _sp = 0; while (cond) { __builtin_amdgcn_s_sleep(1); \
    if ((++_sp & 255u) == 0u) { if (xb_ld(&(bar)[XB_TMO])) break; if (_sp > XB_SPIN_CAP) { atomicAdd(&(bar)[XB_TMO], 1u); break; } } } } while (0)

struct XcdBarrier { unsigned* bar; unsigned x; volatile LAS unsigned* st; };

__device__ __forceinline__ XcdBarrier xcd_barrier_post(unsigned* bar, volatile LAS unsigned* st) {
    XcdBarrier b; b.bar = bar; b.x = xb_xcc_id(); b.st = st;
    if (threadIdx.x == 0) (void)xb_add(&bar[XB_XCNT(b.x)], 1u);
    return b;
}
__device__ __forceinline__ void xcd_barrier_complete(unsigned* bar, unsigned x, unsigned& nloc, unsigned& nx) {
    const unsigned G = gridDim.x * gridDim.y * gridDim.z;
    unsigned sum, cnt, mine, sp = 0u;
    for (;;) {
        sum = 0u; cnt = 0u; mine = 0u;
#pragma unroll
        for (unsigned j = 0; j < 16; ++j) { const unsigned c = xb_ld(&bar[XB_XCNT(j)]); sum += c; cnt += (c > 0u) ? 1u : 0u; mine = (j == x) ? c : mine; }
        if (sum == G) break;
        __builtin_amdgcn_s_sleep(1);
        if ((++sp & 255u) == 0u) { if (xb_ld(&bar[XB_TMO])) break; if (sp > XB_SPIN_CAP) { atomicAdd(&bar[XB_TMO], 1u); break; } }
    }
    nloc = mine > 0u ? mine : 1u; nx = cnt > 0u ? cnt : 1u;
}
__device__ __forceinline__ void xcd_barrier(const XcdBarrier& b) {
    asm volatile("s_waitcnt vmcnt(0)" ::: "memory");
    __syncthreads();
    if (threadIdx.x == 0) {
        unsigned* bar = b.bar;
        __builtin_amdgcn_s_waitcnt(0);
        unsigned nloc = b.st[0], nx = b.st[1];
        if (nloc == 0u) { xcd_barrier_complete(bar, b.x, nloc, nx); b.st[0] = nloc; b.st[1] = nx; }
        const unsigned old = xb_add(&bar[XB_XSUB(b.x)], 1u);
        const unsigned gen = old / nloc;
        if (old + 1u == (gen + 1u) * nloc) {
            __builtin_amdgcn_fence(__ATOMIC_RELEASE, "agent");
            asm volatile("s_waitcnt vmcnt(0)" ::: "memory");
            const unsigned og = xb_add(&bar[XB_TOP], 1u);
            const unsigned tg = og / nx;
            if (og + 1u == (tg + 1u) * nx) xb_add(&bar[XB_TOPGEN], 1u);
            else XB_SPIN(xb_ld(&bar[XB_TOPGEN]) == tg, bar);
            __builtin_amdgcn_fence(__ATOMIC_ACQUIRE, "agent");
            xb_add(&bar[XB_XGEN(b.x)], 1u);
            asm volatile("s_waitcnt vmcnt(0)" ::: "memory");
        } else {
            XB_SPIN(xb_ld(&bar[XB_XGEN(b.x)]) == gen, bar);
            __builtin_amdgcn_fence(__ATOMIC_ACQUIRE, "agent");
            asm volatile("s_waitcnt vmcnt(0)" ::: "memory");
        }
    }
    __syncthreads();
}

struct Ctx {
    LAS unsigned char* lds;
    unsigned char* ws;
    const void* const* in;
    float* out;
    int tid, lane, wave, G, bid;
};
#define IN_F(i) ((const float*)C.in[i])
#define WSP(T, off) ((T*)(C.ws + (off)))

struct WJob { const float* W0; const float* W1; bf16_t* WT; const float* gain; int K, ldw, Nout, kind, nE, fp8; size_t sW, sWT; };
__device__ __forceinline__ int permsrc(int j) { return j < 16 ? ((j >> 1) + 8 * (j & 1)) : j; }
__device__ __forceinline__ void map_col(int kind, int np, int& src, int& which, float& scale) {
    which = 0; scale = 1.f; src = np;
    if (kind == 1) { const int blk = (np >> 10) % 3; const int hd = np & 63; if (blk < 2) src = np - hd + permsrc(hd); if (blk == 0) scale = C2; }
    else if (kind == 3) { const int hd = np & 63; if (np < 1152) src = np - hd + permsrc(hd); if (np < 1024) scale = C2; }
    else if (kind == 4) { const int tile = np >> 8, w = np & 255; src = tile * 128 + (w & 127); which = w >> 7; }
}
struct TItem { const float* src; float scale; int e, k0, n0; };
__device__ __forceinline__ TItem titem(const WJob& J, int item, int lane) {
    TItem T; const int nblk = J.Nout / 32, per = (J.K / 64) * nblk;
    T.e = item / per; const int r = item % per, kb = r / nblk, nb = r % nblk; T.k0 = 64 * kb; T.n0 = 32 * nb;
    int src, which; map_col(J.kind, T.n0 + (lane & 31), src, which, T.scale);
    const unsigned long long a0_ = (unsigned long long)J.W0, a1_ = (unsigned long long)(J.W1 ? J.W1 : J.W0);
    T.src = (const float*)(a0_ + (a1_ - a0_) * (unsigned long long)which) + (size_t)T.e * J.sW + (size_t)(T.k0 + (lane >> 5)) * J.ldw + src;
    return T;
}
__device__ __forceinline__ void tload(const WJob& J, const TItem& T, float (&v)[32]) {
#pragma unroll
    for (int i = 0; i < 32; ++i) v[i] = __builtin_nontemporal_load(T.src + (size_t)(2 * i) * J.ldw);
}
__device__ __forceinline__ void tstore(const WJob& J, const TItem& T, const float (&v)[32], LAS float* scr, int lane) {
#pragma unroll
    for (int i = 0; i < 32; ++i) scr[(2 * i + (lane >> 5)) * 33 + (lane & 31)] = v[i] * T.scale;
    LDS_WAIT(); asm volatile("" ::: "memory");
    const int c = lane & 7;
    f32x4 g0 = (f32x4){1.f, 1.f, 1.f, 1.f}, g1 = g0;
    if (J.gain) { g0 = *(const f32x4*)(J.gain + T.k0 + 8 * c); g1 = *(const f32x4*)(J.gain + T.k0 + 8 * c + 4); }
    if (J.fp8) {
        unsigned char* WT8 = (unsigned char*)J.WT + (size_t)T.e * J.sWT;
        g0 = g0 * W8_SCALE; g1 = g1 * W8_SCALE;
#pragma unroll
        for (int j = 0; j < 4; ++j) { const int n = (lane >> 3) + 8 * j; const LAS float* s = scr + (8 * c) * 33 + n;
            u32x2 o; o.x = pk_fp8x4(s[0 * 33] * g0[0], s[1 * 33] * g0[1], s[2 * 33] * g0[2], s[3 * 33] * g0[3]); o.y = pk_fp8x4(s[4 * 33] * g1[0], s[5 * 33] * g1[1], s[6 * 33] * g1[2], s[7 * 33] * g1[3]);
            *(u32x2*)(WT8 + (size_t)(T.n0 + n) * J.K + T.k0 + 8 * c) = o; }
    } else {
    bf16_t* WT = J.WT + (size_t)T.e * J.sWT;
#pragma unroll
    for (int j = 0; j < 4; ++j) { const int n = (lane >> 3) + 8 * j; const LAS float* s = scr + (8 * c) * 33 + n;
        u32x4 o; o.x = pk2(s[0 * 33] * g0[0], s[1 * 33] * g0[1]); o.y = pk2(s[2 * 33] * g0[2], s[3 * 33] * g0[3]); o.z = pk2(s[4 * 33] * g1[0], s[5 * 33] * g1[1]); o.w = pk2(s[6 * 33] * g1[2], s[7 * 33] * g1[3]);
        *(u32x4*)(WT + (size_t)(T.n0 + n) * J.K + T.k0 + 8 * c) = o; }
    }
    LDS_WAIT(); asm volatile("" ::: "memory");
}
__device__ __forceinline__ WJob make_job(const Ctx& C, int j) {
    WJob J; J.W1 = nullptr; J.gain = nullptr; J.nE = 1; J.sW = 0; J.sWT = 0; J.kind = 0; J.fp8 = (j == 0 || j == 12 || j == 6 || j == 7 || j >= 14 || j == 1 || j == 9 || j == 13 || j == 10) ? 1 : 0;
    switch (j) {
    case 0:  J.W0 = IN_F(3);  J.WT = WSP(bf16_t, WS_WQKV0); J.gain = IN_F(2);  J.K = 1024; J.ldw = 9216; J.Nout = 9216; J.kind = 1; break;
    case 1:  J.W0 = IN_F(4);  J.WT = WSP(bf16_t, WS_WO0);   J.K = 1024; J.ldw = 1024; J.Nout = 1024; break;
    case 2:  J.W0 = IN_F(6);  J.W1 = IN_F(7); J.WT = WSP(bf16_t, WS_W13_0); J.gain = IN_F(5); J.K = 1024; J.ldw = FF; J.Nout = 2 * FF; J.kind = 4; break;
    case 3:  J.W0 = IN_F(8);  J.WT = WSP(bf16_t, WS_W2_0);  J.K = FF; J.ldw = 1024; J.Nout = 1024; break;
    case 4:  J.W0 = IN_F(10); J.WT = WSP(bf16_t, WS_WQKV1); J.gain = IN_F(9);  J.K = 1024; J.ldw = 3072; J.Nout = 3072; J.kind = 1; break;
    case 5:  J.W0 = IN_F(16); J.WT = WSP(bf16_t, WS_WO1);   J.K = 1024; J.ldw = 1024; J.Nout = 1024; break;
    case 6:  J.W0 = IN_F(19); J.W1 = IN_F(20); J.WT = WSP(bf16_t, WS_WM13); J.gain = IN_F(17); J.K = 1024; J.ldw = FFE; J.Nout = 2 * FFE; J.kind = 4; J.nE = 8; J.sW = (size_t)1024 * FFE; J.sWT = (size_t)2 * FFE * 1024; break;
    case 7:  J.W0 = IN_F(21); J.WT = WSP(bf16_t, WS_WM2);   J.K = FFE; J.ldw = 1024; J.Nout = 1024; J.nE = 8; J.sW = (size_t)FFE * 1024; J.sWT = (size_t)1024 * FFE; break;
    case 8:  J.W0 = IN_F(23); J.WT = WSP(bf16_t, WS_WQKV2); J.gain = IN_F(22); J.K = 1024; J.ldw = 1280; J.Nout = 1280; J.kind = 3; break;
    case 9:  J.W0 = IN_F(25); J.WT = WSP(bf16_t, WS_WO2);   J.K = 1024; J.ldw = 1024; J.Nout = 1024; break;
    case 10: J.W0 = IN_F(27); J.W1 = IN_F(28); J.WT = WSP(bf16_t, WS_W13_2); J.gain = IN_F(26); J.K = 1024; J.ldw = FF; J.Nout = 2 * FF; J.kind = 4; break;
    case 11: J.W0 = IN_F(29); J.WT = WSP(bf16_t, WS_W2_2);  J.K = FF; J.ldw = 1024; J.Nout = 1024; break;
    case 12: J.W0 = IN_F(31); J.WT = WSP(bf16_t, WS_WQKV3); J.gain = IN_F(30); J.K = 1024; J.ldw = 9216; J.Nout = 9216; J.kind = 1; break;
    case 13: J.W0 = IN_F(32); J.WT = WSP(bf16_t, WS_WO3);   J.K = 1024; J.ldw = 1024; J.Nout = 1024; break;
    case 14: J.W0 = IN_F(35); J.W1 = IN_F(36); J.WT = WSP(bf16_t, WS_WM13); J.gain = IN_F(33); J.K = 1024; J.ldw = FFE; J.Nout = 2 * FFE; J.kind = 4; J.nE = 8; J.sW = (size_t)1024 * FFE; J.sWT = (size_t)2 * FFE * 1024; break;
    default: J.W0 = IN_F(37); J.WT = WSP(bf16_t, WS_WM2);   J.K = FFE; J.ldw = 1024; J.Nout = 1024; J.nE = 8; J.sW = (size_t)FFE * 1024; J.sWT = (size_t)1024 * FFE; break;
    }
    return J;
}
template <int j>
__device__ __forceinline__ void convert_one(const Ctx& C) {
    LAS float* scr = (LAS float*)(C.lds + C.wave * 16384);
    const int gw = C.bid * 8 + C.wave, NGW = C.G * 8;
    const WJob J = make_job(C, j);
    const int nitems = J.nE * (J.K / 64) * (J.Nout / 32);
    if (gw >= nitems) return;
    TItem T = titem(J, gw, C.lane); float v[32]; tload(J, T, v);
    for (int it = gw; it < nitems; it += NGW) {
        const int nx = it + NGW; TItem Tn = T; float w[32];
        if (nx < nitems) { Tn = titem(J, nx, C.lane); tload(J, Tn, w); }
        tstore(J, T, v, scr, C.lane);
        if (nx < nitems) { T = Tn;
#pragma unroll
            for (int i = 0; i < 32; ++i) v[i] = w[i]; }
    }
}
__device__ __forceinline__ void convert_weights_first(const Ctx& C) {
    convert_one<0>(C); convert_one<1>(C); convert_one<2>(C); convert_one<3>(C); convert_one<4>(C); convert_one<5>(C); convert_one<6>(C);
    convert_one<7>(C); convert_one<8>(C); convert_one<9>(C); convert_one<10>(C); convert_one<11>(C); convert_one<12>(C); convert_one<13>(C);
}
__device__ __forceinline__ void convert_weights_second(const Ctx& C) { convert_one<14>(C); convert_one<15>(C); }
__device__ __forceinline__ void rope_table(const Ctx& C) {
    const int* pos = (const int*)C.in[1];
    float* tab = WSP(float, WS_ROPE);
    for (int i = C.bid * 512 + C.tid; i < NTOK * 8; i += C.G * 512) {
        const int tok = i >> 3, f = i & 7;
        const float inv = powf(500000.0f, -(float)f * 0.125f);
        const float ang = (float)pos[tok] * inv;
        const double a = (double)ang;
        const double k = rint(a * 0.15915494309189535);
        const float r = (float)(a - k * 6.283185307179586);
        tab[(size_t)tok * 16 + f] = cosf(r); tab[(size_t)tok * 16 + 8 + f] = sinf(r);
    }
}
__device__ __forceinline__ void write_ssq_row(float* ssq, int row, float tot, int lane) { if (lane < 16) ssq[(size_t)row * 16 + lane] = (lane == 0) ? tot : 0.f; }
__device__ __forceinline__ void x_to_bf16(const Ctx& C) {
    const float* x = IN_F(0); bf16_t* xb = WSP(bf16_t, WS_XB); float* ssq = WSP(float, WS_SSQ); unsigned char* x8 = WSP(unsigned char, WS_X8);
    const int gw = C.bid * 8 + C.wave, NGW = C.G * 8;
    for (int m = gw; m < NTOK; m += NGW) {
        const f32x4* xr = (const f32x4*)(x + (size_t)m * DM) + C.lane; u32x2* o = (u32x2*)(xb + (size_t)m * DM) + C.lane; unsigned* o8 = (unsigned*)(x8 + (size_t)m * DM) + C.lane;
        float s = 0.f;
#pragma unroll
        for (int j = 0; j < 4; ++j) { const f32x4 v = xr[64 * j]; s += (v[0] * v[0] + v[1] * v[1]) + (v[2] * v[2] + v[3] * v[3]); u32x2 w; w.x = pk2(v[0], v[1]); w.y = pk2(v[2], v[3]); o[64 * j] = w; o8[64 * j] = pk_fp8x4(v[0], v[1], v[2], v[3]); }
        write_ssq_row(ssq, m, wave_sum(s), C.lane);
    }
}

__device__ __forceinline__ void load_q64(const bf16_t* qp, float (&q)[64]) {
#pragma unroll
    for (int c = 0; c < 8; ++c) { const u32x4 w = *(const u32x4*)(qp + 8 * c);
        q[8 * c + 0] = bflo(w.x); q[8 * c + 1] = bfhi(w.x); q[8 * c + 2] = bflo(w.y); q[8 * c + 3] = bfhi(w.y); q[8 * c + 4] = bflo(w.z); q[8 * c + 5] = bfhi(w.z); q[8 * c + 6] = bflo(w.w); q[8 * c + 7] = bfhi(w.w); }
}
__device__ __forceinline__ float dot64(const float (&q)[64], const bf16_t* kp) {
    float s = 0.f;
#pragma unroll
    for (int c = 0; c < 8; ++c) { const u32x4 w = *(const u32x4*)(kp + 8 * c);
        s += q[8 * c + 0] * bflo(w.x); s += q[8 * c + 1] * bfhi(w.x); s += q[8 * c + 2] * bflo(w.y); s += q[8 * c + 3] * bfhi(w.y);
        s += q[8 * c + 4] * bflo(w.z); s += q[8 * c + 5] * bfhi(w.z); s += q[8 * c + 6] * bflo(w.w); s += q[8 * c + 7] * bfhi(w.w); }
    return s;
}
__device__ __forceinline__ void naive_band(const bf16_t* qp, const bf16_t* K, const bf16_t* V, size_t kstride, int jlo, int jhi, float m0, float l0, int lane, float& o_out, float& m_out, float& l_out) {
    float q[64]; load_q64(qp, q);
    float m = m0, l = l0, o = 0.f;
    for (int j0 = jlo; j0 <= jhi; j0 += 64) {
        const int j = j0 + lane; const bool valid = j <= jhi; const int jj = valid ? j : jhi;
        float s = dot64(q, K + (size_t)jj * kstride); if (!valid) s = -INFINITY;
        const float mn = fmaxf(m, wave_max(s)); const float alpha = exp2f(m - mn); const float p = exp2f(s - mn);
        l = l * alpha + wave_sum(p); o *= alpha; m = mn;
        const int cnt = (jhi - j0 + 1) < 64 ? (jhi - j0 + 1) : 64;
        for (int t = 0; t < cnt; ++t) { const float pj = __shfl(p, t); o += pj * bf2f(V[(size_t)(j0 + t) * kstride + lane]); }
    }
    o_out = o; m_out = m; l_out = l;
}
__device__ __forceinline__ void naive_attn_A(const Ctx& C) {
    const bf16_t* QKV = WSP(bf16_t, WS_BIG + BIG_QKV); bf16_t* OG = WSP(bf16_t, WS_BIG + BIG_OG); float* LSE = WSP(float, WS_LSE);
    const int gw = C.bid * 8 + C.wave, NGW = C.G * 8;
    for (int it = gw; it < NTOK * 16 * 3; it += NGW) {
        const int gi = it % 3, h = (it / 3) % 16, tok = it / 48;
        const int dil = gi == 0 ? 1 : (gi == 1 ? 4 : 16);
        const int b = tok / SEQ, s = tok % SEQ, r = s % dil, i = s / dil, L = SEQ / dil;
        const int jlo = i - 64 < 0 ? 0 : i - 64, jhi = i + 64 > L - 1 ? L - 1 : i + 64;
        const bf16_t* base = QKV + (size_t)(b * SEQ + r) * NQKV_A + gi * 3072 + h * 64;
        float o, m, l;
        naive_band(QKV + (size_t)tok * NQKV_A + gi * 3072 + h * 64, base + 1024, base + 2048, (size_t)dil * NQKV_A, jlo, jhi, -1e30f, 0.f, C.lane, o, m, l);
        OG[((size_t)gi * NTOK + tok) * DM + h * 64 + C.lane] = (bf16_t)f2bf(o / l);
        if (C.lane == 0) LSE[((size_t)gi * NTOK + tok) * 16 + h] = m + log2f(l);
    }
}
__device__ __forceinline__ void naive_attn_C(const Ctx& C) {
    const bf16_t* QKV = WSP(bf16_t, WS_BIG + BIG_QKV); bf16_t* O = WSP(bf16_t, WS_O); const float* sink = IN_F(24);
    const int gw = C.bid * 8 + C.wave, NGW = C.G * 8;
    for (int it = gw; it < NTOK * 16; it += NGW) {
        const int h = it % 16, tok = it / 16, g = h / 8;
        const int b = tok / SEQ, s = tok % SEQ;
        const int jlo = s - 128 < 0 ? 0 : s - 128, jhi = s + 128 > SEQ - 1 ? SEQ - 1 : s + 128;
        const bf16_t* base = QKV + (size_t)(b * SEQ) * NQKV_C;
        float o, m, l;
        naive_band(QKV + (size_t)tok * NQKV_C + h * 64, base + 1024 + g * 64, base + 1152 + g * 64, (size_t)NQKV_C, jlo, jhi, sink[h] * LOG2E, 1.f, C.lane, o, m, l);
        O[(size_t)tok * DM + h * 64 + C.lane] = (bf16_t)f2bf(o / l);
    }
}
__device__ __forceinline__ float diff_lambda(const Ctx& C) {
    const float a = IN_F(11)[C.lane] * IN_F(12)[C.lane], b = IN_F(13)[C.lane] * IN_F(14)[C.lane];
    return expf(wave_sum(a)) - expf(wave_sum(b)) + LAMBDA_INIT;
}
__device__ __forceinline__ void naive_attn_B(const Ctx& C) {
    const bf16_t* QKV = WSP(bf16_t, WS_BIG + BIG_QKV); bf16_t* O = WSP(bf16_t, WS_O); const float* subln = IN_F(15);
    const float lam = diff_lambda(C);
    const int gw = C.bid * 8 + C.wave, NGW = C.G * 8, lane = C.lane;
    for (int it = gw; it < NTOK * 8; it += NGW) {
        const int h = it % 8, tok = it / 8, b = tok / SEQ;
        float q0[64], q1[64]; load_q64(QKV + (size_t)tok * NQKV_B + (2 * h) * 64, q0); load_q64(QKV + (size_t)tok * NQKV_B + (2 * h + 1) * 64, q1);
        const bf16_t* Kb = QKV + (size_t)(b * SEQ) * NQKV_B + 1024 + (2 * h) * 64; const bf16_t* Vb = QKV + (size_t)(b * SEQ) * NQKV_B + 2048 + h * 128;
        float m0 = -1e30f, l0 = 0.f, m1 = -1e30f, l1 = 0.f, oa0 = 0.f, ob0 = 0.f, oa1 = 0.f, ob1 = 0.f;
        for (int j0 = 0; j0 < SEQ; j0 += 64) {
            const bf16_t* kr = Kb + (size_t)(j0 + lane) * NQKV_B;
            const float s0 = dot64(q0, kr), s1 = dot64(q1, kr + 64);
            const float mn0 = fmaxf(m0, wave_max(s0)), mn1 = fmaxf(m1, wave_max(s1));
            const float a0 = exp2f(m0 - mn0), a1 = exp2f(m1 - mn1), p0 = exp2f(s0 - mn0), p1 = exp2f(s1 - mn1);
            l0 = l0 * a0 + wave_sum(p0); l1 = l1 * a1 + wave_sum(p1); oa0 *= a0; ob0 *= a0; oa1 *= a1; ob1 *= a1; m0 = mn0; m1 = mn1;
#pragma unroll 8
            for (int t = 0; t < 64; ++t) {
                const bf16_t* vr = Vb + (size_t)(j0 + t) * NQKV_B;
                const float va = bf2f(vr[lane]), vb = bf2f(vr[lane + 64]);
                const float pa = __shfl(p0, t), pb = __shfl(p1, t);
                oa0 += pa * va; ob0 += pa * vb; oa1 += pb * va; ob1 += pb * vb;
            }
        }
        const float f0 = 1.0f / l0, f1 = lam / l1;
        const float ya = oa0 * f0 - oa1 * f1, yb = ob0 * f0 - ob1 * f1;
        const float ms = wave_sum(ya * ya + yb * yb) * (1.0f / 128.0f);
        const float rs = (1.0f / sqrtf(ms + SUBLN_EPS)) * (1.0f - LAMBDA_INIT);
        O[(size_t)tok * DM + h * 128 + lane] = (bf16_t)f2bf(ya * rs * subln[lane]);
        O[(size_t)tok * DM + h * 128 + 64 + lane] = (bf16_t)f2bf(yb * rs * subln[lane + 64]);
    }
}

namespace att {
typedef float f32x16 __attribute__((ext_vector_type(16)));
typedef short s16x4 __attribute__((ext_vector_type(4)));
typedef short v4i16_t __attribute__((ext_vector_type(4)));
typedef __bf16 bf16x2_t __attribute__((ext_vector_type(2)));
#define ADI __device__ __forceinline__
#define MFMA32(a, b, c) __builtin_amdgcn_mfma_f32_32x32x16_bf16((a), (b), (c), 0, 0, 0)
ADI int crow(int i, int hh) { return (i & 3) + 8 * (i >> 2) + 4 * hh; }
ADI float hmax(float v) { auto rr = __builtin_amdgcn_permlane32_swap(__float_as_uint(v), __float_as_uint(v), false, false); return fmaxf(__uint_as_float(rr[0]), __uint_as_float(rr[1])); }
ADI float hsum(float v) { auto rr = __builtin_amdgcn_permlane32_swap(__float_as_uint(v), __float_as_uint(v), false, false); return __uint_as_float(rr[0]) + __uint_as_float(rr[1]); }
ADI unsigned cvtpk(float lo, float hi) { f32x2 v = {lo, hi}; bf16x2_t b = __builtin_convertvector(v, bf16x2_t); return __builtin_bit_cast(unsigned, b); }
template <int S> ADI bf16x8 pack8(const f32x16& x) { u32x4 p; p[0] = cvtpk(x[8 * S], x[8 * S + 1]); p[1] = cvtpk(x[8 * S + 2], x[8 * S + 3]); p[2] = cvtpk(x[8 * S + 4], x[8 * S + 5]); p[3] = cvtpk(x[8 * S + 6], x[8 * S + 7]); return __builtin_bit_cast(bf16x8, p); }
ADI s16x4 vtr(const LAS unsigned char* p) { return __builtin_bit_cast(s16x4, __builtin_amdgcn_ds_read_tr16_b64_v4i16((LAS v4i16_t*)p)); }
ADI bf16x8 cat8(s16x4 lo, s16x4 hi) { return (bf16x8){lo[0], lo[1], lo[2], lo[3], hi[0], hi[1], hi[2], hi[3]}; }
ADI float fexp2(float x) { return __builtin_amdgcn_exp2f(x); }
ADI float max3f(float a, float b, float c) { return __builtin_fmaxf(__builtin_fmaxf(a, b), c); }

ADI void qk_tile(f32x16& s0, f32x16& s1, const LAS unsigned char* kt, const bf16x8 (&q)[4], int kro, int kx6) {
    s0 = f32x16{}; s1 = f32x16{};
#pragma unroll
    for (int d0 = 0; d0 < 4; ++d0) {
        const int ko = kro + (kx6 ^ (d0 << 5));
        const bf16x8 a0 = *(const LAS bf16x8*)(kt + ko); const bf16x8 a1 = *(const LAS bf16x8*)(kt + 4096 + ko);
        s0 = MFMA32(a0, q[d0], s0); s1 = MFMA32(a1, q[d0], s1);
    }
}
ADI void qk_tile_init(f32x16& s0, f32x16& s1, const f32x16& init, const LAS unsigned char* kt, const bf16x8 (&q)[4], int kro, int kx6) {
    s0 = init; s1 = init;
#pragma unroll
    for (int d0 = 0; d0 < 4; ++d0) {
        const int ko = kro + (kx6 ^ (d0 << 5));
        const bf16x8 a0 = *(const LAS bf16x8*)(kt + ko); const bf16x8 a1 = *(const LAS bf16x8*)(kt + 4096 + ko);
        s0 = MFMA32(a0, q[d0], s0); s1 = MFMA32(a1, q[d0], s1);
    }
}
ADI void qk_tile_lq(f32x16& s0, f32x16& s1, const LAS unsigned char* kt, const LAS unsigned char* qf, int kro, int kx6) {
    s0 = f32x16{}; s1 = f32x16{};
#pragma unroll
    for (int d0 = 0; d0 < 4; ++d0) {
        const int ko = kro + (kx6 ^ (d0 << 5));
        const bf16x8 a0 = *(const LAS bf16x8*)(kt + ko); const bf16x8 a1 = *(const LAS bf16x8*)(kt + 4096 + ko);
        const bf16x8 qd = *(const LAS bf16x8*)(qf + d0 * 1024);
        s0 = MFMA32(a0, qd, s0); s1 = MFMA32(a1, qd, s1);
    }
}
template <int NB>
ADI void softmax_tile(f32x16& s0, f32x16& s1, float& m, float& l, f32x16 (&O)[NB], LAS float* scr, int r, int hh) {
    float mxa = max3f(s0[0], s0[1], s1[0]), mxb = max3f(s0[2], s0[3], s1[1]); mxa = max3f(mxa, s1[2], s1[3]);
#pragma unroll
    for (int i = 4; i < 16; i += 4) { mxa = max3f(mxa, s0[i], s0[i + 1]); mxb = max3f(mxb, s0[i + 2], s0[i + 3]); mxa = max3f(mxa, s1[i], s1[i + 1]); mxb = max3f(mxb, s1[i + 2], s1[i + 3]); }
    float mx = hmax(max3f(mxa, mxb, mxb));
    if (__any(mx > m + 8.0f)) {
        const float mn = fmaxf(m, mx), al = fexp2(m - mn); l *= al; m = mn;
        if (hh == 0) scr[r] = al;
#pragma unroll
        for (int g = 0; g < 4; ++g) { const f32x4 a4 = *(const LAS f32x4*)(scr + 8 * g + 4 * hh);
#pragma unroll
            for (int c = 0; c < NB; ++c) { O[c][4 * g] *= a4[0]; O[c][4 * g + 1] *= a4[1]; O[c][4 * g + 2] *= a4[2]; O[c][4 * g + 3] *= a4[3]; } }
    }
    float sa = 0.f, sb = 0.f, sc = 0.f, sd = 0.f;
#pragma unroll
    for (int i = 0; i < 16; i += 2) { s0[i] = fexp2(s0[i] - m); s1[i] = fexp2(s1[i] - m); s0[i + 1] = fexp2(s0[i + 1] - m); s1[i + 1] = fexp2(s1[i + 1] - m); sa += s0[i]; sb += s1[i]; sc += s0[i + 1]; sd += s1[i + 1]; }
    l += (sa + sb) + (sc + sd);
}

template <int NB>
ADI void softmax_max(const f32x16& s0, const f32x16& s1, float& m, float& l, f32x16 (&O)[NB], LAS float* scr, int r, int hh) {
    float mxa = max3f(s0[0], s0[1], s1[0]), mxb = max3f(s0[2], s0[3], s1[1]); mxa = max3f(mxa, s1[2], s1[3]);
#pragma unroll
    for (int i = 4; i < 16; i += 4) { mxa = max3f(mxa, s0[i], s0[i + 1]); mxb = max3f(mxb, s0[i + 2], s0[i + 3]); mxa = max3f(mxa, s1[i], s1[i + 1]); mxb = max3f(mxb, s1[i + 2], s1[i + 3]); }
    const float mx = hmax(max3f(mxa, mxb, mxb));
    if (__any(mx > m + 8.0f)) {
        const float mn = fmaxf(m, mx), al = fexp2(m - mn); l *= al; m = mn;
        if (hh == 0) scr[r] = al;
#pragma unroll
        for (int g = 0; g < 4; ++g) { const f32x4 a4 = *(const LAS f32x4*)(scr + 8 * g + 4 * hh);
#pragma unroll
            for (int c = 0; c < NB; ++c) { O[c][4 * g] *= a4[0]; O[c][4 * g + 1] *= a4[1]; O[c][4 * g + 2] *= a4[2]; O[c][4 * g + 3] *= a4[3]; } }
    }
}
template <int S> ADI bf16x8 exp_pack8(f32x16& x, float m, float& sa, float& sb) {
#pragma unroll
    for (int i = 0; i < 8; i += 2) { x[8 * S + i] = fexp2(x[8 * S + i] - m); x[8 * S + i + 1] = fexp2(x[8 * S + i + 1] - m); sa += x[8 * S + i]; sb += x[8 * S + i + 1]; }
    return pack8<S>(x);
}
ADI void glds16(const void* gsrc, unsigned lds_dst) { unsigned keep;
    asm volatile("s_mov_b32 %0, m0\n\ts_mov_b32 m0, %2\n\ts_nop 0\n\tglobal_load_lds_dwordx4 %1, off\n\ts_mov_b32 m0, %0" : "=&s"(keep) : "v"(gsrc), "s"(lds_dst) : "memory"); }
#define ATT_GLDS(gp, lp) glds16((gp), (unsigned)__builtin_amdgcn_readfirstlane((int)(lp)))
typedef int v8i_a __attribute__((ext_vector_type(8)));
typedef int v4i_a __attribute__((ext_vector_type(4)));
typedef int v2i_a __attribute__((ext_vector_type(2)));
ADI void diff_unit(LAS unsigned char* lds, const unsigned char* QKV8, bf16_t* Oout, const float* subln, float lam, int b, int h, int qb, int tid, int lane, int wave) {
    const int r = lane & 31, hh = lane >> 5, comp = wave & 1, qt = wave >> 1;
    const size_t rowbase = (size_t)b * SEQ;
    v8i_a q8;
    {
        const unsigned char* qrow = QKV8 + (rowbase + qb * 128 + qt * 32 + r) * NQKV_B + (2 * h + comp) * 64 + 32 * hh;
        const v4i_a qa = *(const v4i_a*)qrow, qb_ = *(const v4i_a*)(qrow + 16);
        q8 = __builtin_shufflevector(qa, qb_, 0, 1, 2, 3, 4, 5, 6, 7);
    }
    const bool isV = wave >= 4; const int w4 = wave & 3;
    const int srow = 16 * w4 + (lane >> 2);
    const int vkey = 16 * w4 + (lane >> 3), vf0 = (vkey >> 1) & 1;
    const unsigned char* src0 = isV ? QKV8 + (rowbase + vkey) * NQKV_B + 2048 + h * 128 + ((((lane >> 1) & 3) ^ vf0) << 5) + ((lane & 1) << 4)
                                    : QKV8 + (rowbase + srow) * NQKV_B + 1024 + (2 * h) * 64 + (((lane & 3) ^ ((srow >> 2) & 3)) << 4);
    const unsigned char* src1 = isV ? QKV8 + (rowbase + vkey + 8) * NQKV_B + 2048 + h * 128 + ((((lane >> 1) & 3) ^ (vf0 | 2)) << 5) + ((lane & 1) << 4)
                                    : src0 + 64;
    const unsigned lb = (unsigned)(uintptr_t)lds;
    const unsigned dk0 = lb + (isV ? 8192 + (2 * w4) * 1024 : w4 * 1024), dk1 = lb + (isV ? 8192 + (2 * w4 + 1) * 1024 : 4096 + w4 * 1024);
#define DIFF_DMA(tt) do { const unsigned so_ = ((tt) & 3) * 16384; const size_t go_ = (size_t)(tt) * 64 * NQKV_B; \
        ATT_GLDS(src0 + go_, dk0 + so_); ATT_GLDS(src1 + go_, dk1 + so_); } while (0)
    const int kx = (r >> 2) & 3;
    const int kro0 = comp * 4096 + r * 64 + (((2 * hh) ^ kx) << 4), kro1 = comp * 4096 + r * 64 + (((2 * hh + 1) ^ kx) << 4);
    const int ts_ = lane & 15, tblk = (lane >> 4) & 1;
    const int te = ts_ >> 1, tcol = ts_ & 1;
    const int tkey = (te & 3) + 8 * (te >> 2) + 4 * hh;
    const int tfx = (te >> 1) & 3;
    const int vro = 8192 + tkey * 128 + 16 * tblk + 8 * tcol;
    LAS float* scr = (LAS float*)(lds + 132096 + wave * 256);
    f32x16 O[4];
#pragma unroll
    for (int c = 0; c < 4; ++c) O[c] = f32x16{};
    float m4 = 0.f, l = 0.f;
    f32x16 negm = f32x16{};
    constexpr int NT = SEQ / 64;
    const int sP = 0x7b7b7b7b, sV = 0x7f7f7f7f, sK = 0x7f7f7f7f, sQ = 0x7b7b7b7b;
    DIFF_DMA(0); DIFF_DMA(1);
    asm volatile("s_waitcnt vmcnt(2)\n\ts_barrier" ::: "memory");
    if (wave >= 4) __builtin_amdgcn_s_setprio(1);
    for (int t = 0; t < NT; ++t) {
        if (t + 2 < NT) DIFF_DMA(t + 2);
        const LAS unsigned char* st = lds + (t & 3) * 16384;
        f32x16 s0, s1;
        {
            const v4i_a a0 = *(const LAS v4i_a*)(st + kro0), a1 = *(const LAS v4i_a*)(st + kro1), b0 = *(const LAS v4i_a*)(st + 2048 + kro0), b1 = *(const LAS v4i_a*)(st + 2048 + kro1);
            const v8i_a k0 = __builtin_shufflevector(a0, a1, 0, 1, 2, 3, 4, 5, 6, 7), k1 = __builtin_shufflevector(b0, b1, 0, 1, 2, 3, 4, 5, 6, 7);
            asm volatile("s_nop 3\n\tv_mfma_scale_f32_32x32x64_f8f6f4 %0, %2, %4, %5, %6, %7 op_sel_hi:[0,0,0]\n\tv_mfma_scale_f32_32x32x64_f8f6f4 %1, %3, %4, %5, %6, %7 op_sel_hi:[0,0,0]\n\ts_nop 15\n\ts_nop 7"
                         : "=&v"(s0), "=&v"(s1) : "v"(k0), "v"(k1), "v"(q8), "v"(negm), "v"(sK), "v"(sQ));
        }
        {
            float mxa = max3f(s0[0], s0[1], s1[0]), mxb = max3f(s0[2], s0[3], s1[1]); mxa = max3f(mxa, s1[2], s1[3]);
#pragma unroll
            for (int i = 4; i < 16; i += 4) { mxa = max3f(mxa, s0[i], s0[i + 1]); mxb = max3f(mxb, s0[i + 2], s0[i + 3]); mxa = max3f(mxa, s1[i], s1[i + 1]); mxb = max3f(mxb, s1[i + 2], s1[i + 3]); }
            const float mx = hmax(max3f(mxa, mxb, mxb));
            if (t == 0 || __any(mx > 8.0f)) {
                const float dl = (t == 0) ? (mx - 4.0f) : fmaxf(mx - 4.0f, 0.f);
                const float al = (t == 0) ? 0.f : fexp2(-dl); l *= al; m4 += dl;
#pragma unroll
                for (int i = 0; i < 16; ++i) { s0[i] -= dl; s1[i] -= dl; negm[i] = -m4; }
                if (hh == 0) scr[r] = al;
#pragma unroll
                for (int g = 0; g < 4; ++g) { const f32x4 a4 = *(const LAS f32x4*)(scr + 8 * g + 4 * hh);
#pragma unroll
                    for (int c = 0; c < 4; ++c) { O[c][4 * g] *= a4[0]; O[c][4 * g + 1] *= a4[1]; O[c][4 * g + 2] *= a4[2]; O[c][4 * g + 3] *= a4[3]; } }
            }
        }
        float sa = 0.f, sb = 0.f, sc = 0.f, sd = 0.f;
#pragma unroll
        for (int i = 0; i < 16; i += 2) { s0[i] = fexp2(s0[i]); s1[i] = fexp2(s1[i]); s0[i + 1] = fexp2(s0[i + 1]); s1[i + 1] = fexp2(s1[i + 1]); sa += s0[i]; sb += s1[i]; sc += s0[i + 1]; sd += s1[i + 1]; }
        l += ((sa + sb) + (sc + sd)) * 0.0625f;
        v8i_a P8;
#pragma unroll
        for (int g = 0; g < 4; ++g) { P8[g] = (int)pk_fp8x4_nc(s0[4 * g], s0[4 * g + 1], s0[4 * g + 2], s0[4 * g + 3]); P8[4 + g] = (int)pk_fp8x4_nc(s1[4 * g], s1[4 * g + 1], s1[4 * g + 2], s1[4 * g + 3]); }
#pragma unroll
        for (int c = 0; c < 4; ++c) {
            const LAS unsigned char* vp = st + vro + ((c ^ tfx) << 5);
            const v2i_a t0 = __builtin_amdgcn_ds_read_tr8_b64_v2i32((LAS v2i_a*)(vp)), t1 = __builtin_amdgcn_ds_read_tr8_b64_v2i32((LAS v2i_a*)(vp + 16 * 128));
            const v2i_a t2 = __builtin_amdgcn_ds_read_tr8_b64_v2i32((LAS v2i_a*)(vp + 32 * 128)), t3 = __builtin_amdgcn_ds_read_tr8_b64_v2i32((LAS v2i_a*)(vp + 48 * 128));
            const v8i_a V8 = (v8i_a){t0[0], t0[1], t1[0], t1[1], t2[0], t2[1], t3[0], t3[1]};
            asm volatile("s_nop 3\n\tv_mfma_scale_f32_32x32x64_f8f6f4 %0, %1, %2, %0, %3, %4 op_sel_hi:[0,0,0]" : "+v"(O[c]) : "v"(P8), "v"(V8), "v"(sP), "v"(sV));
        }
        if (t + 2 < NT) asm volatile("s_waitcnt vmcnt(2) lgkmcnt(0)\n\ts_barrier" ::: "memory"); else asm volatile("s_waitcnt vmcnt(0) lgkmcnt(0)\n\ts_barrier" ::: "memory");
    }
#undef DIFF_DMA
    __builtin_amdgcn_s_setprio(0);
    asm volatile("s_nop 15\n\ts_nop 15" ::: "memory");
    l = hsum(l);
    if (hh == 0) scr[r] = (comp == 0 ? 1.0f : lam) / l;
    LAS float* xch = (LAS float*)(lds + qt * 16384) + lane;
#pragma unroll
    for (int g = 0; g < 4; ++g) { const f32x4 a4 = *(const LAS f32x4*)(scr + 8 * g + 4 * hh);
#pragma unroll
        for (int c = 0; c < 4; ++c) { O[c][4 * g] *= a4[0]; O[c][4 * g + 1] *= a4[1]; O[c][4 * g + 2] *= a4[2]; O[c][4 * g + 3] *= a4[3]; } }
    if (comp == 1) {
#pragma unroll
        for (int c = 0; c < 4; ++c)
#pragma unroll
            for (int i = 0; i < 16; ++i) xch[(c * 16 + i) * 64] = O[c][i];
    }
    __syncthreads();
    if (comp == 0) {
        float sg[4];
#pragma unroll
        for (int c = 0; c < 4; ++c) sg[c] = subln[32 * c + r] * (1.0f - LAMBDA_INIT);
#pragma unroll
        for (int i = 0; i < 16; ++i) {
            float y[4]; float ss = 0.f;
#pragma unroll
            for (int c = 0; c < 4; ++c) { y[c] = O[c][i] - xch[(c * 16 + i) * 64]; ss += y[c] * y[c]; }
            ss += __shfl_xor(ss, 1); ss += __shfl_xor(ss, 2); ss += __shfl_xor(ss, 4); ss += __shfl_xor(ss, 8); ss += __shfl_xor(ss, 16);
            const float rs = 1.0f / sqrtf(ss * (1.0f / 128.0f) + SUBLN_EPS);
            bf16_t* op = Oout + (rowbase + qb * 128 + qt * 32 + crow(i, hh)) * DM + h * 128 + r;
#pragma unroll
            for (int c = 0; c < 4; ++c) op[32 * c] = (bf16_t)f2bf(y[c] * rs * sg[c]);
        }
    }
    __syncthreads();
}

struct BandW { const bf16_t* qrow; int qi0, tlo, thi; float m0, l0; bf16_t* out; size_t ostride; float* lse; size_t lstride; };
template <bool LSE_OUT>
ADI void band_unit(LAS unsigned char* lds, const bf16_t* Kb, const bf16_t* Vb, size_t kstride, int L, int jstart, int ntiles, int halfw, const BandW& W, int tid, int lane, int wave) {
    const int r = lane & 31, hh = lane >> 5;
    bf16x8 q[4];
#pragma unroll
    for (int d0 = 0; d0 < 4; ++d0) q[d0] = *(const bf16x8*)(W.qrow + 16 * d0 + 8 * hh);
    const int srow = tid >> 3, sch = tid & 7;
    const int kdst = srow * 128 + ((sch ^ ((srow >> 1) & 7)) << 4);
    const int vdst = 8192 + srow * 128 + ((sch ^ (((srow >> 1) & 1) << 2)) << 4);
    const int xs = (r >> 1) & 7;
    const int kro = r * 128 + ((hh ^ (xs & 1)) << 4), kx6 = (xs & 6) << 4;
    const int blk = (lane >> 4) & 1, qq = (lane & 15) >> 2, pp = lane & 3;
    const int vro = 8192 + (4 * hh + qq) * 128 + ((2 * blk + (pp >> 1)) << 4) + 8 * (pp & 1), vq6 = ((qq >> 1) & 1) << 6;
    LAS float* scr = (LAS float*)(lds + 132096 + wave * 256);
    f32x16 O[2]; O[0] = f32x16{}; O[1] = f32x16{};
    float m = W.m0, l = W.l0;
    const int qi = W.qi0 + r;
    {
        int j = jstart + srow; j = j < 0 ? 0 : (j > L - 1 ? L - 1 : j);
        const u32x4 ka = *(const u32x4*)(Kb + (size_t)j * kstride + sch * 8), va = *(const u32x4*)(Vb + (size_t)j * kstride + sch * 8);
        *(LAS u32x4*)(lds + kdst) = ka; *(LAS u32x4*)(lds + vdst) = va;
    }
    __syncthreads();
    for (int t = 0; t < ntiles; ++t) {
        const LAS unsigned char* st = lds + (t & 1) * 16384;
        const bool active = (t >= W.tlo) && (t <= W.thi);
        bf16x8 P[4];
        if (active) {
            f32x16 s0, s1;
            qk_tile(s0, s1, st, q, kro, kx6);
            const int jb = jstart + 64 * t + 4 * hh;
#pragma unroll
            for (int i = 0; i < 16; ++i) {
                const int j0 = jb + (i & 3) + 8 * (i >> 2), j1 = j0 + 32;
                if (!(((unsigned)j0 < (unsigned)L) && ((unsigned)(j0 - qi + halfw) <= (unsigned)(2 * halfw)))) s0[i] = -INFINITY;
                if (!(((unsigned)j1 < (unsigned)L) && ((unsigned)(j1 - qi + halfw) <= (unsigned)(2 * halfw)))) s1[i] = -INFINITY;
            }
            softmax_tile<2>(s0, s1, m, l, O, scr, r, hh);
            P[0] = pack8<0>(s0); P[1] = pack8<1>(s0); P[2] = pack8<0>(s1); P[3] = pack8<1>(s1);
        }
        int j = jstart + 64 * ((t + 1 < ntiles) ? t + 1 : t) + srow; j = j < 0 ? 0 : (j > L - 1 ? L - 1 : j);
        const u32x4 ka = *(const u32x4*)(Kb + (size_t)j * kstride + sch * 8), va = *(const u32x4*)(Vb + (size_t)j * kstride + sch * 8);
        if (active) {
#pragma unroll
            for (int c = 0; c < 2; ++c)
#pragma unroll
                for (int kc = 0; kc < 4; ++kc) {
                    const LAS unsigned char* vp = st + vro + (vq6 ^ (c << 6)) + kc * 2048;
                    const bf16x8 vf = cat8(vtr(vp), vtr(vp + 1024));
                    O[c] = MFMA32(P[kc], vf, O[c]);
                }
        }
        LAS unsigned char* sn = lds + ((t + 1) & 1) * 16384;
        *(LAS u32x4*)(sn + kdst) = ka; *(LAS u32x4*)(sn + vdst) = va;
        __syncthreads();
    }
    l = hsum(l);
    if (hh == 0) scr[r] = 1.0f / l;
    if (LSE_OUT) { if (hh == 0) W.lse[(size_t)(W.qi0 + r) * W.lstride] = m + log2f(l); }
#pragma unroll
    for (int g = 0; g < 4; ++g) { const f32x4 a4 = *(const LAS f32x4*)(scr + 8 * g + 4 * hh);
#pragma unroll
        for (int k = 0; k < 4; ++k) { bf16_t* op = W.out + (size_t)(W.qi0 + 8 * g + 4 * hh + k) * W.ostride + r;
            op[0] = (bf16_t)f2bf(O[0][4 * g + k] * a4[k]); op[32] = (bf16_t)f2bf(O[1][4 * g + k] * a4[k]); } }
}

struct BandDesc { const bf16_t* Kb; const bf16_t* Vb; size_t kstride; int L, jstart; const bf16_t* qrow; int qi0, tlo, thi; float m0, l0; bf16_t* out; size_t ostride; float* lse; size_t lstride; };
template <int NTL, int HALFW, bool LSE_OUT, class F>
ADI void band_stream(LAS unsigned char* lds, int nunits, const F& get, int tid, int lane, int wave) {
    const int r = lane & 31, hh = lane >> 5;
    const unsigned lbase = (unsigned)(uintptr_t)lds;
    const int srow = 8 * wave + (lane >> 3), kchs = ((lane & 7) ^ ((srow >> 1) & 7)) * 8, vchs = ((lane & 7) ^ (((srow >> 1) & 1) << 2)) * 8;
    const int xs = (r >> 1) & 7;
    const int kro = r * 128 + ((hh ^ (xs & 1)) << 4), kx6 = (xs & 6) << 4;
    const int blk = (lane >> 4) & 1, qq = (lane & 15) >> 2, pp = lane & 3;
    const int vro = 8192 + (4 * hh + qq) * 128 + ((2 * blk + (pp >> 1)) << 4) + 8 * (pp & 1), vq6 = ((qq >> 1) & 1) << 6;
    LAS float* scr = (LAS float*)(lds + 132096 + wave * 256);
    const int total = nunits * NTL;
#define BAND_TILE_DMA(sp) do { const int sp_ = (sp) < total ? (sp) : total - 1; const int k_ = sp_ / NTL, t_ = sp_ % NTL; const BandDesc D_ = get(k_); \
        int j_ = D_.jstart + 64 * t_ + srow; j_ = j_ < 0 ? 0 : (j_ > D_.L - 1 ? D_.L - 1 : j_); const unsigned st_ = lbase + ((sp) & 3) * 16384 + wave * 1024; \
        ATT_GLDS(D_.Kb + (size_t)j_ * D_.kstride + kchs, st_); ATT_GLDS(D_.Vb + (size_t)j_ * D_.kstride + vchs, st_ + 8192); } while (0)
#define BAND_Q_DMA(ku, d0) do { const int ku_ = (ku) < nunits ? (ku) : nunits - 1; const BandDesc D_ = get(ku_); \
        ATT_GLDS(D_.qrow + 16 * (d0) + 8 * hh, lbase + 65536 + ((ku) & 1) * 32768 + wave * 4096 + (d0) * 1024); } while (0)
    BAND_Q_DMA(0, 0); BAND_Q_DMA(0, 1); BAND_Q_DMA(0, 2); BAND_Q_DMA(0, 3);
    BAND_TILE_DMA(0); BAND_TILE_DMA(1);
    asm volatile("s_waitcnt vmcnt(2)\n\ts_barrier" ::: "memory");
    bf16x8 q[4]; f32x16 O[2]; float m = 0.f, l = 0.f;
    O[0] = f32x16{}; O[1] = f32x16{};
#pragma unroll
    for (int d0 = 0; d0 < 4; ++d0) q[d0] = bf16x8{};
    int k = 0, t = 0;
    for (int s = 0; s < total; ++s) {
        BAND_TILE_DMA(s + 2); BAND_Q_DMA(k + 1, (t < 4 ? t : 3));
        const BandDesc D = get(k);
        if (t == 0) {
            const LAS unsigned char* qs = lds + 65536 + (k & 1) * 32768 + wave * 4096 + lane * 16;
#pragma unroll
            for (int d0 = 0; d0 < 4; ++d0) q[d0] = *(const LAS bf16x8*)(qs + d0 * 1024);
            O[0] = f32x16{}; O[1] = f32x16{}; m = D.m0; l = D.l0;
        }
        const LAS unsigned char* st = lds + (s & 3) * 16384;
        if (t >= D.tlo && t <= D.thi) {
            f32x16 s0, s1;
            qk_tile(s0, s1, st, q, kro, kx6);
            const int ts = D.jstart + 64 * t;
            if (!(ts >= D.qi0 + 31 - HALFW && ts + 63 <= D.qi0 + HALFW && ts >= 0 && ts + 63 < D.L)) {
                const int jb = ts + 4 * hh, qi = D.qi0 + r;
#pragma unroll
                for (int i = 0; i < 16; ++i) {
                    const int j0 = jb + (i & 3) + 8 * (i >> 2), j1 = j0 + 32;
                    if (!(((unsigned)j0 < (unsigned)D.L) && ((unsigned)(j0 - qi + HALFW) <= (unsigned)(2 * HALFW)))) s0[i] = -INFINITY;
                    if (!(((unsigned)j1 < (unsigned)D.L) && ((unsigned)(j1 - qi + HALFW) <= (unsigned)(2 * HALFW)))) s1[i] = -INFINITY;
                }
            }
            softmax_tile<2>(s0, s1, m, l, O, scr, r, hh);
            bf16x8 P[4]; P[0] = pack8<0>(s0); P[1] = pack8<1>(s0); P[2] = pack8<0>(s1); P[3] = pack8<1>(s1);
#pragma unroll
            for (int c = 0; c < 2; ++c)
#pragma unroll
                for (int kc = 0; kc < 4; ++kc) {
                    const LAS unsigned char* vp = st + vro + (vq6 ^ (c << 6)) + kc * 2048;
                    const bf16x8 vf = cat8(vtr(vp), vtr(vp + 1024));
                    O[c] = MFMA32(P[kc], vf, O[c]);
                }
        }
        if (t == NTL - 1 && D.tlo <= D.thi) {
            const float lt = hsum(l);
            if (hh == 0) scr[r] = 1.0f / lt;
            if (LSE_OUT) { if (hh == 0) D.lse[(size_t)(D.qi0 + r) * D.lstride] = m + log2f(lt); }
#pragma unroll
            for (int g = 0; g < 4; ++g) { const f32x4 a4 = *(const LAS f32x4*)(scr + 8 * g + 4 * hh);
#pragma unroll
                for (int kk = 0; kk < 4; ++kk) { bf16_t* op = D.out + (size_t)(D.qi0 + 8 * g + 4 * hh + kk) * D.ostride + r;
                    op[0] = (bf16_t)f2bf(O[0][4 * g + kk] * a4[kk]); op[32] = (bf16_t)f2bf(O[1][4 * g + kk] * a4[kk]); } }
        }
        asm volatile("s_waitcnt vmcnt(3) lgkmcnt(0)\n\ts_barrier" ::: "memory");
        if (++t == NTL) { t = 0; ++k; }
    }
    asm volatile("s_waitcnt vmcnt(0)\n\ts_barrier" ::: "memory");
#undef BAND_TILE_DMA
#undef BAND_Q_DMA
}

template <int NB>
ADI void softmax_tile8(f32x16& s0, f32x16& s1, float& m, float& l, f32x16 (&O)[NB], LAS float* scr, int r, int hh) {
    float mxa = max3f(s0[0], s0[1], s1[0]), mxb = max3f(s0[2], s0[3], s1[1]); mxa = max3f(mxa, s1[2], s1[3]);
#pragma unroll
    for (int i = 4; i < 16; i += 4) { mxa = max3f(mxa, s0[i], s0[i + 1]); mxb = max3f(mxb, s0[i + 2], s0[i + 3]); mxa = max3f(mxa, s1[i], s1[i + 1]); mxb = max3f(mxb, s1[i + 2], s1[i + 3]); }
    float mx = hmax(max3f(mxa, mxb, mxb));
    if (__any(mx > m + 4.0f)) {
        const float mn = fmaxf(m, mx), al = fexp2(m - mn); l *= al; m = mn;
        if (hh == 0) scr[r] = al;
#pragma unroll
        for (int g = 0; g < 4; ++g) { const f32x4 a4 = *(const LAS f32x4*)(scr + 8 * g + 4 * hh);
#pragma unroll
            for (int c = 0; c < NB; ++c) { O[c][4 * g] *= a4[0]; O[c][4 * g + 1] *= a4[1]; O[c][4 * g + 2] *= a4[2]; O[c][4 * g + 3] *= a4[3]; } }
    }
    const float m4 = m - 4.0f;
    float sa = 0.f, sb = 0.f, sc = 0.f, sd = 0.f;
#pragma unroll
    for (int i = 0; i < 16; i += 2) { s0[i] = fexp2(s0[i] - m4); s1[i] = fexp2(s1[i] - m4); s0[i + 1] = fexp2(s0[i + 1] - m4); s1[i + 1] = fexp2(s1[i + 1] - m4); sa += s0[i]; sb += s1[i]; sc += s0[i + 1]; sd += s1[i + 1]; }
    l += ((sa + sb) + (sc + sd)) * 0.0625f;
}

struct BandDesc8 { const unsigned char* Kb; const unsigned char* Vb; size_t kstride; int L, jstart; const unsigned char* qrow; int qi0, tlo, thi; float m0, l0; bf16_t* out; size_t ostride; float* lse; size_t lstride; };
template <int NTL, int HALFW, class F, bool OUT8 = false>
ADI void band_stream8(LAS unsigned char* lds, int nunits, const F& get, int tid, int lane, int wave) {
    static_assert(2 * NTL * 8192 + 32768 <= 132096, "LDS");
    const int r = lane & 31, hh = lane >> 5;
    const unsigned lbase = (unsigned)(uintptr_t)lds;
    const bool isV = wave >= 4;
    const int srow = 16 * (wave & 3) + (lane >> 2);
    const int soff = isV ? (((((lane >> 1) & 1) ^ ((srow >> 3) & 1)) << 5) + ((lane & 1) << 4)) : (((lane & 3) ^ ((srow >> 2) & 3)) << 4);
    const int kx = (r >> 2) & 3;
    const int kro0 = r * 64 + (((2 * hh) ^ kx) << 4), kro1 = r * 64 + (((2 * hh + 1) ^ kx) << 4);
    const int ts_ = lane & 15, tblk = (lane >> 4) & 1, te = ts_ >> 1, tcol = ts_ & 1;
    const int tkey = (te & 3) + 8 * (te >> 2) + 4 * hh, tfx = (te >> 2) & 1;
    const int vro = 4096 + tkey * 64 + 16 * tblk + 8 * tcol;
    LAS float* scr = (LAS float*)(lds + 132096 + wave * 256);
    const int sK = 0x7f7f7f7f, sQ = 0x7b7b7b7b, sP = 0x7b7b7b7b, sV = 0x7f7f7f7f;
#define B8_UNIT_DMA(ku) do { if ((ku) < nunits) { const BandDesc8 D_ = get(ku); \
        _Pragma("unroll") for (int ti_ = 0; ti_ < NTL; ++ti_) { int j_ = D_.jstart + 64 * ti_ + srow; j_ = j_ < 0 ? 0 : (j_ > D_.L - 1 ? D_.L - 1 : j_); \
            ATT_GLDS((isV ? D_.Vb : D_.Kb) + (size_t)j_ * D_.kstride + soff, lbase + ((ku) & 1) * (NTL * 8192) + ti_ * 8192 + wave * 1024); } \
        ATT_GLDS(D_.qrow + 32 * hh, lbase + 2 * NTL * 8192 + ((ku) & 1) * 16384 + wave * 2048); \
        ATT_GLDS(D_.qrow + 32 * hh + 16, lbase + 2 * NTL * 8192 + ((ku) & 1) * 16384 + wave * 2048 + 1024); } } while (0)
    B8_UNIT_DMA(0);
    asm volatile("s_waitcnt vmcnt(0)\n\ts_barrier" ::: "memory");
    for (int k = 0; k < nunits; ++k) {
        B8_UNIT_DMA(k + 1);
        const BandDesc8 D = get(k);
        const int tlo = __builtin_amdgcn_readfirstlane(D.tlo), thi = __builtin_amdgcn_readfirstlane(D.thi);
        if (tlo <= thi) {
            v8i_a q8; f32x16 O[2]; float m = D.m0, l = D.l0;
            {
                const LAS unsigned char* qs = lds + 2 * NTL * 8192 + (k & 1) * 16384 + wave * 2048 + lane * 16;
                const v4i_a qa = *(const LAS v4i_a*)qs, qb = *(const LAS v4i_a*)(qs + 1024);
                q8 = __builtin_shufflevector(qa, qb, 0, 1, 2, 3, 4, 5, 6, 7);
            }
            O[0] = f32x16{}; O[1] = f32x16{};
#pragma unroll 1
            for (int t = tlo; t <= thi; ++t) {
                const LAS unsigned char* st = lds + (k & 1) * (NTL * 8192) + t * 8192;
                f32x16 s0, s1;
                {
                    const v4i_a a0 = *(const LAS v4i_a*)(st + kro0), a1 = *(const LAS v4i_a*)(st + kro1), b0 = *(const LAS v4i_a*)(st + 2048 + kro0), b1 = *(const LAS v4i_a*)(st + 2048 + kro1);
                    const v8i_a k0 = __builtin_shufflevector(a0, a1, 0, 1, 2, 3, 4, 5, 6, 7), k1 = __builtin_shufflevector(b0, b1, 0, 1, 2, 3, 4, 5, 6, 7);
                    asm volatile("v_mfma_scale_f32_32x32x64_f8f6f4 %0, %2, %4, 0, %5, %6 op_sel_hi:[0,0,0]\n\tv_mfma_scale_f32_32x32x64_f8f6f4 %1, %3, %4, 0, %5, %6 op_sel_hi:[0,0,0]\n\ts_nop 15\n\ts_nop 7"
                                 : "=&v"(s0), "=&v"(s1) : "v"(k0), "v"(k1), "v"(q8), "v"(sK), "v"(sQ));
                }
                const int ts = D.jstart + 64 * t;
                if (!(ts >= D.qi0 + 31 - HALFW && ts + 63 <= D.qi0 + HALFW && ts >= 0 && ts + 63 < D.L)) {
                    const int jb = ts + 4 * hh, qi = D.qi0 + r;
#pragma unroll
                    for (int i = 0; i < 16; ++i) {
                        const int j0 = jb + (i & 3) + 8 * (i >> 2), j1 = j0 + 32;
                        if (!(((unsigned)j0 < (unsigned)D.L) && ((unsigned)(j0 - qi + HALFW) <= (unsigned)(2 * HALFW)))) s0[i] = -INFINITY;
                        if (!(((unsigned)j1 < (unsigned)D.L) && ((unsigned)(j1 - qi + HALFW) <= (unsigned)(2 * HALFW)))) s1[i] = -INFINITY;
                    }
                }
                softmax_tile8<2>(s0, s1, m, l, O, scr, r, hh);
                v8i_a P8;
#pragma unroll
                for (int g = 0; g < 4; ++g) { P8[g] = (int)pk_fp8x4_nc(s0[4 * g], s0[4 * g + 1], s0[4 * g + 2], s0[4 * g + 3]); P8[4 + g] = (int)pk_fp8x4_nc(s1[4 * g], s1[4 * g + 1], s1[4 * g + 2], s1[4 * g + 3]); }
#pragma unroll
                for (int c = 0; c < 2; ++c) {
                    const LAS unsigned char* vp = st + vro + ((c ^ tfx) << 5);
                    const v2i_a t0 = __builtin_amdgcn_ds_read_tr8_b64_v2i32((LAS v2i_a*)(vp)), t1 = __builtin_amdgcn_ds_read_tr8_b64_v2i32((LAS v2i_a*)(vp + 16 * 64));
                    const v2i_a t2 = __builtin_amdgcn_ds_read_tr8_b64_v2i32((LAS v2i_a*)(vp + 32 * 64)), t3 = __builtin_amdgcn_ds_read_tr8_b64_v2i32((LAS v2i_a*)(vp + 48 * 64));
                    const v8i_a V8 = (v8i_a){t0[0], t0[1], t1[0], t1[1], t2[0], t2[1], t3[0], t3[1]};
                    asm volatile("s_nop 3\n\tv_mfma_scale_f32_32x32x64_f8f6f4 %0, %1, %2, %0, %3, %4 op_sel_hi:[0,0,0]" : "+v"(O[c]) : "v"(P8), "v"(V8), "v"(sP), "v"(sV));
                }
            }
            asm volatile("s_nop 15\n\ts_nop 15" ::: "memory");
            const float lt = hsum(l);
            if (hh == 0) scr[r] = 1.0f / lt;
            asm volatile("s_waitcnt vmcnt(0)" ::: "memory");
            if (hh == 0 && D.lse != nullptr) D.lse[(size_t)(D.qi0 + r) * D.lstride] = m + log2f(lt);
#pragma unroll
            for (int g = 0; g < 4; ++g) { const f32x4 a4 = *(const LAS f32x4*)(scr + 8 * g + 4 * hh);
#pragma unroll
                for (int kk = 0; kk < 4; ++kk) {
                    if constexpr (OUT8) { unsigned char* op = (unsigned char*)D.out + (size_t)(D.qi0 + 8 * g + 4 * hh + kk) * D.ostride + r;
                        op[0] = fp8_byte(O[0][4 * g + kk] * a4[kk]); op[32] = fp8_byte(O[1][4 * g + kk] * a4[kk]); }
                    else { bf16_t* op = D.out + (size_t)(D.qi0 + 8 * g + 4 * hh + kk) * D.ostride + r;
                    op[0] = (bf16_t)f2bf(O[0][4 * g + kk] * a4[kk]); op[32] = (bf16_t)f2bf(O[1][4 * g + kk] * a4[kk]); } } }
        } else {
            asm volatile("s_waitcnt vmcnt(0)" ::: "memory");
        }
        asm volatile("s_waitcnt lgkmcnt(0)\n\ts_barrier" ::: "memory");
    }
    asm volatile("s_waitcnt vmcnt(0)\n\ts_barrier" ::: "memory");
#undef B8_UNIT_DMA
}
}

__device__ __forceinline__ void attn_B(const Ctx& C) {
    const bf16_t* QKV = WSP(bf16_t, WS_BIG + BIG_QKV); bf16_t* O = WSP(bf16_t, WS_O); const float* subln = IN_F(15);
    const float lam = diff_lambda(C);
    const int vcu = (C.G % 8 == 0) ? (C.bid % 8) * (C.G / 8) + C.bid / 8 : C.bid;
    for (int u = vcu; u < 1024; u += C.G) {
        const int k = u / C.G, v = u % C.G; int bh, qb;
        if (C.G == 256) { bh = v >> 4; qb = (v & 15) * 4 + k; } else { bh = u >> 6; qb = u & 63; }
        att::diff_unit(C.lds, (const unsigned char*)QKV, O, subln, lam, bh >> 3, bh & 7, qb, C.tid, C.lane, C.wave);
    }
}

struct GetA {
    const bf16_t* QKV; bf16_t* OG; float* LSE; int vcu, G, wave, r;
    __device__ __forceinline__ att::BandDesc operator()(int k) const {
        const int U = vcu + k * G; att::BandDesc D;
        const bool ok = U < 3072; const int Uc = ok ? U : 0;
        const int v = Uc & 31, t3 = Uc >> 5, gi = t3 % 3, bh = t3 / 3, b = bh >> 4, h = bh & 15;
        const int sh = 2 * gi, dil = 1 << sh, Lg = SEQ >> sh, nqb = 32 >> sh, res = v >> (5 - sh), i0 = (v & (nqb - 1)) << 8;
        const size_t tok0 = (size_t)b * SEQ + res;
        const bf16_t* base = QKV + tok0 * NQKV_A + gi * 3072 + h * 64;
        D.Kb = base + 1024; D.Vb = base + 2048; D.kstride = (size_t)dil * NQKV_A; D.L = Lg; D.jstart = i0 - 64;
        D.qi0 = i0 + 32 * wave; D.tlo = ok ? (wave >> 1) : 1; D.thi = ok ? ((32 * wave + 159) >> 6) : 0; D.m0 = -1e30f; D.l0 = 0.f;
        D.qrow = base + (size_t)(D.qi0 + r) * dil * NQKV_A;
        D.out = OG + ((size_t)gi * NTOK + tok0) * DM + h * 64; D.ostride = (size_t)dil * DM;
        D.lse = LSE + ((size_t)gi * NTOK + tok0) * 16 + h; D.lstride = (size_t)dil * 16;
        return D;
    }
};
struct GetA8 {
    const unsigned char* QKV8; bf16_t* OG; float* LSE; int vcu, G, wave, r;
    __device__ __forceinline__ att::BandDesc8 operator()(int k) const {
        const int U = vcu + k * G; att::BandDesc8 D;
        const bool ok = U < 3072; const int Uc = ok ? U : 0;
        const int v = Uc & 31, t3 = Uc >> 5, gi = t3 % 3, bh = t3 / 3, b = bh >> 4, h = bh & 15;
        const int sh = 2 * gi, dil = 1 << sh, Lg = SEQ >> sh, nqb = 32 >> sh, res = v >> (5 - sh), i0 = (v & (nqb - 1)) << 8;
        const size_t tok0 = (size_t)b * SEQ + res;
        const unsigned char* base = QKV8 + (size_t)(3 * gi) * ((size_t)NTOK * 1024) + (size_t)((b * 16 + h) * SEQ + res * Lg) * 64;
        D.Kb = base + (size_t)NTOK * 1024; D.Vb = base + (size_t)2 * NTOK * 1024; D.kstride = 64; D.L = Lg; D.jstart = i0 - 64;
        D.qi0 = i0 + 32 * wave; D.tlo = ok ? (wave >> 1) : 1; D.thi = ok ? ((32 * wave + 159) >> 6) : 0; D.m0 = -1e30f; D.l0 = 0.f;
        D.qrow = base + (size_t)(D.qi0 + r) * 64;
        D.out = OG + ((size_t)gi * NTOK + tok0) * DM + h * 64; D.ostride = (size_t)dil * DM;
        D.lse = LSE + ((size_t)gi * NTOK + tok0) * 16 + h; D.lstride = (size_t)dil * 16;
        return D;
    }
};
__device__ __forceinline__ void attn_A8(const Ctx& C) {
    GetA8 g; g.QKV8 = WSP(unsigned char, WS_BIG + BIG_QKV); g.OG = WSP(bf16_t, WS_BIG + BIG_OG); g.LSE = WSP(float, WS_LSE);
    g.vcu = (C.G % 8 == 0) ? (C.bid % 8) * (C.G / 8) + C.bid / 8 : C.bid; g.G = C.G; g.wave = C.wave; g.r = C.lane & 31;
    att::band_stream8<6, 64, GetA8>(C.lds, (3072 + C.G - 1) / C.G, g, C.tid, C.lane, C.wave);
}
__device__ __forceinline__ void attn_A(const Ctx& C) {
    GetA g; g.QKV = WSP(bf16_t, WS_BIG + BIG_QKV); g.OG = WSP(bf16_t, WS_BIG + BIG_OG); g.LSE = WSP(float, WS_LSE);
    g.vcu = (C.G % 8 == 0) ? (C.bid % 8) * (C.G / 8) + C.bid / 8 : C.bid; g.G = C.G; g.wave = C.wave; g.r = C.lane & 31;
    att::band_stream<6, 64, true, GetA>(C.lds, (3072 + C.G - 1) / C.G, g, C.tid, C.lane, C.wave);
}
struct GetC {
    const bf16_t* QKV; bf16_t* O; float sk0, sk1; int vcu, G, wave, r, hh;
    __device__ __forceinline__ att::BandDesc operator()(int k) const {
        const int U = vcu + k * G; att::BandDesc D;
        const bool ok = U < 1024; const int Uc = ok ? U : 0;
        const int qblk = Uc & 255, bg = Uc >> 8, b = bg >> 1, g = bg & 1, i0 = qblk * 32, head = 8 * g + wave;
        const bf16_t* base = QKV + (size_t)b * SEQ * NQKV_C;
        D.Kb = base + 1024 + g * 64; D.Vb = base + 1152 + g * 64; D.kstride = (size_t)NQKV_C; D.L = SEQ; D.jstart = i0 - 128;
        D.qi0 = i0; D.tlo = ok ? 0 : 1; D.thi = ok ? 4 : 0; D.m0 = (g ? sk1 : sk0) * LOG2E; D.l0 = hh == 0 ? 1.f : 0.f;
        D.qrow = base + (size_t)(i0 + r) * NQKV_C + head * 64;
        D.out = O + (size_t)b * SEQ * DM + head * 64; D.ostride = DM; D.lse = nullptr; D.lstride = 0;
        return D;
    }
};
struct GetC8 {
    const unsigned char* QKV8; bf16_t* O; float sk0, sk1; int vcu, G, wave, r, hh;
    __device__ __forceinline__ att::BandDesc8 operator()(int k) const {
        const int U = vcu + k * G; att::BandDesc8 D;
        const bool ok = U < 1024; const int Uc = ok ? U : 0;
        const int qblk = Uc & 255, bg = Uc >> 8, b = bg >> 1, g = bg & 1, i0 = qblk * 32, head = 8 * g + wave;
        const unsigned char* base = QKV8 + (size_t)b * SEQ * NQKV_C;
        D.Kb = base + 1024 + g * 64; D.Vb = base + 1152 + g * 64; D.kstride = (size_t)NQKV_C; D.L = SEQ; D.jstart = i0 - 128;
        D.qi0 = i0; D.tlo = ok ? 0 : 1; D.thi = ok ? 4 : 0; D.m0 = (g ? sk1 : sk0) * LOG2E; D.l0 = hh == 0 ? 1.f : 0.f;
        D.qrow = base + (size_t)(i0 + r) * NQKV_C + head * 64;
        D.out = (bf16_t*)((unsigned char*)O + (size_t)b * SEQ * DM + head * 64); D.ostride = DM; D.lse = nullptr; D.lstride = 0;
        return D;
    }
};
__device__ __forceinline__ void attn_C8(const Ctx& C) {
    GetC8 g; g.QKV8 = WSP(unsigned char, WS_BIG + BIG_QKV); g.O = WSP(bf16_t, WS_O); g.sk0 = IN_F(24)[C.wave]; g.sk1 = IN_F(24)[8 + C.wave];
    g.vcu = (C.G % 8 == 0) ? (C.bid % 8) * (C.G / 8) + C.bid / 8 : C.bid; g.G = C.G; g.wave = C.wave; g.r = C.lane & 31; g.hh = C.lane >> 5;
    asm volatile("s_waitcnt vmcnt(0)" ::: "memory");
    att::band_stream8<5, 128, GetC8, true>(C.lds, (1024 + C.G - 1) / C.G, g, C.tid, C.lane, C.wave);
}
__device__ __forceinline__ void attn_C(const Ctx& C) {
    GetC g; g.QKV = WSP(bf16_t, WS_BIG + BIG_QKV); g.O = WSP(bf16_t, WS_O); g.sk0 = IN_F(24)[C.wave]; g.sk1 = IN_F(24)[8 + C.wave];
    g.vcu = (C.G % 8 == 0) ? (C.bid % 8) * (C.G / 8) + C.bid / 8 : C.bid; g.G = C.G; g.wave = C.wave; g.r = C.lane & 31; g.hh = C.lane >> 5;
    asm volatile("s_waitcnt vmcnt(0)" ::: "memory");
    att::band_stream<5, 128, false, GetC>(C.lds, (1024 + C.G - 1) / C.G, g, C.tid, C.lane, C.wave);
}

__device__ __forceinline__ void combine_A(const Ctx& C) {
    const bf16_t* OG = WSP(bf16_t, WS_BIG + BIG_OG); const float* LSE = WSP(float, WS_LSE); bf16_t* O = WSP(bf16_t, WS_O);
    const int gw = C.bid * 8 + C.wave, NGW = C.G * 8, lane = C.lane, h = lane >> 2;
    for (int tok = gw; tok < NTOK; tok += NGW) {
        const float L0 = LSE[((size_t)0 * NTOK + tok) * 16 + h], L1 = LSE[((size_t)1 * NTOK + tok) * 16 + h], L2 = LSE[((size_t)2 * NTOK + tok) * 16 + h];
        const float M = fmaxf(L0, fmaxf(L1, L2));
        float w0 = exp2f(L0 - M), w1 = exp2f(L1 - M), w2 = exp2f(L2 - M); const float inv = 1.0f / (w0 + w1 + w2); w0 *= inv; w1 *= inv; w2 *= inv;
        u32x4 o8;
#pragma unroll
        for (int c = 0; c < 2; ++c) {
            const size_t off = (size_t)tok * DM + lane * 16 + c * 8;
            const u32x4 a = *(const u32x4*)(OG + off), b = *(const u32x4*)(OG + (size_t)NTOK * DM + off), d = *(const u32x4*)(OG + (size_t)2 * NTOK * DM + off);
            float f[8];
#pragma unroll
            for (int i = 0; i < 4; ++i) { f[2 * i] = w0 * bflo(a[i]) + w1 * bflo(b[i]) + w2 * bflo(d[i]); f[2 * i + 1] = w0 * bfhi(a[i]) + w1 * bfhi(b[i]) + w2 * bfhi(d[i]); }
            o8[2 * c] = pk_fp8x4(f[0], f[1], f[2], f[3]); o8[2 * c + 1] = pk_fp8x4(f[4], f[5], f[6], f[7]);
        }
        *(u32x4*)((unsigned char*)O + (size_t)tok * DM + lane * 16) = o8;
    }
}

template <int N, int MASK>
__device__ __forceinline__ void halve_step(float (&v)[64], int lane) {
    const bool up = (lane & MASK) != 0;
#pragma unroll
    for (int i = 0; i < N / 2; ++i) { const float keep = up ? v[i + N / 2] : v[i], send = up ? v[i] : v[i + N / 2]; v[i] = keep + __shfl_xor(send, MASK); }
}
__device__ __forceinline__ void moe_router(const Ctx& C, const float* gain, const float* router) {
    const bf16_t* X = WSP(bf16_t, WS_XB);
    LAS float* grt = (LAS float*)C.lds;
    LAS int* tE = (LAS int*)(C.lds + 32768); LAS float* tG0 = (LAS float*)(C.lds + 32768 + 256); LAS float* tG1 = (LAS float*)(C.lds + 32768 + 512);
    for (int i = C.tid; i < 8192; i += 512) { const int k = i >> 3, e = i & 7; grt[e * 1024 + k] = gain[k] * router[i]; }
    __syncthreads();
    int* gE = WSP(int, WS_TOK + TOK_E); float* gG0 = WSP(float, WS_TOK + TOK_G0); float* gG1 = WSP(float, WS_TOK + TOK_G1); int* gR = WSP(int, WS_TOK + TOK_RANK); int* hist = WSP(int, WS_TOK + TOK_HIST);
    const int lane = C.lane;
    for (int chunk = C.bid; chunk < NTOK / 64; chunk += C.G) {
        float v[64]; float sv[64];
        u32x2 raw[8][4];
#pragma unroll
        for (int j = 0; j < 8; ++j) { const u32x2* xr = (const u32x2*)(X + (size_t)(chunk * 64 + C.wave * 8 + j) * DM) + lane;
#pragma unroll
            for (int jj = 0; jj < 4; ++jj) raw[j][jj] = xr[64 * jj]; }
        asm volatile("" ::: "memory");
#pragma unroll
        for (int j = 0; j < 8; ++j) {
            f32x4 x[4]; float ss = 0.f;
#pragma unroll
            for (int jj = 0; jj < 4; ++jj) { const u32x2 w = raw[j][jj]; x[jj] = (f32x4){bflo(w.x), bfhi(w.x), bflo(w.y), bfhi(w.y)}; ss += (x[jj][0] * x[jj][0] + x[jj][1] * x[jj][1]) + (x[jj][2] * x[jj][2] + x[jj][3] * x[jj][3]); }
            sv[j] = ss;
#pragma unroll
            for (int e = 0; e < 8; ++e) { float a = 0.f;
#pragma unroll
                for (int jj = 0; jj < 4; ++jj) { const f32x4 w = *(const LAS f32x4*)(grt + e * 1024 + (64 * jj + lane) * 4); a += x[jj][0] * w[0]; a += x[jj][1] * w[1]; a += x[jj][2] * w[2]; a += x[jj][3] * w[3]; }
                v[j * 8 + e] = a; }
        }
        halve_step<64, 32>(v, lane); halve_step<32, 16>(v, lane); halve_step<16, 8>(v, lane); halve_step<8, 4>(v, lane); halve_step<4, 2>(v, lane); halve_step<2, 1>(v, lane);
        halve_step<8, 32>(sv, lane); halve_step<4, 16>(sv, lane); halve_step<2, 8>(sv, lane);
        float ss = sv[0]; ss += __shfl_xor(ss, 1); ss += __shfl_xor(ss, 2); ss += __shfl_xor(ss, 4);
        const float rstd = 1.0f / sqrtf(ss * (1.0f / 1024.0f) + NORM_EPS);
        const float val = v[0]; const int idx = lane & 7;
        float v0 = val; int e0 = idx;
#pragma unroll
        for (int o = 1; o < 8; o <<= 1) { const float ov = __shfl_xor(v0, o); const int oi = __shfl_xor(e0, o); if (ov > v0 || (ov == v0 && oi < e0)) { v0 = ov; e0 = oi; } }
        float v1 = (idx == e0) ? -INFINITY : val; int e1 = idx;
#pragma unroll
        for (int o = 1; o < 8; o <<= 1) { const float ov = __shfl_xor(v1, o); const int oi = __shfl_xor(e1, o); if (ov > v1 || (ov == v1 && oi < e1)) { v1 = ov; e1 = oi; } }
        const float ex = expf((v1 - v0) * rstd), g0 = 1.0f / (1.0f + ex), g1 = ex / (1.0f + ex);
        if (idx == 0) { const int tl = C.wave * 8 + (lane >> 3); tE[tl] = e0 | (e1 << 8); tG0[tl] = g0; tG1[tl] = g1; }
        __syncthreads();
        if (C.wave == 0) {
            const int ee = tE[C.lane], f0 = ee & 255, f1 = ee >> 8; int r0 = 0, r1 = 0;
            const unsigned long long lt = (1ull << C.lane) - 1ull;
#pragma unroll
            for (int e = 0; e < 8; ++e) {
                const unsigned long long b0 = __ballot(f0 == e), b1 = __ballot(f1 == e);
                const int before = __popcll(b0 & lt) + __popcll(b1 & lt);
                if (f0 == e) r0 = before; if (f1 == e) r1 = before;
                if (C.lane == 0) hist[chunk * 8 + e] = __popcll(b0) + __popcll(b1);
            }
            const int tok = chunk * 64 + C.lane;
            gE[tok] = ee; gG0[tok] = tG0[C.lane]; gG1[tok] = tG1[C.lane]; gR[tok] = r0 | (r1 << 16);
        }
        __syncthreads();
    }
}
__device__ __forceinline__ void moe_gather(const Ctx& C) {
    const bf16_t* X = WSP(bf16_t, WS_XB); unsigned char* XBUF = WSP(unsigned char, WS_BIG + BIG_XBUF);
    const int* gE = WSP(int, WS_TOK + TOK_E); const int* gR = WSP(int, WS_TOK + TOK_RANK); const int* hist = WSP(int, WS_TOK + TOK_HIST);
    int* gD0 = WSP(int, WS_TOK + TOK_D0); int* gD1 = WSP(int, WS_TOK + TOK_D1); int* pendg = WSP(int, WS_TOK + TOK_PEND);
    LAS int* pre = (LAS int*)C.lds;
    LAS int* tot = (LAS int*)(C.lds + 8192);
    {
        const int e = C.wave; int h4[4]; int s = 0;
#pragma unroll
        for (int i = 0; i < 4; ++i) { h4[i] = hist[(4 * C.lane + i) * 8 + e]; s += h4[i]; }
        int inc = s;
#pragma unroll
        for (int o = 1; o < 64; o <<= 1) { const int t = __shfl_up(inc, o); if (C.lane >= o) inc += t; }
        int ex = inc - s;
#pragma unroll
        for (int i = 0; i < 4; ++i) { pre[(4 * C.lane + i) * 8 + e] = ex; ex += h4[i]; }
        if (C.lane == 63) tot[e] = inc;
    }
    __syncthreads();
    if (C.tid == 0) { int p = 0; for (int e = 0; e < 8; ++e) { tot[8 + e] = p; p += ((tot[e] + 255) >> 8) << 8; tot[16 + e] = p; } }
    __syncthreads();
    if (C.bid == 0 && C.tid < 8) pendg[C.tid] = tot[16 + C.tid];
    if (C.bid == 0 && C.tid == 8) pendg[8] = tot[23] >> 8;
    for (int chunk = C.bid; chunk < NTOK / 64; chunk += C.G) {
        for (int tl = C.wave * 8; tl < C.wave * 8 + 8; ++tl) {
            const int tok = chunk * 64 + tl;
            const int ee = gE[tok], e0 = ee & 255, e1 = ee >> 8, rr = gR[tok];
            const int d0 = tot[8 + e0] + pre[chunk * 8 + e0] + (rr & 0xffff), d1 = tot[8 + e1] + pre[chunk * 8 + e1] + (rr >> 16);
            if (C.lane == 0) { gD0[tok] = d0; gD1[tok] = d1; }
            const u32x2* xr = (const u32x2*)(X + (size_t)tok * DM) + C.lane;
            f32x4 v[4]; float ss = 0.f;
#pragma unroll
            for (int j = 0; j < 4; ++j) { const u32x2 w = xr[64 * j]; v[j] = (f32x4){bflo(w.x), bfhi(w.x), bflo(w.y), bfhi(w.y)}; ss += (v[j][0] * v[j][0] + v[j][1] * v[j][1]) + (v[j][2] * v[j][2] + v[j][3] * v[j][3]); }
            const float rstd = 1.0f / sqrtf(wave_sum(ss) * (1.0f / 1024.0f) + NORM_EPS);
            unsigned* o0 = (unsigned*)(XBUF + (size_t)d0 * DM) + C.lane; unsigned* o1 = (unsigned*)(XBUF + (size_t)d1 * DM) + C.lane;
#pragma unroll
            for (int j = 0; j < 4; ++j) { const unsigned w = pk_fp8x4(v[j][0] * rstd, v[j][1] * rstd, v[j][2] * rstd, v[j][3] * rstd); o0[64 * j] = w; o1[64 * j] = w; }
        }
    }
    if (C.bid < 8) {
        const int e = C.bid, r0 = tot[8 + e] + tot[e], r1 = tot[16 + e];
        for (int i = C.tid; i < (r1 - r0) * 64; i += 512) *((u32x4*)(XBUF + (size_t)r0 * DM) + i) = (u32x4){0u, 0u, 0u, 0u};
    }
}
template <bool FINAL>
__device__ __forceinline__ void moe_combine(const Ctx& C, const float* gfinal) {
    bf16_t* XB = WSP(bf16_t, WS_XB); float* ssq = WSP(float, WS_SSQ); const bf16_t* Y = WSP(bf16_t, WS_BIG + BIG_YBUF);
    const float* gG0 = WSP(float, WS_TOK + TOK_G0); const float* gG1 = WSP(float, WS_TOK + TOK_G1); const int* gD0 = WSP(int, WS_TOK + TOK_D0); const int* gD1 = WSP(int, WS_TOK + TOK_D1);
    const int gw = C.bid * 8 + C.wave, NGW = C.G * 8;
    for (int tok = gw; tok < NTOK; tok += NGW) {
        const float g0 = gG0[tok], g1 = gG1[tok]; const int d0 = gD0[tok], d1 = gD1[tok];
        const u32x2* xr = (const u32x2*)(XB + (size_t)tok * DM) + C.lane;
        const u32x2* y0 = (const u32x2*)(Y + (size_t)d0 * DM) + C.lane; const u32x2* y1 = (const u32x2*)(Y + (size_t)d1 * DM) + C.lane;
        f32x4 v[4]; float ss = 0.f;
#pragma unroll
        for (int j = 0; j < 4; ++j) { const u32x2 xw = xr[64 * j]; const f32x4 x = (f32x4){bflo(xw.x), bfhi(xw.x), bflo(xw.y), bfhi(xw.y)}; const u32x2 a = y0[64 * j], b = y1[64 * j];
            v[j][0] = x[0] + g0 * bflo(a.x) + g1 * bflo(b.x); v[j][1] = x[1] + g0 * bfhi(a.x) + g1 * bfhi(b.x);
            v[j][2] = x[2] + g0 * bflo(a.y) + g1 * bflo(b.y); v[j][3] = x[3] + g0 * bfhi(a.y) + g1 * bfhi(b.y);
            ss += (v[j][0] * v[j][0] + v[j][1] * v[j][1]) + (v[j][2] * v[j][2] + v[j][3] * v[j][3]); }
        const float tot = wave_sum(ss);
        if (FINAL) {
            const float rstd = 1.0f / sqrtf(tot * (1.0f / 1024.0f) + NORM_EPS);
            f32x4* o = (f32x4*)(C.out + (size_t)tok * DM) + C.lane; const f32x4* gf = (const f32x4*)gfinal + C.lane;
#pragma unroll
            for (int j = 0; j < 4; ++j) { const f32x4 g = gf[64 * j]; o[64 * j] = v[j] * rstd * g; }
        } else {
            u32x2* bo = (u32x2*)(XB + (size_t)tok * DM) + C.lane;
#pragma unroll
            for (int j = 0; j < 4; ++j) { u32x2 w; w.x = pk2(v[j][0], v[j][1]); w.y = pk2(v[j][2], v[j][3]); bo[64 * j] = w; }
            write_ssq_row(ssq, tok, tot, C.lane);
        }
    }
}

constexpr int RTAB_OFF = 134144, RTAB_UNITS = 13;
template <class Epi, bool FP8 = false>
__device__ __forceinline__ void dense_gemm(const Ctx& C, const bf16_t* A, const bf16_t* Bt, int M, int N, int K, const Epi& E, const float* ssq = nullptr, int sx = SC_ONE) {
    pg8::Gemm g{A, Bt, M, N, FP8 ? K / 2 : K, 0, SC_W8, sx}; pg8::StaticOrder S; S.init(M, N, C.G, C.bid);
    if (ssq) {
        LAS float* tab = (LAS float*)(C.lds + RTAB_OFF); pg8::Unit u;
        for (int i = C.tid >> 8; i < RTAB_UNITS && S.next(i, u); i += 2) tab[i * 256 + (C.tid & 255)] = pg8::row_rstd(ssq, u.pm * 256 + (C.tid & 255));
        __syncthreads();
    }
    pg8::gemm_phase<Epi, pg8::StaticOrder, FP8>(C.lds, g, S, E);
}
template <class Epi>
__device__ __forceinline__ void moe_gemm(const Ctx& C, const bf16_t* A, const bf16_t* Bt, int NC, int K, const Epi& E) {
    const int* pendg = WSP(int, WS_TOK + TOK_PEND);
    pg8::GroupedOrder S; S.NC = NC; S.G = C.G; S.c = C.bid;
#pragma unroll
    for (int e = 0; e < 8; ++e) S.pend[e] = __builtin_amdgcn_readfirstlane(pendg[e]);
    S.RT = __builtin_amdgcn_readfirstlane(pendg[8]);
    pg8::Gemm g{A, Bt, S.RT * 256, NC * 256, K / 2, 0, SC_W8, SC_ONE};
    pg8::gemm_phase<Epi, pg8::GroupedOrder, true>(C.lds, g, S, E);
}

constexpr int DOWN_NSL = 7, DOWN_SNT = 4;
__device__ __forceinline__ void moe_gemm_down(const Ctx& C, const bf16_t* A, const bf16_t* Bt, bf16_t* Y, float* part) {
    const int* pendg = WSP(int, WS_TOK + TOK_PEND);
    pg8::GroupedOrderK S; S.NC = 4; S.G = C.G; S.c = C.bid; S.NSL = DOWN_NSL; S.SNT = DOWN_SNT;
#pragma unroll
    for (int e = 0; e < 8; ++e) S.pend[e] = __builtin_amdgcn_readfirstlane(pendg[e]);
    S.RT = __builtin_amdgcn_readfirstlane(pendg[8]);
    const int full = 2 * C.G / 4, rtf = S.RT < full ? S.RT : full;
    pg8::Gemm g{A, Bt, S.RT * 256, 1024, FFE / 2, 0, SC_W8, SC_H8};
    pg8::EpiPlainK E{Y, DM, part, rtf, DOWN_NSL};
    pg8::gemm_phase<pg8::EpiPlainK, pg8::GroupedOrderK, true>(C.lds, g, S, E);
}
__device__ __forceinline__ void moe_down_reduce(const Ctx& C, bf16_t* Y, const float* part) {
    const int* pendg = WSP(int, WS_TOK + TOK_PEND);
    const int RT = pendg[8], full = 2 * C.G / 4, rtf = RT < full ? RT : full;
    const int nitems = (RT - rtf) * 256 * 128;
    for (int it = C.bid * 512 + C.tid; it < nitems; it += C.G * 512) {
        const int cg = it & 127, row = it >> 7, trel = row >> 8, lr = row & 255, ct = cg >> 5, lc = (cg & 31) * 8;
        const float* p = part + (size_t)((trel * 4 + ct) * DOWN_NSL) * 65536 + (size_t)lr * 256 + lc;
        f32x4 a = (f32x4){0.f, 0.f, 0.f, 0.f}, b = a;
#pragma unroll
        for (int ks = 0; ks < DOWN_NSL; ++ks) { a += *(const f32x4*)(p + (size_t)ks * 65536); b += *(const f32x4*)(p + (size_t)ks * 65536 + 4); }
        u32x4 w; w.x = pk2(a[0], a[1]); w.y = pk2(a[2], a[3]); w.z = pk2(b[0], b[1]); w.w = pk2(b[2], b[3]);
        *(u32x4*)(Y + (size_t)((rtf + trel) * 256 + lr) * DM + ct * 256 + lc) = w;
    }
}

constexpr int N_PHASES = 29;
struct Args { const void* in[39]; float* out; unsigned char* ws; int ph_lo, ph_hi; };

__global__ void __launch_bounds__(512, 2) fwd_kernel(Args args) {
    extern __shared__ __attribute__((aligned(16))) unsigned char lds_raw[];
    Ctx C0;
    C0.lds = (LAS unsigned char*)lds_raw; C0.ws = args.ws; C0.in = args.in; C0.out = args.out;
    C0.tid = threadIdx.x; C0.lane = C0.tid & 63; C0.wave = __builtin_amdgcn_readfirstlane(C0.tid >> 6); C0.G = gridDim.x; C0.bid = blockIdx.x;
    const Ctx& C = C0;
    volatile LAS unsigned* MISC = (volatile LAS unsigned*)(C.lds + MISC_OFF);
    for (int u = C.tid; u < (LDS_BYTES - RING_BYTES) / 4; u += 512) ((LAS unsigned*)(C.lds + RING_BYTES))[u] = 0u;
    __syncthreads();
    XcdBarrier bar; bar.bar = WSP(unsigned, WS_CTL) + CW_BAR; bar.x = 0; bar.st = nullptr;
    if (MK_SINGLE) bar = xcd_barrier_post(WSP(unsigned, WS_CTL) + CW_BAR, MISC + 8);
    const int lo = args.ph_lo, hi = args.ph_hi;
#define IN(k) (lo <= (k) && (k) < hi)
#define SEAM(k) do { if (IN(k) && IN((k) + 1)) xcd_barrier(bar); else __syncthreads(); } while (0)
#define PHASE(k, ...) if (IN(k)) { Ctx C = C0; { int t_ = (int)threadIdx.x; asm volatile("" : "+v"(t_)); C.tid = t_; C.lane = t_ & 63; } { __VA_ARGS__ } if (PROBE_PHASE == (k)) { xcd_barrier(bar); { __VA_ARGS__ } } } SEAM(k);

    const LAS float* const RTAB = (const LAS float*)(C.lds + RTAB_OFF);
    bf16_t* const XB = WSP(bf16_t, WS_XB); float* const SSQ = WSP(float, WS_SSQ); const float* const ROPE = WSP(float, WS_ROPE);
    bf16_t* const QKV = WSP(bf16_t, WS_BIG + BIG_QKV); bf16_t* const OB = WSP(bf16_t, WS_O); bf16_t* const HB = WSP(bf16_t, WS_BIG + BIG_H);
    bf16_t* const XBUF = WSP(bf16_t, WS_BIG + BIG_XBUF); bf16_t* const YBUF = WSP(bf16_t, WS_BIG + BIG_YBUF); bf16_t* const HBUF = WSP(bf16_t, WS_BIG + BIG_HBUF);

    PHASE(0, convert_weights_first(C); rope_table(C); x_to_bf16(C);)
    PHASE(1, pg8::EpiQKV E{QKV, NQKV_A, RTAB, ROPE, 3072, 2048, nullptr, (unsigned char*)QKV, 1}; dense_gemm<pg8::EpiQKV, true>(C, WSP(bf16_t, WS_X8), WSP(bf16_t, WS_WQKV0), NTOK, NQKV_A, DM, E, SSQ, SC_ONE);)
    PHASE(2, attn_A8(C);)
    PHASE(3, combine_A(C);)
    PHASE(4, pg8::EpiRes E{XB, SSQ, DM, nullptr}; dense_gemm<pg8::EpiRes, true>(C, OB, WSP(bf16_t, WS_WO0), NTOK, DM, DM, E, nullptr, SC_ONE);)
    PHASE(5, pg8::EpiSwiGLU E{HB, FF, RTAB}; dense_gemm(C, XB, WSP(bf16_t, WS_W13_0), NTOK, 2 * FF, DM, E, SSQ);)
    PHASE(6, pg8::EpiRes E{XB, SSQ, DM, nullptr}; dense_gemm(C, HB, WSP(bf16_t, WS_W2_0), NTOK, DM, FF, E);)
    PHASE(7, pg8::EpiQKV E{QKV, NQKV_B, RTAB, ROPE, 3072, 2048, nullptr, (unsigned char*)QKV}; dense_gemm(C, XB, WSP(bf16_t, WS_WQKV1), NTOK, NQKV_B, DM, E, SSQ);)
    PHASE(8, attn_B(C);)
    PHASE(9, pg8::EpiRes E{XB, SSQ, DM, nullptr}; dense_gemm(C, OB, WSP(bf16_t, WS_WO1), NTOK, DM, DM, E);)
    PHASE(10, moe_router(C, IN_F(17), IN_F(18));)
    PHASE(11, moe_gather(C);)
    PHASE(12, pg8::EpiSwiGLU8 E{(unsigned char*)HBUF, FFE}; moe_gemm(C, XBUF, WSP(bf16_t, WS_WM13), 2 * FFE / 256, DM, E);)
    PHASE(13, moe_gemm_down(C, HBUF, WSP(bf16_t, WS_WM2), YBUF, WSP(float, WS_BIG + BIG_XBUF));)
    PHASE(14, moe_down_reduce(C, YBUF, WSP(float, WS_BIG + BIG_XBUF)); xcd_barrier(bar); moe_combine<false>(C, nullptr); convert_weights_second(C);)
    PHASE(15, pg8::EpiQKV E{QKV, NQKV_C, RTAB, ROPE, 4096, 1152, nullptr, (unsigned char*)QKV}; dense_gemm(C, XB, WSP(bf16_t, WS_WQKV2), NTOK, NQKV_C, DM, E, SSQ);)
    PHASE(16, attn_C8(C);)
    PHASE(17, pg8::EpiRes E{XB, SSQ, DM, WSP(unsigned char, WS_X8)}; dense_gemm<pg8::EpiRes, true>(C, OB, WSP(bf16_t, WS_WO2), NTOK, DM, DM, E, nullptr, SC_ONE);)
    PHASE(18, pg8::EpiSwiGLU E{HB, FF, RTAB}; dense_gemm<pg8::EpiSwiGLU, true>(C, WSP(bf16_t, WS_X8), WSP(bf16_t, WS_W13_2), NTOK, 2 * FF, DM, E, SSQ, SC_ONE);)
    PHASE(19, pg8::EpiRes E{XB, SSQ, DM, WSP(unsigned char, WS_X8)}; dense_gemm(C, HB, WSP(bf16_t, WS_W2_2), NTOK, DM, FF, E);)
    PHASE(20, pg8::EpiQKV E{QKV, NQKV_A, RTAB, ROPE, 3072, 2048, nullptr, (unsigned char*)QKV, 1}; dense_gemm<pg8::EpiQKV, true>(C, WSP(bf16_t, WS_X8), WSP(bf16_t, WS_WQKV3), NTOK, NQKV_A, DM, E, SSQ, SC_ONE);)
    PHASE(21, attn_A8(C);)
    PHASE(22, combine_A(C);)
    PHASE(23, pg8::EpiRes E{XB, SSQ, DM, nullptr}; dense_gemm<pg8::EpiRes, true>(C, OB, WSP(bf16_t, WS_WO3), NTOK, DM, DM, E, nullptr, SC_ONE);)
    PHASE(24, moe_router(C, IN_F(33), IN_F(34));)
    PHASE(25, moe_gather(C);)
    PHASE(26, pg8::EpiSwiGLU8 E{(unsigned char*)HBUF, FFE}; moe_gemm(C, XBUF, WSP(bf16_t, WS_WM13), 2 * FFE / 256, DM, E);)
    PHASE(27, moe_gemm_down(C, HBUF, WSP(bf16_t, WS_WM2), YBUF, WSP(float, WS_BIG + BIG_XBUF));)
    if (IN(28)) { Ctx C = C0; { int t_ = (int)threadIdx.x; asm volatile("" : "+v"(t_)); C.tid = t_; C.lane = t_ & 63; } moe_down_reduce(C, YBUF, WSP(float, WS_BIG + BIG_XBUF)); xcd_barrier(bar); moe_combine<true>(C, IN_F(38)); }
#undef IN
#undef SEAM
#undef PHASE
}

extern "C" void kernel_launch(void* const* d_in, const int* in_sizes, int n_in, void* d_out, int out_size, void* d_ws, size_t ws_size, hipStream_t stream) {
    static int grid = 0;
    if (grid == 0) {
        if (n_in != 39 || out_size != NTOK * DM || ws_size < WS_END) { fprintf(stderr, "kernel_launch: unexpected shapes (n_in %d out %d ws %zu)\n", n_in, out_size, ws_size); grid = -1; return; }
        int dev = 0, cus = 0, per_cu = 0;
        if (hipGetDevice(&dev) != hipSuccess || hipDeviceGetAttribute(&cus, hipDeviceAttributeMultiprocessorCount, dev) != hipSuccess) { grid = -1; return; }
        if (hipFuncSetAttribute((const void*)fwd_kernel, hipFuncAttributeMaxDynamicSharedMemorySize, LDS_BYTES) != hipSuccess) { grid = -1; return; }
        if (hipOccupancyMaxActiveBlocksPerMultiprocessor(&per_cu, (const void*)fwd_kernel, 512, LDS_BYTES) != hipSuccess || per_cu < 1) { fprintf(stderr, "kernel_launch: occupancy query says %d\n", per_cu); }
        (void)hipGetLastError();
        grid = cus;
    }
    if (grid < 0) return;
    if (hipMemsetAsync((char*)d_ws + WS_CTL, 0, CTL_ZERO_BYTES, stream) != hipSuccess) return;
    Args a{};
    for (int i = 0; i < 39; ++i) a.in[i] = d_in[i];
    a.out = (float*)d_out; a.ws = (unsigned char*)d_ws;
#if MK_SINGLE
    a.ph_lo = 0; a.ph_hi = N_PHASES;
    hipLaunchKernelGGL(fwd_kernel, dim3(grid), dim3(512), LDS_BYTES, stream, a);
#else
    for (int p = 0; p < N_PHASES; ++p) { a.ph_lo = p; a.ph_hi = p + 1; hipLaunchKernelGGL(fwd_kernel, dim3(grid), dim3(512), LDS_BYTES, stream, a); }
#endif
}
```

```cpp
#include <hip/hip_runtime.h>
#include <cstdio>
#include <cstdint>
#include <cmath>

#ifndef MK_SINGLE
#define MK_SINGLE 1
#endif
#ifndef PROBE_PHASE
#define PROBE_PHASE -1
#endif

#define LAS __attribute__((address_space(3)))
#define GAS __attribute__((address_space(1)))
typedef unsigned short bf16_t;
typedef short bf16x8 __attribute__((ext_vector_type(8)));
typedef float f32x4 __attribute__((ext_vector_type(4)));
typedef float f32x2 __attribute__((ext_vector_type(2)));
typedef unsigned u32x4 __attribute__((ext_vector_type(4)));
typedef unsigned u32x2 __attribute__((ext_vector_type(2)));

constexpr int NTOK = 16384, SEQ = 8192, DM = 1024;
constexpr int NQKV_A = 9216, NQKV_B = 3072, NQKV_C = 1280;
constexpr int FF = 2816, FFE = 3584, NEXP = 8;
constexpr int MOE_ROWS = 32768 + 2048;
constexpr float LOG2E = 1.4426950408889634f;
constexpr float C2 = 0.125f * 1.4426950408889634f;
constexpr float NORM_EPS = 1e-6f, SUBLN_EPS = 1e-5f;
constexpr float LAMBDA_INIT = 0.35550906759096926f;

constexpr size_t MiB = 1u << 20;
constexpr size_t WS_CTL = 0, CTL_ZERO_BYTES = 1 * MiB;
constexpr size_t WS_ROPE = 1 * MiB;
constexpr size_t WS_SSQ = 2 * MiB;
constexpr size_t WS_TOK = 3 * MiB;
constexpr size_t WS_LSE = 4 * MiB;
constexpr size_t WS_WQKV0 = 8 * MiB, WS_WO0 = 26 * MiB, WS_W13_0 = 28 * MiB, WS_W2_0 = 39 * MiB;
constexpr size_t WS_WQKV1 = 45 * MiB, WS_WO1 = 51 * MiB;
constexpr size_t WS_WQKV2 = 53 * MiB, WS_WO2 = 56 * MiB, WS_W13_2 = 58 * MiB, WS_W2_2 = 69 * MiB;
constexpr size_t WS_WQKV3 = 75 * MiB, WS_WO3 = 93 * MiB;
constexpr size_t WS_WM13 = 96 * MiB, WS_WM2 = 208 * MiB;
constexpr size_t WS_X = 264 * MiB, WS_XB = 328 * MiB, WS_O = 360 * MiB, WS_BIG = 392 * MiB, WS_END = 776 * MiB;
constexpr size_t WS_VT8 = WS_X + 16 * MiB;
constexpr size_t WS_X8 = WS_X;
constexpr size_t BIG_QKV = 0, BIG_OG = 288 * MiB, BIG_H = 0, BIG_XBUF = 0, BIG_YBUF = 68 * MiB, BIG_HBUF = 136 * MiB;
constexpr size_t TOK_E = 0, TOK_G0 = 64 * 1024, TOK_G1 = 128 * 1024, TOK_RANK = 192 * 1024, TOK_D0 = 256 * 1024, TOK_D1 = 320 * 1024, TOK_HIST = 512 * 1024, TOK_PEND = 600 * 1024;
constexpr int CW_BAR = 4096;

constexpr int RING_BYTES = 131072;
constexpr int MISC_OFF = RING_BYTES + 320;
constexpr int LDS_BYTES = 147456;

__device__ __forceinline__ unsigned f2bf(float f) { unsigned u = __builtin_bit_cast(unsigned, f); return (u + 0x7fffu + ((u >> 16) & 1u)) >> 16; }
__device__ __forceinline__ unsigned pk2(float lo, float hi) { return f2bf(lo) | (f2bf(hi) << 16); }
__device__ __forceinline__ float bf2f(unsigned short b) { return __builtin_bit_cast(float, (unsigned)b << 16); }
__device__ __forceinline__ float bflo(unsigned w) { return __builtin_bit_cast(float, w << 16); }
__device__ __forceinline__ float bfhi(unsigned w) { return __builtin_bit_cast(float, w & 0xffff0000u); }
__device__ __forceinline__ float wave_sum(float v) {
#pragma unroll
    for (int o = 1; o < 64; o <<= 1) v += __shfl_xor(v, o);
    return v;
}
__device__ __forceinline__ float wave_max(float v) {
#pragma unroll
    for (int o = 1; o < 64; o <<= 1) v = fmaxf(v, __shfl_xor(v, o));
    return v;
}
#define LDS_WAIT() asm volatile("s_waitcnt lgkmcnt(0)" ::: "memory")
__device__ __forceinline__ unsigned pk_fp8x4(float a, float b, float c, float d) {
    a = fminf(fmaxf(a, -448.f), 448.f); b = fminf(fmaxf(b, -448.f), 448.f); c = fminf(fmaxf(c, -448.f), 448.f); d = fminf(fmaxf(d, -448.f), 448.f);
    int p = __builtin_bit_cast(int, a); p = __builtin_amdgcn_cvt_pk_fp8_f32(a, b, p, false); p = __builtin_amdgcn_cvt_pk_fp8_f32(c, d, p, true); return (unsigned)p;
}
__device__ __forceinline__ unsigned pk_fp8x4_nc(float a, float b, float c, float d) {
    int p; asm volatile("" : "=v"(p));
    p = __builtin_amdgcn_cvt_pk_fp8_f32(a, b, p, false); p = __builtin_amdgcn_cvt_pk_fp8_f32(c, d, p, true); return (unsigned)p;
}
__device__ __forceinline__ unsigned char fp8_byte(float x) { x = fminf(fmaxf(x, -448.f), 448.f); return (unsigned char)__builtin_amdgcn_cvt_pk_fp8_f32(x, x, 0, false); }
constexpr float W8_SCALE = 64.0f, H8_SCALE = 8.0f;
constexpr int SC_ONE = 0x7f7f7f7f, SC_W8 = 0x79797979, SC_H8 = 0x7c7c7c7c;

namespace pg8 {
#define PG8_LAS __attribute__((address_space(3)))
constexpr int BM = 256, BK = 64, HALF = 128, HTB = HALF * BK * 2, STAGE_BYTES = 8 * HTB, NXCD = 8, WGM = 8;

__host__ __device__ __forceinline__ int lds_byte(int r, int c) { const int st = (r >> 4) * 2 + (c >> 5), rr = r & 15, cc = c & 31, ob = rr * 64 + cc * 2; return st * 1024 + (ob ^ (((ob >> 9) & 1) << 5)); }
__host__ __device__ __forceinline__ void stage_rc(int b, int& R, int& C) { const int st = b / 1024, sb = b % 1024, swz = sb ^ (((sb >> 9) & 1) << 5); R = (st >> 1) * 16 + swz / 64; C = (st & 1) * 32 + (swz % 64) / 2; }
__host__ __device__ __forceinline__ int perm32(int rho) { const int n = rho >> 4, i = rho & 15; return 8 * (i >> 2) + 4 * n + (i & 3); }

__device__ __forceinline__ void glds16s(unsigned voff, unsigned long long sbase, unsigned lds_dst) { unsigned keep;
    asm volatile("s_mov_b32 %0, m0\n\ts_mov_b32 m0, %2\n\ts_nop 0\n\tglobal_load_lds_dwordx4 %1, %3\n\ts_mov_b32 m0, %0" : "=&s"(keep) : "v"(voff), "s"(lds_dst), "s"(sbase) : "memory"); }
struct Unit { int pm, pn, pc, koff, nt, mode; };
struct Gemm { const bf16_t* A; const bf16_t* Bt; int M, N, K, ld, sw, sx; };

struct StaticOrder {
    int nM, nN, nwg, G, c;
    __host__ __device__ void init(int M, int N, int G_, int c_) { nM = M / BM; nN = N / BM; nwg = nM * nN; G = G_; c = c_; }
    __host__ __device__ bool next(int i, Unit& u) const {
        const long L = (long)i * G + c; if (L >= nwg) return false;
        int wgid = (int)L; { const int q = nwg / NXCD, r = nwg % NXCD, xcd = wgid % NXCD, off = wgid / NXCD; wgid = (xcd < r ? xcd * (q + 1) : r * (q + 1) + (xcd - r) * q) + off; }
        const int nig = WGM * nN, gid = wgid / nig, fm = gid * WGM, gsz = (nM - fm) < WGM ? (nM - fm) : WGM;
        u.pm = fm + ((wgid % nig) % gsz); u.pn = (wgid % nig) / gsz; u.pc = u.pn; u.koff = 0; u.nt = 0; u.mode = 0; return true;
    }
};
struct GroupedOrder {
    int RT, NC, G, c; int pend[8];
    __device__ bool next(int i, Unit& u) const {
        const long L = (G % 8 == 0) ? ((long)(i * 8 + (c & 7)) * (G >> 3) + (c >> 3)) : ((long)i * G + c);
        if (L >= (long)RT * NC) return false;
        const int per = 8 * NC, blk = (int)(L / per), rem = (int)(L % per), rows = (RT - 8 * blk) < 8 ? (RT - 8 * blk) : 8;
        const int ct = rem / rows, rt = 8 * blk + rem % rows;
        int e = 0;
#pragma unroll
        for (int k = 0; k < 7; ++k) e += (rt * 256 >= pend[k]) ? 1 : 0;
        u.pm = rt; u.pn = e * NC + ct; u.pc = ct; u.koff = 0; u.nt = 0; u.mode = 0; return true;
    }
};
struct GroupedOrderK {
    int RT, NC, G, c, NSL, SNT; int pend[8];
    __device__ bool next(int i, Unit& u) const {
        const long L = (long)(i * 8 + (c & 7)) * (G >> 3) + (c >> 3);
        const int full = 2 * G / NC, RTF = RT < full ? RT : full;
        int rt, ct; u.koff = 0; u.nt = 0; u.mode = 0;
        if (L < (long)RTF * NC) {
            const int per = 8 * NC, blk = (int)(L / per), rem = (int)(L % per), rows = (RTF - 8 * blk) < 8 ? (RTF - 8 * blk) : 8;
            ct = rem / rows; rt = 8 * blk + rem % rows;
        } else {
            const long idx = L - (long)RTF * NC; if (idx >= (long)(RT - RTF) * NC * NSL) return false;
            const int su = (int)(idx / NSL), ks = (int)(idx % NSL);
            rt = RTF + su / NC; ct = su % NC; u.koff = ks * SNT * BK * 2; u.nt = SNT; u.mode = 1 + ks;
        }
        int e = 0;
#pragma unroll
        for (int k = 0; k < 7; ++k) e += (rt * 256 >= pend[k]) ? 1 : 0;
        u.pm = rt; u.pn = e * NC + ct; u.pc = ct; return true;
    }
};

typedef __bf16 bf16x2v __attribute__((ext_vector_type(2)));
__device__ __forceinline__ unsigned cvt_pk_bf16(float lo, float hi) { f32x2 v = {lo, hi}; bf16x2v b = __builtin_convertvector(v, bf16x2v); return __builtin_bit_cast(unsigned, b); }

__device__ __forceinline__ float row_rstd(const float* ssq, int row) {
    const f32x4* sp = (const f32x4*)(ssq + (size_t)row * 16);
    const f32x4 a = sp[0], b = sp[1], c = sp[2], d = sp[3];
    const float s = ((a[0] + a[1]) + (a[2] + a[3])) + ((b[0] + b[1]) + (b[2] + b[3])) + ((c[0] + c[1]) + (c[2] + c[3])) + ((d[0] + d[1]) + (d[2] + d[3]));
    return 1.0f / sqrtf(s * (1.0f / 1024.0f) + 1e-6f);
}
struct EpiQKV {
    static constexpr bool PERM = true;
    bf16_t* O; int ldc; const PG8_LAS float* rtab; const float* rope; int ropeMod, ropeLim; unsigned char* vt8; unsigned char* o8; int hm;
    __device__ __forceinline__ void operator()(const f32x4 (&acc)[2][2][4][2], const Unit& u, int ui, int wr, int wc, int fr, int fq) const {
        const int row0 = u.pm * BM + wr * 64 + fr;
        const int colh = wc * 32 + 8 * fq;
        const bool ropelane = ((wc & 1) == 0) && (fq < 2);
        const PG8_LAS float* rt = rtab + ui * 256 + wr * 64 + fr;
#pragma unroll
        for (int ai = 0; ai < 2; ++ai) {
            f32x4 cs[4], sn[4]; float rs[4];
#pragma unroll
            for (int m = 0; m < 4; ++m) {
                rs[m] = rt[ai * HALF + m * 16];
                cs[m] = (f32x4){1.f, 1.f, 1.f, 1.f}; sn[m] = (f32x4){0.f, 0.f, 0.f, 0.f};
                if (ropelane) { const float* rp = rope + (size_t)(row0 + ai * HALF + m * 16) * 16 + 4 * fq; cs[m] = *(const f32x4*)rp; sn[m] = *(const f32x4*)(rp + 8); }
            }
#pragma unroll
            for (int m = 0; m < 4; ++m) {
                const int row = row0 + ai * HALF + m * 16;
                const float r_ = rs[m]; const f32x4 c_ = cs[m], s_ = sn[m];
#pragma unroll
                for (int bj = 0; bj < 2; ++bj) {
                    const int colbase = u.pc * BM + bj * HALF;
                    f32x4 v0 = acc[ai][bj][m][0] * r_, v1 = acc[ai][bj][m][1] * r_;
                    if (ropelane && (colbase % ropeMod) < ropeLim) {
                        f32x4 w0, w1;
                        w0[0] = v0[0] * c_[0] - v0[1] * s_[0]; w0[1] = v0[1] * c_[0] + v0[0] * s_[0];
                        w0[2] = v0[2] * c_[1] - v0[3] * s_[1]; w0[3] = v0[3] * c_[1] + v0[2] * s_[1];
                        w1[0] = v1[0] * c_[2] - v1[1] * s_[2]; w1[1] = v1[1] * c_[2] + v1[0] * s_[2];
                        w1[2] = v1[2] * c_[3] - v1[3] * s_[3]; w1[3] = v1[3] * c_[3] + v1[2] * s_[3];
                        v0 = w0; v1 = w1;
                    }
                    if (o8) {
                        const float qs = ((colbase % 3072) < 1024) ? 16.0f : 1.0f;
                        u32x2 w8; w8.x = pk_fp8x4(v0[0] * qs, v0[1] * qs, v0[2] * qs, v0[3] * qs); w8.y = pk_fp8x4(v1[0] * qs, v1[1] * qs, v1[2] * qs, v1[3] * qs);
                        size_t off = (size_t)row * ldc + colbase + colh;
                        if (hm) { const int col = colbase + colh, blk = col >> 10, sh = 2 * ((blk * 11) >> 5), head = (col & 1023) >> 6, bb = row >> 13, t = row & (SEQ - 1);
                            off = (size_t)blk * ((size_t)NTOK * 1024) + (size_t)((bb * 16 + head) * SEQ + ((t & ((1 << sh) - 1)) << (13 - sh)) + (t >> sh)) * 64 + (col & 63); }
                        *(u32x2*)(o8 + off) = w8;
                    } else if (vt8 && colbase >= 2048) {
                        u32x2 w8; w8.x = pk_fp8x4(v0[0], v0[1], v0[2], v0[3]); w8.y = pk_fp8x4(v1[0], v1[1], v1[2], v1[3]);
                        *(u32x2*)(vt8 + (size_t)row * 1024 + (colbase - 2048) + colh) = w8;
                    } else {
                    u32x4 w; w.x = cvt_pk_bf16(v0[0], v0[1]); w.y = cvt_pk_bf16(v0[2], v0[3]); w.z = cvt_pk_bf16(v1[0], v1[1]); w.w = cvt_pk_bf16(v1[2], v1[3]);
                    *(u32x4*)(O + (size_t)row * ldc + colbase + colh) = w;
                    }
                }
            }
        }
    }
};
struct EpiSwiGLU {
    static constexpr bool PERM = true;
    bf16_t* O; int ldc; const PG8_LAS float* rtab;
    __device__ __forceinline__ void operator()(const f32x4 (&acc)[2][2][4][2], const Unit& u, int ui, int wr, int wc, int fr, int fq) const {
        const int row0 = u.pm * BM + wr * 64 + fr;
        const int col = u.pc * HALF + wc * 32 + 8 * fq;
#pragma unroll
        for (int ai = 0; ai < 2; ++ai)
#pragma unroll
            for (int m = 0; m < 4; ++m) {
                const int row = row0 + ai * HALF + m * 16;
                const float rs = rtab ? rtab[ui * 256 + wr * 64 + fr + ai * HALF + m * 16] : 1.0f;
                float h[8];
#pragma unroll
                for (int n = 0; n < 2; ++n)
#pragma unroll
                    for (int i = 0; i < 4; ++i) {
                        const float a = acc[ai][0][m][n][i] * rs, b = acc[ai][1][m][n][i] * rs;
                        h[n * 4 + i] = a * __builtin_amdgcn_rcpf(1.0f + __expf(-a)) * b;
                    }
                u32x4 w; w.x = cvt_pk_bf16(h[0], h[1]); w.y = cvt_pk_bf16(h[2], h[3]); w.z = cvt_pk_bf16(h[4], h[5]); w.w = cvt_pk_bf16(h[6], h[7]);
                *(u32x4*)(O + (size_t)row * ldc + col) = w;
            }
    }
};
struct EpiSwiGLU8 {
    static constexpr bool PERM = true;
    unsigned char* O; int ldc;
    __device__ __forceinline__ void operator()(const f32x4 (&acc)[2][2][4][2], const Unit& u, int ui, int wr, int wc, int fr, int fq) const {
        const int row0 = u.pm * BM + wr * 64 + fr;
        const int col = u.pc * HALF + wc * 32 + 8 * fq;
#pragma unroll
        for (int ai = 0; ai < 2; ++ai)
#pragma unroll
            for (int m = 0; m < 4; ++m) {
                const int row = row0 + ai * HALF + m * 16;
                float h[8];
#pragma unroll
                for (int n = 0; n < 2; ++n)
#pragma unroll
                    for (int i = 0; i < 4; ++i) { const float a = acc[ai][0][m][n][i], b = acc[ai][1][m][n][i]; h[n * 4 + i] = a * __builtin_amdgcn_rcpf(1.0f + __expf(-a)) * b * H8_SCALE; }
                u32x2 w; w.x = pk_fp8x4(h[0], h[1], h[2], h[3]); w.y = pk_fp8x4(h[4], h[5], h[6], h[7]);
                *(u32x2*)(O + (size_t)row * ldc + col) = w;
            }
    }
};
struct EpiRes {
    static constexpr bool PERM = false;
    bf16_t* XB; float* ssq; int ldc; unsigned char* X8;
    __device__ __forceinline__ void operator()(const f32x4 (&acc)[2][2][4][2], const Unit& u, int ui, int wr, int wc, int fr, int fq) const {
        const int row0 = u.pm * BM + wr * 64 + fr;
        const int col0 = u.pc * BM + wc * 32 + 4 * fq;
#pragma unroll
        for (int ai = 0; ai < 2; ++ai) {
            u32x2 rv[4][2][2];
#pragma unroll
            for (int m = 0; m < 4; ++m)
#pragma unroll
                for (int bj = 0; bj < 2; ++bj)
#pragma unroll
                    for (int n = 0; n < 2; ++n) rv[m][bj][n] = *(const u32x2*)(XB + (size_t)(row0 + ai * HALF + m * 16) * ldc + col0 + bj * HALF + n * 16);
#pragma unroll
            for (int m = 0; m < 4; ++m) {
                const int row = row0 + ai * HALF + m * 16;
                float q = 0.f;
#pragma unroll
                for (int bj = 0; bj < 2; ++bj)
#pragma unroll
                    for (int n = 0; n < 2; ++n) {
                        const size_t off = (size_t)row * ldc + col0 + bj * HALF + n * 16;
                        const u32x2 rr = rv[m][bj][n]; const f32x4 a = acc[ai][bj][m][n];
                        const float v0 = bflo(rr.x) + a[0], v1 = bfhi(rr.x) + a[1], v2 = bflo(rr.y) + a[2], v3 = bfhi(rr.y) + a[3];
                        q += (v0 * v0 + v1 * v1) + (v2 * v2 + v3 * v3);
                        u32x2 w; w.x = cvt_pk_bf16(v0, v1); w.y = cvt_pk_bf16(v2, v3); *(u32x2*)(XB + off) = w;
                        if (X8) *(unsigned*)(X8 + off) = pk_fp8x4(v0, v1, v2, v3);
                    }
                q += __shfl_xor(q, 16); q += __shfl_xor(q, 32);
                if (fq == 0) ssq[(size_t)row * 16 + u.pc * 4 + wc] = q;
            }
        }
    }
};
struct EpiPlain {
    static constexpr bool PERM = true;
    bf16_t* O; int ldc;
    __device__ __forceinline__ void operator()(const f32x4 (&acc)[2][2][4][2], const Unit& u, int ui, int wr, int wc, int fr, int fq) const {
        const int row0 = u.pm * BM + wr * 64 + fr;
        const int col0 = u.pc * BM + wc * 32 + 8 * fq;
#pragma unroll
        for (int ai = 0; ai < 2; ++ai)
#pragma unroll
            for (int m = 0; m < 4; ++m) {
                bf16_t* rowp = O + (size_t)(row0 + ai * HALF + m * 16) * ldc + col0;
#pragma unroll
                for (int bj = 0; bj < 2; ++bj) {
                    const f32x4 v0 = acc[ai][bj][m][0], v1 = acc[ai][bj][m][1];
                    u32x4 w; w.x = cvt_pk_bf16(v0[0], v0[1]); w.y = cvt_pk_bf16(v0[2], v0[3]); w.z = cvt_pk_bf16(v1[0], v1[1]); w.w = cvt_pk_bf16(v1[2], v1[3]);
                    *(u32x4*)(rowp + bj * HALF) = w;
                }
            }
    }
};

struct EpiPlainK {
    static constexpr bool PERM = true;
    bf16_t* O; int ldc; float* part; int rtf, nsl;
    __device__ __forceinline__ void operator()(const f32x4 (&acc)[2][2][4][2], const Unit& u, int ui, int wr, int wc, int fr, int fq) const {
        if (u.mode == 0) {
            const int row0 = u.pm * BM + wr * 64 + fr; const int col0 = u.pc * BM + wc * 32 + 8 * fq;
#pragma unroll
            for (int ai = 0; ai < 2; ++ai)
#pragma unroll
                for (int m = 0; m < 4; ++m) {
                    bf16_t* rowp = O + (size_t)(row0 + ai * HALF + m * 16) * ldc + col0;
#pragma unroll
                    for (int bj = 0; bj < 2; ++bj) {
                        const f32x4 v0 = acc[ai][bj][m][0], v1 = acc[ai][bj][m][1];
                        u32x4 w; w.x = cvt_pk_bf16(v0[0], v0[1]); w.y = cvt_pk_bf16(v0[2], v0[3]); w.z = cvt_pk_bf16(v1[0], v1[1]); w.w = cvt_pk_bf16(v1[2], v1[3]);
                        *(u32x4*)(rowp + bj * HALF) = w;
                    }
                }
        } else {
            float* pb = part + (size_t)(((u.pm - rtf) * 4 + u.pc) * nsl + (u.mode - 1)) * 65536 + (size_t)(wr * 64 + fr) * 256 + wc * 32 + 8 * fq;
#pragma unroll
            for (int ai = 0; ai < 2; ++ai)
#pragma unroll
                for (int m = 0; m < 4; ++m)
#pragma unroll
                    for (int bj = 0; bj < 2; ++bj) { float* p = pb + (size_t)(ai * HALF + m * 16) * 256 + bj * HALF; *(f32x4*)p = acc[ai][bj][m][0]; *(f32x4*)(p + 4) = acc[ai][bj][m][1]; }
        }
    }
};

typedef int v8i_t __attribute__((ext_vector_type(8)));
typedef int v4i_t __attribute__((ext_vector_type(4)));
__device__ __forceinline__ v8i_t cat32(bf16x8 lo, bf16x8 hi) { const v4i_t a = __builtin_bit_cast(v4i_t, lo), b = __builtin_bit_cast(v4i_t, hi); return __builtin_shufflevector(a, b, 0, 1, 2, 3, 4, 5, 6, 7); }
template <class Epi, class Sched, bool FP8 = false>
__device__ __forceinline__ void gemm_phase(PG8_LAS unsigned char* lds, const Gemm g, const Sched& S, const Epi& E) {
    const int tid = threadIdx.x, wid = __builtin_amdgcn_readfirstlane(tid >> 6), lane = tid & 63, wr = wid >> 2, wc = wid & 3, fr = lane & 15, fq = lane >> 4;
    const int sw_ = g.sw, sx_ = g.sx;
    const int K = g.ld ? g.ld : g.K, ntd = g.K / BK;
    unsigned voffA[2], voffB[2];
#pragma unroll
    for (int i = 0; i < 2; ++i) { int R, C; stage_rc(tid * 16 + i * 8192, R, C); const int Rb = Epi::PERM ? ((R & ~31) + perm32(R & 31)) : R;
        voffA[i] = (unsigned)(R * K + C) * 2u; voffB[i] = (unsigned)(Rb * K + C) * 2u; }
    const size_t kstep = (size_t)(BK * 2);
    const size_t hstep = (size_t)HALF * K * 2;
    const size_t tstep = 2 * hstep;
    const unsigned ldsw = (unsigned)wid * 1024u; const unsigned ldsb = (unsigned)(uintptr_t)lds;
    const int aoff = lds_byte(wr * 64 + fr, fq * 8), boff = lds_byte(wc * 32 + fr, fq * 8);
#define PG8_SA(b, h) (((b) * 2 + (h)) * HTB)
#define PG8_SB(b, h) ((4 + (b) * 2 + (h)) * HTB)
#define PG8_STAGE(bufoff, gbase, voff) do { _Pragma("unroll") for (int _i = 0; _i < 2; ++_i) { \
        if constexpr (FP8) glds16s((voff)[_i], (unsigned long long)(gbase), (unsigned)__builtin_amdgcn_readfirstlane((int)(ldsb + (bufoff) + ldsw + _i * 8192))); \
        else __builtin_amdgcn_global_load_lds((const unsigned*)((const char*)(gbase) + (voff)[_i]), (PG8_LAS unsigned*)(lds + (bufoff) + ldsw + _i * 8192), 16, 0, 0); } } while (0)
#define PG8_LDA(dst, b, h) do { if constexpr (FP8) { _Pragma("unroll") for (int m = 0; m < 4; ++m) dst##8[m] = __builtin_shufflevector(*(const PG8_LAS v4i_t*)(lds + PG8_SA(b, h) + aoff + m * 2048), *(const PG8_LAS v4i_t*)(lds + PG8_SA(b, h) + aoff + m * 2048 + 1024), 0, 1, 2, 3, 4, 5, 6, 7); } \
        else { _Pragma("unroll") for (int m = 0; m < 4; ++m) _Pragma("unroll") for (int k = 0; k < 2; ++k) dst[m][k] = *(const PG8_LAS bf16x8*)(lds + PG8_SA(b, h) + aoff + m * 2048 + k * 1024); } } while (0)
#define PG8_LDB(dst, b, h) do { if constexpr (FP8) { _Pragma("unroll") for (int n = 0; n < 2; ++n) dst##8[n] = __builtin_shufflevector(*(const PG8_LAS v4i_t*)(lds + PG8_SB(b, h) + boff + n * 2048), *(const PG8_LAS v4i_t*)(lds + PG8_SB(b, h) + boff + n * 2048 + 1024), 0, 1, 2, 3, 4, 5, 6, 7); } \
        else { _Pragma("unroll") for (int n = 0; n < 2; ++n) _Pragma("unroll") for (int k = 0; k < 2; ++k) dst[n][k] = *(const PG8_LAS bf16x8*)(lds + PG8_SB(b, h) + boff + n * 2048 + k * 1024); } } while (0)
#define PG8_MMA(ai, bj, At, Bt) do { __builtin_amdgcn_s_setprio(1); \
        if constexpr (FP8) { _Pragma("unroll") for (int m = 0; m < 4; ++m) _Pragma("unroll") for (int n = 0; n < 2; ++n) \
            asm volatile("v_mfma_scale_f32_16x16x128_f8f6f4 %0, %1, %2, %0, %3, %4 op_sel_hi:[0,0,0]" : "+v"(acc[ai][bj][m][n]) : "v"(Bt##8[n]), "v"(At##8[m]), "v"(sw_), "v"(sx_)); } \
        else { _Pragma("unroll") for (int m = 0; m < 4; ++m) _Pragma("unroll") for (int n = 0; n < 2; ++n) _Pragma("unroll") for (int k = 0; k < 2; ++k) acc[ai][bj][m][n] = __builtin_amdgcn_mfma_f32_16x16x32_bf16(Bt[n][k], At[m][k], acc[ai][bj][m][n], 0, 0, 0); } \
        __builtin_amdgcn_s_setprio(0); } while (0)
#define PG8_WAIT_V(n) asm volatile("s_waitcnt vmcnt(" #n ")" ::: "memory")
#define PG8_WAIT_L(n) asm volatile("s_waitcnt lgkmcnt(" #n ")" ::: "memory")
#define PG8_BAR __builtin_amdgcn_s_barrier()
#define PG8_SCHED __builtin_amdgcn_sched_barrier(0)
    Unit cur, nxt; int ui = 0;
    if (!S.next(0, cur)) return;
    f32x4 acc[2][2][4][2];
#pragma unroll
    for (int a = 0; a < 2; ++a)
#pragma unroll
        for (int b = 0; b < 2; ++b)
#pragma unroll
            for (int m = 0; m < 4; ++m)
#pragma unroll
                for (int n = 0; n < 2; ++n) acc[a][b][m][n] = (f32x4){0.f, 0.f, 0.f, 0.f};
    bf16x8 At[4][2], B0[2][2], B1[2][2]; v8i_t At8[4], B08[2], B18[2];
    const char* cA = (const char*)g.A + (size_t)cur.pm * tstep + cur.koff; const char* cB = (const char*)g.Bt + (size_t)cur.pn * tstep + cur.koff;
    PG8_STAGE(PG8_SB(0, 0), cB, voffB); PG8_STAGE(PG8_SB(0, 1), cB + hstep, voffB); PG8_STAGE(PG8_SA(0, 0), cA, voffA); PG8_STAGE(PG8_SA(0, 1), cA + hstep, voffA);
    if (wr == 1) PG8_BAR;
    PG8_WAIT_V(2); PG8_BAR;
    PG8_STAGE(PG8_SB(1, 0), cB + kstep, voffB); PG8_STAGE(PG8_SA(1, 0), cA + kstep, voffA); PG8_STAGE(PG8_SB(1, 1), cB + hstep + kstep, voffB);
    PG8_WAIT_V(6); PG8_BAR;
    for (;;) {
        const bool has_next = S.next(ui + 1, nxt);
        const char* nA = has_next ? (const char*)g.A + (size_t)nxt.pm * tstep + nxt.koff : cA; const char* nB = has_next ? (const char*)g.Bt + (size_t)nxt.pn * tstep + nxt.koff : cB;
        const int nt = cur.nt ? cur.nt : ntd;
#pragma nounroll
        for (int t = 0; t < nt; t += 2) {
            const bool last = (t == nt - 2);
            const char* a1 = cA + (size_t)(t + 1) * kstep;
            const char* a2 = last ? nA : cA + (size_t)(t + 2) * kstep; const char* b2 = last ? nB : cB + (size_t)(t + 2) * kstep;
            const char* a3 = a2 + kstep; const char* b3 = b2 + kstep;
            PG8_LDB(B0, 0, 0); PG8_LDB(B1, 0, 1); PG8_SCHED; PG8_LDA(At, 0, 0); PG8_STAGE(PG8_SA(1, 1), a1 + hstep, voffA);
            PG8_WAIT_V(8); PG8_WAIT_L(0); PG8_BAR; PG8_MMA(0, 0, At, B0); PG8_MMA(0, 1, At, B1); PG8_BAR; PG8_SCHED;
            PG8_LDA(At, 0, 1); PG8_STAGE(PG8_SB(0, 0), b2, voffB); PG8_STAGE(PG8_SB(0, 1), b2 + hstep, voffB); PG8_STAGE(PG8_SA(0, 0), a2, voffA);
            PG8_WAIT_V(8); PG8_WAIT_L(0); PG8_BAR; PG8_MMA(1, 0, At, B0); PG8_MMA(1, 1, At, B1); PG8_BAR; PG8_SCHED;
            PG8_LDB(B0, 1, 0); PG8_LDB(B1, 1, 1); PG8_SCHED; PG8_LDA(At, 1, 0); PG8_STAGE(PG8_SA(0, 1), a2 + hstep, voffA);
            PG8_WAIT_V(8); PG8_WAIT_L(0); PG8_BAR; PG8_MMA(0, 0, At, B0); PG8_MMA(0, 1, At, B1); PG8_BAR; PG8_SCHED;
            PG8_LDA(At, 1, 1); PG8_STAGE(PG8_SB(1, 0), b3, voffB); PG8_STAGE(PG8_SB(1, 1), b3 + hstep, voffB); PG8_STAGE(PG8_SA(1, 0), a3, voffA);
            PG8_WAIT_V(8); PG8_WAIT_L(0); PG8_BAR; PG8_MMA(1, 0, At, B0); PG8_MMA(1, 1, At, B1); PG8_BAR; PG8_SCHED;
        }
        if (wr == 0) PG8_BAR;
        if constexpr (FP8) asm volatile("s_nop 15\n\ts_nop 15" ::: "memory");
        { int le_ = lane; asm volatile("" : "+v"(le_)); E(acc, cur, ui, wr, wc, le_ & 15, le_ >> 4); }
        if (!has_next) break;
#pragma unroll
        for (int a = 0; a < 2; ++a)
#pragma unroll
            for (int b = 0; b < 2; ++b)
#pragma unroll
                for (int m = 0; m < 4; ++m)
#pragma unroll
                    for (int n = 0; n < 2; ++n) acc[a][b][m][n] = (f32x4){0.f, 0.f, 0.f, 0.f};
        cur = nxt; cA = nA; cB = nB; ++ui;
        if (wr == 1) PG8_BAR;
    }
    PG8_WAIT_V(0);
    PG8_BAR;
#undef PG8_SA
#undef PG8_SB
#undef PG8_STAGE
#undef PG8_LDA
#undef PG8_LDB
#undef PG8_MMA
#undef PG8_WAIT_V
#undef PG8_WAIT_L
#undef PG8_BAR
#undef PG8_SCHED
}
}

#define XB_TMO      128
#define XB_XCNT(j)  (256  + 64 * (j))
#define XB_XSUB(j)  (1280 + 64 * (j))
#define XB_XGEN(j)  (2304 + 64 * (j))
#define XB_TOP      3328
#define XB_TOPGEN   3392
#define XCD_BAR_WORDS 3456
#define XB_SPIN_CAP (1u << 24)

__device__ __forceinline__ unsigned xb_ld(unsigned* p)              { return __hip_atomic_load(p, __ATOMIC_RELAXED, __HIP_MEMORY_SCOPE_AGENT); }
__device__ __forceinline__ unsigned xb_add(unsigned* p, unsigned v) { return __hip_atomic_fetch_add(p, v, __ATOMIC_RELAXED, __HIP_MEMORY_SCOPE_AGENT); }
__device__ __forceinline__ unsigned xb_xcc_id() { return (unsigned)__builtin_amdgcn_s_getreg((3 << 11) | 20) & 0xFu; }
#define XB_SPIN(cond, bar) do { unsigned _sp = 0; while (cond) { __builtin_amdgcn_s_sleep(1); \
    if ((++_sp & 255u) == 0u) { if (xb_ld(&(bar)[XB_TMO])) break; if (_sp > XB_SPIN_CAP) { atomicAdd(&(bar)[XB_TMO], 1u); break; } } } } while (0)

struct XcdBarrier { unsigned* bar; unsigned x; volatile LAS unsigned* st; };

__device__ __forceinline__ XcdBarrier xcd_barrier_post(unsigned* bar, volatile LAS unsigned* st) {
    XcdBarrier b; b.bar = bar; b.x = xb_xcc_id(); b.st = st;
    if (threadIdx.x == 0) (void)xb_add(&bar[XB_XCNT(b.x)], 1u);
    return b;
}
__device__ __forceinline__ void xcd_barrier_complete(unsigned* bar, unsigned x, unsigned& nloc, unsigned& nx) {
    const unsigned G = gridDim.x * gridDim.y * gridDim.z;
    unsigned sum, cnt, mine, sp = 0u;
    for (;;) {
        sum = 0u; cnt = 0u; mine = 0u;
#pragma unroll
        for (unsigned j = 0; j < 16; ++j) { const unsigned c = xb_ld(&bar[XB_XCNT(j)]); sum += c; cnt += (c > 0u) ? 1u : 0u; mine = (j == x) ? c : mine; }
        if (sum == G) break;
        __builtin_amdgcn_s_sleep(1);
        if ((++sp & 255u) == 0u) { if (xb_ld(&bar[XB_TMO])) break; if (sp > XB_SPIN_CAP) { atomicAdd(&bar[XB_TMO], 1u); break; } }
    }
    nloc = mine > 0u ? mine : 1u; nx = cnt > 0u ? cnt : 1u;
}
__device__ __forceinline__ void xcd_barrier(const XcdBarrier& b) {
    asm volatile("s_waitcnt vmcnt(0)" ::: "memory");
    __syncthreads();
    if (threadIdx.x == 0) {
        unsigned* bar = b.bar;
        __builtin_amdgcn_s_waitcnt(0);
        unsigned nloc = b.st[0], nx = b.st[1];
        if (nloc == 0u) { xcd_barrier_complete(bar, b.x, nloc, nx); b.st[0] = nloc; b.st[1] = nx; }
        const unsigned old = xb_add(&bar[XB_XSUB(b.x)], 1u);
        const unsigned gen = old / nloc;
        if (old + 1u == (gen + 1u) * nloc) {
            __builtin_amdgcn_fence(__ATOMIC_RELEASE, "agent");
            asm volatile("s_waitcnt vmcnt(0)" ::: "memory");
            const unsigned og = xb_add(&bar[XB_TOP], 1u);
            const unsigned tg = og / nx;
            if (og + 1u == (tg + 1u) * nx) xb_add(&bar[XB_TOPGEN], 1u);
            else XB_SPIN(xb_ld(&bar[XB_TOPGEN]) == tg, bar);
            __builtin_amdgcn_fence(__ATOMIC_ACQUIRE, "agent");
            xb_add(&bar[XB_XGEN(b.x)], 1u);
            asm volatile("s_waitcnt vmcnt(0)" ::: "memory");
        } else {
            XB_SPIN(xb_ld(&bar[XB_XGEN(b.x)]) == gen, bar);
            __builtin_amdgcn_fence(__ATOMIC_ACQUIRE, "agent");
            asm volatile("s_waitcnt vmcnt(0)" ::: "memory");
        }
    }
    __syncthreads();
}

struct Ctx {
    LAS unsigned char* lds;
    unsigned char* ws;
    const void* const* in;
    float* out;
    int tid, lane, wave, G, bid;
};
#define IN_F(i) ((const float*)C.in[i])
#define WSP(T, off) ((T*)(C.ws + (off)))

struct WJob { const float* W0; const float* W1; bf16_t* WT; const float* gain; int K, ldw, Nout, kind, nE, fp8; size_t sW, sWT; };
__device__ __forceinline__ int permsrc(int j) { return j < 16 ? ((j >> 1) + 8 * (j & 1)) : j; }
__device__ __forceinline__ void map_col(int kind, int np, int& src, int& which, float& scale) {
    which = 0; scale = 1.f; src = np;
    if (kind == 1) { const int blk = (np >> 10) % 3; const int hd = np & 63; if (blk < 2) src = np - hd + permsrc(hd); if (blk == 0) scale = C2; }
    else if (kind == 3) { const int hd = np & 63; if (np < 1152) src = np - hd + permsrc(hd); if (np < 1024) scale = C2; }
    else if (kind == 4) { const int tile = np >> 8, w = np & 255; src = tile * 128 + (w & 127); which = w >> 7; }
}
struct TItem { const float* src; float scale; int e, k0, n0; };
__device__ __forceinline__ TItem titem(const WJob& J, int item, int lane) {
    TItem T; const int nblk = J.Nout / 32, per = (J.K / 64) * nblk;
    T.e = item / per; const int r = item % per, kb = r / nblk, nb = r % nblk; T.k0 = 64 * kb; T.n0 = 32 * nb;
    int src, which; map_col(J.kind, T.n0 + (lane & 31), src, which, T.scale);
    const unsigned long long a0_ = (unsigned long long)J.W0, a1_ = (unsigned long long)(J.W1 ? J.W1 : J.W0);
    T.src = (const float*)(a0_ + (a1_ - a0_) * (unsigned long long)which) + (size_t)T.e * J.sW + (size_t)(T.k0 + (lane >> 5)) * J.ldw + src;
    return T;
}
__device__ __forceinline__ void tload(const WJob& J, const TItem& T, float (&v)[32]) {
#pragma unroll
    for (int i = 0; i < 32; ++i) v[i] = __builtin_nontemporal_load(T.src + (size_t)(2 * i) * J.ldw);
}
__device__ __forceinline__ void tstore(const WJob& J, const TItem& T, const float (&v)[32], LAS float* scr, int lane) {
#pragma unroll
    for (int i = 0; i < 32; ++i) scr[(2 * i + (lane >> 5)) * 33 + (lane & 31)] = v[i] * T.scale;
    LDS_WAIT(); asm volatile("" ::: "memory");
    const int c = lane & 7;
    f32x4 g0 = (f32x4){1.f, 1.f, 1.f, 1.f}, g1 = g0;
    if (J.gain) { g0 = *(const f32x4*)(J.gain + T.k0 + 8 * c); g1 = *(const f32x4*)(J.gain + T.k0 + 8 * c + 4); }
    if (J.fp8) {
        unsigned char* WT8 = (unsigned char*)J.WT + (size_t)T.e * J.sWT;
        g0 = g0 * W8_SCALE; g1 = g1 * W8_SCALE;
#pragma unroll
        for (int j = 0; j < 4; ++j) { const int n = (lane >> 3) + 8 * j; const LAS float* s = scr + (8 * c) * 33 + n;
            u32x2 o; o.x = pk_fp8x4(s[0 * 33] * g0[0], s[1 * 33] * g0[1], s[2 * 33] * g0[2], s[3 * 33] * g0[3]); o.y = pk_fp8x4(s[4 * 33] * g1[0], s[5 * 33] * g1[1], s[6 * 33] * g1[2], s[7 * 33] * g1[3]);
            *(u32x2*)(WT8 + (size_t)(T.n0 + n) * J.K + T.k0 + 8 * c) = o; }
    } else {
    bf16_t* WT = J.WT + (size_t)T.e * J.sWT;
#pragma unroll
    for (int j = 0; j < 4; ++j) { const int n = (lane >> 3) + 8 * j; const LAS float* s = scr + (8 * c) * 33 + n;
        u32x4 o; o.x = pk2(s[0 * 33] * g0[0], s[1 * 33] * g0[1]); o.y = pk2(s[2 * 33] * g0[2], s[3 * 33] * g0[3]); o.z = pk2(s[4 * 33] * g1[0], s[5 * 33] * g1[1]); o.w = pk2(s[6 * 33] * g1[2], s[7 * 33] * g1[3]);
        *(u32x4*)(WT + (size_t)(T.n0 + n) * J.K + T.k0 + 8 * c) = o; }
    }
    LDS_WAIT(); asm volatile("" ::: "memory");
}
__device__ __forceinline__ WJob make_job(const Ctx& C, int j) {
    WJob J; J.W1 = nullptr; J.gain = nullptr; J.nE = 1; J.sW = 0; J.sWT = 0; J.kind = 0; J.fp8 = (j == 0 || j == 12 || j == 6 || j == 7 || j >= 14 || j == 1 || j == 9 || j == 13 || j == 10 || j == 8) ? 1 : 0;
    switch (j) {
    case 0:  J.W0 = IN_F(3);  J.WT = WSP(bf16_t, WS_WQKV0); J.gain = IN_F(2);  J.K = 1024; J.ldw = 9216; J.Nout = 9216; J.kind = 1; break;
    case 1:  J.W0 = IN_F(4);  J.WT = WSP(bf16_t, WS_WO0);   J.K = 1024; J.ldw = 1024; J.Nout = 1024; break;
    case 2:  J.W0 = IN_F(6);  J.W1 = IN_F(7); J.WT = WSP(bf16_t, WS_W13_0); J.gain = IN_F(5); J.K = 1024; J.ldw = FF; J.Nout = 2 * FF; J.kind = 4; break;
    case 3:  J.W0 = IN_F(8);  J.WT = WSP(bf16_t, WS_W2_0);  J.K = FF; J.ldw = 1024; J.Nout = 1024; break;
    case 4:  J.W0 = IN_F(10); J.WT = WSP(bf16_t, WS_WQKV1); J.gain = IN_F(9);  J.K = 1024; J.ldw = 3072; J.Nout = 3072; J.kind = 1; break;
    case 5:  J.W0 = IN_F(16); J.WT = WSP(bf16_t, WS_WO1);   J.K = 1024; J.ldw = 1024; J.Nout = 1024; break;
    case 6:  J.W0 = IN_F(19); J.W1 = IN_F(20); J.WT = WSP(bf16_t, WS_WM13); J.gain = IN_F(17); J.K = 1024; J.ldw = FFE; J.Nout = 2 * FFE; J.kind = 4; J.nE = 8; J.sW = (size_t)1024 * FFE; J.sWT = (size_t)2 * FFE * 1024; break;
    case 7:  J.W0 = IN_F(21); J.WT = WSP(bf16_t, WS_WM2);   J.K = FFE; J.ldw = 1024; J.Nout = 1024; J.nE = 8; J.sW = (size_t)FFE * 1024; J.sWT = (size_t)1024 * FFE; break;
    case 8:  J.W0 = IN_F(23); J.WT = WSP(bf16_t, WS_WQKV2); J.gain = IN_F(22); J.K = 1024; J.ldw = 1280; J.Nout = 1280; J.kind = 3; break;
    case 9:  J.W0 = IN_F(25); J.WT = WSP(bf16_t, WS_WO2);   J.K = 1024; J.ldw = 1024; J.Nout = 1024; break;
    case 10: J.W0 = IN_F(27); J.W1 = IN_F(28); J.WT = WSP(bf16_t, WS_W13_2); J.gain = IN_F(26); J.K = 1024; J.ldw = FF; J.Nout = 2 * FF; J.kind = 4; break;
    case 11: J.W0 = IN_F(29); J.WT = WSP(bf16_t, WS_W2_2);  J.K = FF; J.ldw = 1024; J.Nout = 1024; break;
    case 12: J.W0 = IN_F(31); J.WT = WSP(bf16_t, WS_WQKV3); J.gain = IN_F(30); J.K = 1024; J.ldw = 9216; J.Nout = 9216; J.kind = 1; break;
    case 13: J.W0 = IN_F(32); J.WT = WSP(bf16_t, WS_WO3);   J.K = 1024; J.ldw = 1024; J.Nout = 1024; break;
    case 14: J.W0 = IN_F(35); J.W1 = IN_F(36); J.WT = WSP(bf16_t, WS_WM13); J.gain = IN_F(33); J.K = 1024; J.ldw = FFE; J.Nout = 2 * FFE; J.kind = 4; J.nE = 8; J.sW = (size_t)1024 * FFE; J.sWT = (size_t)2 * FFE * 1024; break;
    default: J.W0 = IN_F(37); J.WT = WSP(bf16_t, WS_WM2);   J.K = FFE; J.ldw = 1024; J.Nout = 1024; J.nE = 8; J.sW = (size_t)FFE * 1024; J.sWT = (size_t)1024 * FFE; break;
    }
    return J;
}
template <int j>
__device__ __forceinline__ void convert_one(const Ctx& C) {
    LAS float* scr = (LAS float*)(C.lds + C.wave * 16384);
    const int gw = C.bid * 8 + C.wave, NGW = C.G * 8;
    const WJob J = make_job(C, j);
    const int nitems = J.nE * (J.K / 64) * (J.Nout / 32);
    if (gw >= nitems) return;
    TItem T = titem(J, gw, C.lane); float v[32]; tload(J, T, v);
    for (int it = gw; it < nitems; it += NGW) {
        const int nx = it + NGW; TItem Tn = T; float w[32];
        if (nx < nitems) { Tn = titem(J, nx, C.lane); tload(J, Tn, w); }
        tstore(J, T, v, scr, C.lane);
        if (nx < nitems) { T = Tn;
#pragma unroll
            for (int i = 0; i < 32; ++i) v[i] = w[i]; }
    }
}
__device__ __forceinline__ void convert_weights_first(const Ctx& C) {
    convert_one<0>(C); convert_one<1>(C); convert_one<2>(C); convert_one<3>(C); convert_one<4>(C); convert_one<5>(C); convert_one<6>(C);
    convert_one<7>(C); convert_one<8>(C); convert_one<9>(C); convert_one<10>(C); convert_one<11>(C); convert_one<12>(C); convert_one<13>(C);
}
__device__ __forceinline__ void convert_weights_second(const Ctx& C) { convert_one<14>(C); convert_one<15>(C); }
__device__ __forceinline__ void rope_table(const Ctx& C) {
    const int* pos = (const int*)C.in[1];
    float* tab = WSP(float, WS_ROPE);
    for (int i = C.bid * 512 + C.tid; i < NTOK * 8; i += C.G * 512) {
        const int tok = i >> 3, f = i & 7;
        const float inv = powf(500000.0f, -(float)f * 0.125f);
        const float ang = (float)pos[tok] * inv;
        const double a = (double)ang;
        const double k = rint(a * 0.15915494309189535);
        const float r = (float)(a - k * 6.283185307179586);
        tab[(size_t)tok * 16 + f] = cosf(r); tab[(size_t)tok * 16 + 8 + f] = sinf(r);
    }
}
__device__ __forceinline__ void write_ssq_row(float* ssq, int row, float tot, int lane) { if (lane < 16) ssq[(size_t)row * 16 + lane] = (lane == 0) ? tot : 0.f; }
__device__ __forceinline__ void x_to_bf16(const Ctx& C) {
    const float* x = IN_F(0); bf16_t* xb = WSP(bf16_t, WS_XB); float* ssq = WSP(float, WS_SSQ); unsigned char* x8 = WSP(unsigned char, WS_X8);
    const int gw = C.bid * 8 + C.wave, NGW = C.G * 8;
    for (int m = gw; m < NTOK; m += NGW) {
        const f32x4* xr = (const f32x4*)(x + (size_t)m * DM) + C.lane; u32x2* o = (u32x2*)(xb + (size_t)m * DM) + C.lane; unsigned* o8 = (unsigned*)(x8 + (size_t)m * DM) + C.lane;
        float s = 0.f;
#pragma unroll
        for (int j = 0; j < 4; ++j) { const f32x4 v = xr[64 * j]; s += (v[0] * v[0] + v[1] * v[1]) + (v[2] * v[2] + v[3] * v[3]); u32x2 w; w.x = pk2(v[0], v[1]); w.y = pk2(v[2], v[3]); o[64 * j] = w; o8[64 * j] = pk_fp8x4(v[0], v[1], v[2], v[3]); }
        write_ssq_row(ssq, m, wave_sum(s), C.lane);
    }
}

__device__ __forceinline__ void load_q64(const bf16_t* qp, float (&q)[64]) {
#pragma unroll
    for (int c = 0; c < 8; ++c) { const u32x4 w = *(const u32x4*)(qp + 8 * c);
        q[8 * c + 0] = bflo(w.x); q[8 * c + 1] = bfhi(w.x); q[8 * c + 2] = bflo(w.y); q[8 * c + 3] = bfhi(w.y); q[8 * c + 4] = bflo(w.z); q[8 * c + 5] = bfhi(w.z); q[8 * c + 6] = bflo(w.w); q[8 * c + 7] = bfhi(w.w); }
}
__device__ __forceinline__ float dot64(const float (&q)[64], const bf16_t* kp) {
    float s = 0.f;
#pragma unroll
    for (int c = 0; c < 8; ++c) { const u32x4 w = *(const u32x4*)(kp + 8 * c);
        s += q[8 * c + 0] * bflo(w.x); s += q[8 * c + 1] * bfhi(w.x); s += q[8 * c + 2] * bflo(w.y); s += q[8 * c + 3] * bfhi(w.y);
        s += q[8 * c + 4] * bflo(w.z); s += q[8 * c + 5] * bfhi(w.z); s += q[8 * c + 6] * bflo(w.w); s += q[8 * c + 7] * bfhi(w.w); }
    return s;
}
__device__ __forceinline__ void naive_band(const bf16_t* qp, const bf16_t* K, const bf16_t* V, size_t kstride, int jlo, int jhi, float m0, float l0, int lane, float& o_out, float& m_out, float& l_out) {
    float q[64]; load_q64(qp, q);
    float m = m0, l = l0, o = 0.f;
    for (int j0 = jlo; j0 <= jhi; j0 += 64) {
        const int j = j0 + lane; const bool valid = j <= jhi; const int jj = valid ? j : jhi;
        float s = dot64(q, K + (size_t)jj * kstride); if (!valid) s = -INFINITY;
        const float mn = fmaxf(m, wave_max(s)); const float alpha = exp2f(m - mn); const float p = exp2f(s - mn);
        l = l * alpha + wave_sum(p); o *= alpha; m = mn;
        const int cnt = (jhi - j0 + 1) < 64 ? (jhi - j0 + 1) : 64;
        for (int t = 0; t < cnt; ++t) { const float pj = __shfl(p, t); o += pj * bf2f(V[(size_t)(j0 + t) * kstride + lane]); }
    }
    o_out = o; m_out = m; l_out = l;
}
__device__ __forceinline__ void naive_attn_A(const Ctx& C) {
    const bf16_t* QKV = WSP(bf16_t, WS_BIG + BIG_QKV); bf16_t* OG = WSP(bf16_t, WS_BIG + BIG_OG); float* LSE = WSP(float, WS_LSE);
    const int gw = C.bid * 8 + C.wave, NGW = C.G * 8;
    for (int it = gw; it < NTOK * 16 * 3; it += NGW) {
        const int gi = it % 3, h = (it / 3) % 16, tok = it / 48;
        const int dil = gi == 0 ? 1 : (gi == 1 ? 4 : 16);
        const int b = tok / SEQ, s = tok % SEQ, r = s % dil, i = s / dil, L = SEQ / dil;
        const int jlo = i - 64 < 0 ? 0 : i - 64, jhi = i + 64 > L - 1 ? L - 1 : i + 64;
        const bf16_t* base = QKV + (size_t)(b * SEQ + r) * NQKV_A + gi * 3072 + h * 64;
        float o, m, l;
        naive_band(QKV + (size_t)tok * NQKV_A + gi * 3072 + h * 64, base + 1024, base + 2048, (size_t)dil * NQKV_A, jlo, jhi, -1e30f, 0.f, C.lane, o, m, l);
        OG[((size_t)gi * NTOK + tok) * DM + h * 64 + C.lane] = (bf16_t)f2bf(o / l);
        if (C.lane == 0) LSE[((size_t)gi * NTOK + tok) * 16 + h] = m + log2f(l);
    }
}
__device__ __forceinline__ void naive_attn_C(const Ctx& C) {
    const bf16_t* QKV = WSP(bf16_t, WS_BIG + BIG_QKV); bf16_t* O = WSP(bf16_t, WS_O); const float* sink = IN_F(24);
    const int gw = C.bid * 8 + C.wave, NGW = C.G * 8;
    for (int it = gw; it < NTOK * 16; it += NGW) {
        const int h = it % 16, tok = it / 16, g = h / 8;
        const int b = tok / SEQ, s = tok % SEQ;
        const int jlo = s - 128 < 0 ? 0 : s - 128, jhi = s + 128 > SEQ - 1 ? SEQ - 1 : s + 128;
        const bf16_t* base = QKV + (size_t)(b * SEQ) * NQKV_C;
        float o, m, l;
        naive_band(QKV + (size_t)tok * NQKV_C + h * 64, base + 1024 + g * 64, base + 1152 + g * 64, (size_t)NQKV_C, jlo, jhi, sink[h] * LOG2E, 1.f, C.lane, o, m, l);
        O[(size_t)tok * DM + h * 64 + C.lane] = (bf16_t)f2bf(o / l);
    }
}
__device__ __forceinline__ float diff_lambda(const Ctx& C) {
    const float a = IN_F(11)[C.lane] * IN_F(12)[C.lane], b = IN_F(13)[C.lane] * IN_F(14)[C.lane];
    return expf(wave_sum(a)) - expf(wave_sum(b)) + LAMBDA_INIT;
}
__device__ __forceinline__ void naive_attn_B(const Ctx& C) {
    const bf16_t* QKV = WSP(bf16_t, WS_BIG + BIG_QKV); bf16_t* O = WSP(bf16_t, WS_O); const float* subln = IN_F(15);
    const float lam = diff_lambda(C);
    const int gw = C.bid * 8 + C.wave, NGW = C.G * 8, lane = C.lane;
    for (int it = gw; it < NTOK * 8; it += NGW) {
        const int h = it % 8, tok = it / 8, b = tok / SEQ;
        float q0[64], q1[64]; load_q64(QKV + (size_t)tok * NQKV_B + (2 * h) * 64, q0); load_q64(QKV + (size_t)tok * NQKV_B + (2 * h + 1) * 64, q1);
        const bf16_t* Kb = QKV + (size_t)(b * SEQ) * NQKV_B + 1024 + (2 * h) * 64; const bf16_t* Vb = QKV + (size_t)(b * SEQ) * NQKV_B + 2048 + h * 128;
        float m0 = -1e30f, l0 = 0.f, m1 = -1e30f, l1 = 0.f, oa0 = 0.f, ob0 = 0.f, oa1 = 0.f, ob1 = 0.f;
        for (int j0 = 0; j0 < SEQ; j0 += 64) {
            const bf16_t* kr = Kb + (size_t)(j0 + lane) * NQKV_B;
            const float s0 = dot64(q0, kr), s1 = dot64(q1, kr + 64);
            const float mn0 = fmaxf(m0, wave_max(s0)), mn1 = fmaxf(m1, wave_max(s1));
            const float a0 = exp2f(m0 - mn0), a1 = exp2f(m1 - mn1), p0 = exp2f(s0 - mn0), p1 = exp2f(s1 - mn1);
            l0 = l0 * a0 + wave_sum(p0); l1 = l1 * a1 + wave_sum(p1); oa0 *= a0; ob0 *= a0; oa1 *= a1; ob1 *= a1; m0 = mn0; m1 = mn1;
#pragma unroll 8
            for (int t = 0; t < 64; ++t) {
                const bf16_t* vr = Vb + (size_t)(j0 + t) * NQKV_B;
                const float va = bf2f(vr[lane]), vb = bf2f(vr[lane + 64]);
                const float pa = __shfl(p0, t), pb = __shfl(p1, t);
                oa0 += pa * va; ob0 += pa * vb; oa1 += pb * va; ob1 += pb * vb;
            }
        }
        const float f0 = 1.0f / l0, f1 = lam / l1;
        const float ya = oa0 * f0 - oa1 * f1, yb = ob0 * f0 - ob1 * f1;
        const float ms = wave_sum(ya * ya + yb * yb) * (1.0f / 128.0f);
        const float rs = (1.0f / sqrtf(ms + SUBLN_EPS)) * (1.0f - LAMBDA_INIT);
        O[(size_t)tok * DM + h * 128 + lane] = (bf16_t)f2bf(ya * rs * subln[lane]);
        O[(size_t)tok * DM + h * 128 + 64 + lane] = (bf16_t)f2bf(yb * rs * subln[lane + 64]);
    }
}

namespace att {
typedef float f32x16 __attribute__((ext_vector_type(16)));
typedef short s16x4 __attribute__((ext_vector_type(4)));
typedef short v4i16_t __attribute__((ext_vector_type(4)));
typedef __bf16 bf16x2_t __attribute__((ext_vector_type(2)));
#define ADI __device__ __forceinline__
#define MFMA32(a, b, c) __builtin_amdgcn_mfma_f32_32x32x16_bf16((a), (b), (c), 0, 0, 0)
ADI int crow(int i, int hh) { return (i & 3) + 8 * (i >> 2) + 4 * hh; }
ADI float hmax(float v) { auto rr = __builtin_amdgcn_permlane32_swap(__float_as_uint(v), __float_as_uint(v), false, false); return fmaxf(__uint_as_float(rr[0]), __uint_as_float(rr[1])); }
ADI float hsum(float v) { auto rr = __builtin_amdgcn_permlane32_swap(__float_as_uint(v), __float_as_uint(v), false, false); return __uint_as_float(rr[0]) + __uint_as_float(rr[1]); }
ADI unsigned cvtpk(float lo, float hi) { f32x2 v = {lo, hi}; bf16x2_t b = __builtin_convertvector(v, bf16x2_t); return __builtin_bit_cast(unsigned, b); }
template <int S> ADI bf16x8 pack8(const f32x16& x) { u32x4 p; p[0] = cvtpk(x[8 * S], x[8 * S + 1]); p[1] = cvtpk(x[8 * S + 2], x[8 * S + 3]); p[2] = cvtpk(x[8 * S + 4], x[8 * S + 5]); p[3] = cvtpk(x[8 * S + 6], x[8 * S + 7]); return __builtin_bit_cast(bf16x8, p); }
ADI s16x4 vtr(const LAS unsigned char* p) { return __builtin_bit_cast(s16x4, __builtin_amdgcn_ds_read_tr16_b64_v4i16((LAS v4i16_t*)p)); }
ADI bf16x8 cat8(s16x4 lo, s16x4 hi) { return (bf16x8){lo[0], lo[1], lo[2], lo[3], hi[0], hi[1], hi[2], hi[3]}; }
ADI float fexp2(float x) { return __builtin_amdgcn_exp2f(x); }
ADI float max3f(float a, float b, float c) { return __builtin_fmaxf(__builtin_fmaxf(a, b), c); }

ADI void qk_tile(f32x16& s0, f32x16& s1, const LAS unsigned char* kt, const bf16x8 (&q)[4], int kro, int kx6) {
    s0 = f32x16{}; s1 = f32x16{};
#pragma unroll
    for (int d0 = 0; d0 < 4; ++d0) {
        const int ko = kro + (kx6 ^ (d0 << 5));
        const bf16x8 a0 = *(const LAS bf16x8*)(kt + ko); const bf16x8 a1 = *(const LAS bf16x8*)(kt + 4096 + ko);
        s0 = MFMA32(a0, q[d0], s0); s1 = MFMA32(a1, q[d0], s1);
    }
}
ADI void qk_tile_init(f32x16& s0, f32x16& s1, const f32x16& init, const LAS unsigned char* kt, const bf16x8 (&q)[4], int kro, int kx6) {
    s0 = init; s1 = init;
#pragma unroll
    for (int d0 = 0; d0 < 4; ++d0) {
        const int ko = kro + (kx6 ^ (d0 << 5));
        const bf16x8 a0 = *(const LAS bf16x8*)(kt + ko); const bf16x8 a1 = *(const LAS bf16x8*)(kt + 4096 + ko);
        s0 = MFMA32(a0, q[d0], s0); s1 = MFMA32(a1, q[d0], s1);
    }
}
ADI void qk_tile_lq(f32x16& s0, f32x16& s1, const LAS unsigned char* kt, const LAS unsigned char* qf, int kro, int kx6) {
    s0 = f32x16{}; s1 = f32x16{};
#pragma unroll
    for (int d0 = 0; d0 < 4; ++d0) {
        const int ko = kro + (kx6 ^ (d0 << 5));
        const bf16x8 a0 = *(const LAS bf16x8*)(kt + ko); const bf16x8 a1 = *(const LAS bf16x8*)(kt + 4096 + ko);
        const bf16x8 qd = *(const LAS bf16x8*)(qf + d0 * 1024);
        s0 = MFMA32(a0, qd, s0); s1 = MFMA32(a1, qd, s1);
    }
}
template <int NB>
ADI void softmax_tile(f32x16& s0, f32x16& s1, float& m, float& l, f32x16 (&O)[NB], LAS float* scr, int r, int hh) {
    float mxa = max3f(s0[0], s0[1], s1[0]), mxb = max3f(s0[2], s0[3], s1[1]); mxa = max3f(mxa, s1[2], s1[3]);
#pragma unroll
    for (int i = 4; i < 16; i += 4) { mxa = max3f(mxa, s0[i], s0[i + 1]); mxb = max3f(mxb, s0[i + 2], s0[i + 3]); mxa = max3f(mxa, s1[i], s1[i + 1]); mxb = max3f(mxb, s1[i + 2], s1[i + 3]); }
    float mx = hmax(max3f(mxa, mxb, mxb));
    if (__any(mx > m + 8.0f)) {
        const float mn = fmaxf(m, mx), al = fexp2(m - mn); l *= al; m = mn;
        if (hh == 0) scr[r] = al;
#pragma unroll
        for (int g = 0; g < 4; ++g) { const f32x4 a4 = *(const LAS f32x4*)(scr + 8 * g + 4 * hh);
#pragma unroll
            for (int c = 0; c < NB; ++c) { O[c][4 * g] *= a4[0]; O[c][4 * g + 1] *= a4[1]; O[c][4 * g + 2] *= a4[2]; O[c][4 * g + 3] *= a4[3]; } }
    }
    float sa = 0.f, sb = 0.f, sc = 0.f, sd = 0.f;
#pragma unroll
    for (int i = 0; i < 16; i += 2) { s0[i] = fexp2(s0[i] - m); s1[i] = fexp2(s1[i] - m); s0[i + 1] = fexp2(s0[i + 1] - m); s1[i + 1] = fexp2(s1[i + 1] - m); sa += s0[i]; sb += s1[i]; sc += s0[i + 1]; sd += s1[i + 1]; }
    l += (sa + sb) + (sc + sd);
}

template <int NB>
ADI void softmax_max(const f32x16& s0, const f32x16& s1, float& m, float& l, f32x16 (&O)[NB], LAS float* scr, int r, int hh) {
    float mxa = max3f(s0[0], s0[1], s1[0]), mxb = max3f(s0[2], s0[3], s1[1]); mxa = max3f(mxa, s1[2], s1[3]);
#pragma unroll
    for (int i = 4; i < 16; i += 4) { mxa = max3f(mxa, s0[i], s0[i + 1]); mxb = max3f(mxb, s0[i + 2], s0[i + 3]); mxa = max3f(mxa, s1[i], s1[i + 1]); mxb = max3f(mxb, s1[i + 2], s1[i + 3]); }
    const float mx = hmax(max3f(mxa, mxb, mxb));
    if (__any(mx > m + 8.0f)) {
        const float mn = fmaxf(m, mx), al = fexp2(m - mn); l *= al; m = mn;
        if (hh == 0) scr[r] = al;
#pragma unroll
        for (int g = 0; g < 4; ++g) { const f32x4 a4 = *(const LAS f32x4*)(scr + 8 * g + 4 * hh);
#pragma unroll
            for (int c = 0; c < NB; ++c) { O[c][4 * g] *= a4[0]; O[c][4 * g + 1] *= a4[1]; O[c][4 * g + 2] *= a4[2]; O[c][4 * g + 3] *= a4[3]; } }
    }
}
template <int S> ADI bf16x8 exp_pack8(f32x16& x, float m, float& sa, float& sb) {
#pragma unroll
    for (int i = 0; i < 8; i += 2) { x[8 * S + i] = fexp2(x[8 * S + i] - m); x[8 * S + i + 1] = fexp2(x[8 * S + i + 1] - m); sa += x[8 * S + i]; sb += x[8 * S + i + 1]; }
    return pack8<S>(x);
}
ADI void glds16(const void* gsrc, unsigned lds_dst) { unsigned keep;
    asm volatile("s_mov_b32 %0, m0\n\ts_mov_b32 m0, %2\n\ts_nop 0\n\tglobal_load_lds_dwordx4 %1, off\n\ts_mov_b32 m0, %0" : "=&s"(keep) : "v"(gsrc), "s"(lds_dst) : "memory"); }
#define ATT_GLDS(gp, lp) glds16((gp), (unsigned)__builtin_amdgcn_readfirstlane((int)(lp)))
typedef int v8i_a __attribute__((ext_vector_type(8)));
typedef int v4i_a __attribute__((ext_vector_type(4)));
typedef int v2i_a __attribute__((ext_vector_type(2)));
ADI void diff_unit(LAS unsigned char* lds, const unsigned char* QKV8, bf16_t* Oout, const float* subln, float lam, int b, int h, int qb, int tid, int lane, int wave) {
    const int r = lane & 31, hh = lane >> 5, comp = wave & 1, qt = wave >> 1;
    const size_t rowbase = (size_t)b * SEQ;
    v8i_a q8;
    {
        const unsigned char* qrow = QKV8 + (rowbase + qb * 128 + qt * 32 + r) * NQKV_B + (2 * h + comp) * 64 + 32 * hh;
        const v4i_a qa = *(const v4i_a*)qrow, qb_ = *(const v4i_a*)(qrow + 16);
        q8 = __builtin_shufflevector(qa, qb_, 0, 1, 2, 3, 4, 5, 6, 7);
    }
    const bool isV = wave >= 4; const int w4 = wave & 3;
    const int srow = 16 * w4 + (lane >> 2);
    const int vkey = 16 * w4 + (lane >> 3), vf0 = (vkey >> 1) & 1;
    const unsigned char* src0 = isV ? QKV8 + (rowbase + vkey) * NQKV_B + 2048 + h * 128 + ((((lane >> 1) & 3) ^ vf0) << 5) + ((lane & 1) << 4)
                                    : QKV8 + (rowbase + srow) * NQKV_B + 1024 + (2 * h) * 64 + (((lane & 3) ^ ((srow >> 2) & 3)) << 4);
    const unsigned char* src1 = isV ? QKV8 + (rowbase + vkey + 8) * NQKV_B + 2048 + h * 128 + ((((lane >> 1) & 3) ^ (vf0 | 2)) << 5) + ((lane & 1) << 4)
                                    : src0 + 64;
    const unsigned lb = (unsigned)(uintptr_t)lds;
    const unsigned dk0 = lb + (isV ? 8192 + (2 * w4) * 1024 : w4 * 1024), dk1 = lb + (isV ? 8192 + (2 * w4 + 1) * 1024 : 4096 + w4 * 1024);
#define DIFF_DMA(tt) do { const unsigned so_ = ((tt) & 3) * 16384; const size_t go_ = (size_t)(tt) * 64 * NQKV_B; \
        ATT_GLDS(src0 + go_, dk0 + so_); ATT_GLDS(src1 + go_, dk1 + so_); } while (0)
    const int kx = (r >> 2) & 3;
    const int kro0 = comp * 4096 + r * 64 + (((2 * hh) ^ kx) << 4), kro1 = comp * 4096 + r * 64 + (((2 * hh + 1) ^ kx) << 4);
    const int ts_ = lane & 15, tblk = (lane >> 4) & 1;
    const int te = ts_ >> 1, tcol = ts_ & 1;
    const int tkey = (te & 3) + 8 * (te >> 2) + 4 * hh;
    const int tfx = (te >> 1) & 3;
    const int vro = 8192 + tkey * 128 + 16 * tblk + 8 * tcol;
    LAS float* scr = (LAS float*)(lds + 132096 + wave * 256);
    f32x16 O[4];
#pragma unroll
    for (int c = 0; c < 4; ++c) O[c] = f32x16{};
    float m4 = 0.f, l = 0.f;
    f32x16 negm = f32x16{};
    constexpr int NT = SEQ / 64;
    const int sP = 0x7b7b7b7b, sV = 0x7f7f7f7f, sK = 0x7f7f7f7f, sQ = 0x7b7b7b7b;
    DIFF_DMA(0); DIFF_DMA(1);
    asm volatile("s_waitcnt vmcnt(2)\n\ts_barrier" ::: "memory");
    if (wave >= 4) __builtin_amdgcn_s_setprio(1);
    for (int t = 0; t < NT; ++t) {
        if (t + 2 < NT) DIFF_DMA(t + 2);
        const LAS unsigned char* st = lds + (t & 3) * 16384;
        f32x16 s0, s1;
        {
            const v4i_a a0 = *(const LAS v4i_a*)(st + kro0), a1 = *(const LAS v4i_a*)(st + kro1), b0 = *(const LAS v4i_a*)(st + 2048 + kro0), b1 = *(const LAS v4i_a*)(st + 2048 + kro1);
            const v8i_a k0 = __builtin_shufflevector(a0, a1, 0, 1, 2, 3, 4, 5, 6, 7), k1 = __builtin_shufflevector(b0, b1, 0, 1, 2, 3, 4, 5, 6, 7);
            asm volatile("s_nop 3\n\tv_mfma_scale_f32_32x32x64_f8f6f4 %0, %2, %4, %5, %6, %7 op_sel_hi:[0,0,0]\n\tv_mfma_scale_f32_32x32x64_f8f6f4 %1, %3, %4, %5, %6, %7 op_sel_hi:[0,0,0]\n\ts_nop 15\n\ts_nop 7"
                         : "=&v"(s0), "=&v"(s1) : "v"(k0), "v"(k1), "v"(q8), "v"(negm), "v"(sK), "v"(sQ));
        }
        {
            float mxa = max3f(s0[0], s0[1], s1[0]), mxb = max3f(s0[2], s0[3], s1[1]); mxa = max3f(mxa, s1[2], s1[3]);
#pragma unroll
            for (int i = 4; i < 16; i += 4) { mxa = max3f(mxa, s0[i], s0[i + 1]); mxb = max3f(mxb, s0[i + 2], s0[i + 3]); mxa = max3f(mxa, s1[i], s1[i + 1]); mxb = max3f(mxb, s1[i + 2], s1[i + 3]); }
            const float mx = hmax(max3f(mxa, mxb, mxb));
            if (t == 0 || __any(mx > 8.0f)) {
                const float dl = (t == 0) ? (mx - 4.0f) : fmaxf(mx - 4.0f, 0.f);
                const float al = (t == 0) ? 0.f : fexp2(-dl); l *= al; m4 += dl;
#pragma unroll
                for (int i = 0; i < 16; ++i) { s0[i] -= dl; s1[i] -= dl; negm[i] = -m4; }
                if (hh == 0) scr[r] = al;
#pragma unroll
                for (int g = 0; g < 4; ++g) { const f32x4 a4 = *(const LAS f32x4*)(scr + 8 * g + 4 * hh);
#pragma unroll
                    for (int c = 0; c < 4; ++c) { O[c][4 * g] *= a4[0]; O[c][4 * g + 1] *= a4[1]; O[c][4 * g + 2] *= a4[2]; O[c][4 * g + 3] *= a4[3]; } }
            }
        }
        float sa = 0.f, sb = 0.f, sc = 0.f, sd = 0.f;
#pragma unroll
        for (int i = 0; i < 16; i += 2) { s0[i] = fexp2(s0[i]); s1[i] = fexp2(s1[i]); s0[i + 1] = fexp2(s0[i + 1]); s1[i + 1] = fexp2(s1[i + 1]); sa += s0[i]; sb += s1[i]; sc += s0[i + 1]; sd += s1[i + 1]; }
        l += ((sa + sb) + (sc + sd)) * 0.0625f;
        v8i_a P8;
#pragma unroll
        for (int g = 0; g < 4; ++g) { P8[g] = (int)pk_fp8x4_nc(s0[4 * g], s0[4 * g + 1], s0[4 * g + 2], s0[4 * g + 3]); P8[4 + g] = (int)pk_fp8x4_nc(s1[4 * g], s1[4 * g + 1], s1[4 * g + 2], s1[4 * g + 3]); }
#pragma unroll
        for (int c = 0; c < 4; ++c) {
            const LAS unsigned char* vp = st + vro + ((c ^ tfx) << 5);
            const v2i_a t0 = __builtin_amdgcn_ds_read_tr8_b64_v2i32((LAS v2i_a*)(vp)), t1 = __builtin_amdgcn_ds_read_tr8_b64_v2i32((LAS v2i_a*)(vp + 16 * 128));
            const v2i_a t2 = __builtin_amdgcn_ds_read_tr8_b64_v2i32((LAS v2i_a*)(vp + 32 * 128)), t3 = __builtin_amdgcn_ds_read_tr8_b64_v2i32((LAS v2i_a*)(vp + 48 * 128));
            const v8i_a V8 = (v8i_a){t0[0], t0[1], t1[0], t1[1], t2[0], t2[1], t3[0], t3[1]};
            asm volatile("s_nop 3\n\tv_mfma_scale_f32_32x32x64_f8f6f4 %0, %1, %2, %0, %3, %4 op_sel_hi:[0,0,0]" : "+v"(O[c]) : "v"(P8), "v"(V8), "v"(sP), "v"(sV));
        }
        if (t + 2 < NT) asm volatile("s_waitcnt vmcnt(2) lgkmcnt(0)\n\ts_barrier" ::: "memory"); else asm volatile("s_waitcnt vmcnt(0) lgkmcnt(0)\n\ts_barrier" ::: "memory");
    }
#undef DIFF_DMA
    __builtin_amdgcn_s_setprio(0);
    asm volatile("s_nop 15\n\ts_nop 15" ::: "memory");
    l = hsum(l);
    if (hh == 0) scr[r] = (comp == 0 ? 1.0f : lam) / l;
    LAS float* xch = (LAS float*)(lds + qt * 16384) + lane;
#pragma unroll
    for (int g = 0; g < 4; ++g) { const f32x4 a4 = *(const LAS f32x4*)(scr + 8 * g + 4 * hh);
#pragma unroll
        for (int c = 0; c < 4; ++c) { O[c][4 * g] *= a4[0]; O[c][4 * g + 1] *= a4[1]; O[c][4 * g + 2] *= a4[2]; O[c][4 * g + 3] *= a4[3]; } }
    if (comp == 1) {
#pragma unroll
        for (int c = 0; c < 4; ++c)
#pragma unroll
            for (int i = 0; i < 16; ++i) xch[(c * 16 + i) * 64] = O[c][i];
    }
    __syncthreads();
    if (comp == 0) {
        float sg[4];
#pragma unroll
        for (int c = 0; c < 4; ++c) sg[c] = subln[32 * c + r] * (1.0f - LAMBDA_INIT);
#pragma unroll
        for (int i = 0; i < 16; ++i) {
            float y[4]; float ss = 0.f;
#pragma unroll
            for (int c = 0; c < 4; ++c) { y[c] = O[c][i] - xch[(c * 16 + i) * 64]; ss += y[c] * y[c]; }
            ss += __shfl_xor(ss, 1); ss += __shfl_xor(ss, 2); ss += __shfl_xor(ss, 4); ss += __shfl_xor(ss, 8); ss += __shfl_xor(ss, 16);
            const float rs = 1.0f / sqrtf(ss * (1.0f / 128.0f) + SUBLN_EPS);
            bf16_t* op = Oout + (rowbase + qb * 128 + qt * 32 + crow(i, hh)) * DM + h * 128 + r;
#pragma unroll
            for (int c = 0; c < 4; ++c) op[32 * c] = (bf16_t)f2bf(y[c] * rs * sg[c]);
        }
    }
    __syncthreads();
}

struct BandW { const bf16_t* qrow; int qi0, tlo, thi; float m0, l0; bf16_t* out; size_t ostride; float* lse; size_t lstride; };
template <bool LSE_OUT>
ADI void band_unit(LAS unsigned char* lds, const bf16_t* Kb, const bf16_t* Vb, size_t kstride, int L, int jstart, int ntiles, int halfw, const BandW& W, int tid, int lane, int wave) {
    const int r = lane & 31, hh = lane >> 5;
    bf16x8 q[4];
#pragma unroll
    for (int d0 = 0; d0 < 4; ++d0) q[d0] = *(const bf16x8*)(W.qrow + 16 * d0 + 8 * hh);
    const int srow = tid >> 3, sch = tid & 7;
    const int kdst = srow * 128 + ((sch ^ ((srow >> 1) & 7)) << 4);
    const int vdst = 8192 + srow * 128 + ((sch ^ (((srow >> 1) & 1) << 2)) << 4);
    const int xs = (r >> 1) & 7;
    const int kro = r * 128 + ((hh ^ (xs & 1)) << 4), kx6 = (xs & 6) << 4;
    const int blk = (lane >> 4) & 1, qq = (lane & 15) >> 2, pp = lane & 3;
    const int vro = 8192 + (4 * hh + qq) * 128 + ((2 * blk + (pp >> 1)) << 4) + 8 * (pp & 1), vq6 = ((qq >> 1) & 1) << 6;
    LAS float* scr = (LAS float*)(lds + 132096 + wave * 256);
    f32x16 O[2]; O[0] = f32x16{}; O[1] = f32x16{};
    float m = W.m0, l = W.l0;
    const int qi = W.qi0 + r;
    {
        int j = jstart + srow; j = j < 0 ? 0 : (j > L - 1 ? L - 1 : j);
        const u32x4 ka = *(const u32x4*)(Kb + (size_t)j * kstride + sch * 8), va = *(const u32x4*)(Vb + (size_t)j * kstride + sch * 8);
        *(LAS u32x4*)(lds + kdst) = ka; *(LAS u32x4*)(lds + vdst) = va;
    }
    __syncthreads();
    for (int t = 0; t < ntiles; ++t) {
        const LAS unsigned char* st = lds + (t & 1) * 16384;
        const bool active = (t >= W.tlo) && (t <= W.thi);
        bf16x8 P[4];
        if (active) {
            f32x16 s0, s1;
            qk_tile(s0, s1, st, q, kro, kx6);
            const int jb = jstart + 64 * t + 4 * hh;
#pragma unroll
            for (int i = 0; i < 16; ++i) {
                const int j0 = jb + (i & 3) + 8 * (i >> 2), j1 = j0 + 32;
                if (!(((unsigned)j0 < (unsigned)L) && ((unsigned)(j0 - qi + halfw) <= (unsigned)(2 * halfw)))) s0[i] = -INFINITY;
                if (!(((unsigned)j1 < (unsigned)L) && ((unsigned)(j1 - qi + halfw) <= (unsigned)(2 * halfw)))) s1[i] = -INFINITY;
            }
            softmax_tile<2>(s0, s1, m, l, O, scr, r, hh);
            P[0] = pack8<0>(s0); P[1] = pack8<1>(s0); P[2] = pack8<0>(s1); P[3] = pack8<1>(s1);
        }
        int j = jstart + 64 * ((t + 1 < ntiles) ? t + 1 : t) + srow; j = j < 0 ? 0 : (j > L - 1 ? L - 1 : j);
        const u32x4 ka = *(const u32x4*)(Kb + (size_t)j * kstride + sch * 8), va = *(const u32x4*)(Vb + (size_t)j * kstride + sch * 8);
        if (active) {
#pragma unroll
            for (int c = 0; c < 2; ++c)
#pragma unroll
                for (int kc = 0; kc < 4; ++kc) {
                    const LAS unsigned char* vp = st + vro + (vq6 ^ (c << 6)) + kc * 2048;
                    const bf16x8 vf = cat8(vtr(vp), vtr(vp + 1024));
                    O[c] = MFMA32(P[kc], vf, O[c]);
                }
        }
        LAS unsigned char* sn = lds + ((t + 1) & 1) * 16384;
        *(LAS u32x4*)(sn + kdst) = ka; *(LAS u32x4*)(sn + vdst) = va;
        __syncthreads();
    }
    l = hsum(l);
    if (hh == 0) scr[r] = 1.0f / l;
    if (LSE_OUT) { if (hh == 0) W.lse[(size_t)(W.qi0 + r) * W.lstride] = m + log2f(l); }
#pragma unroll
    for (int g = 0; g < 4; ++g) { const f32x4 a4 = *(const LAS f32x4*)(scr + 8 * g + 4 * hh);
#pragma unroll
        for (int k = 0; k < 4; ++k) { bf16_t* op = W.out + (size_t)(W.qi0 + 8 * g + 4 * hh + k) * W.ostride + r;
            op[0] = (bf16_t)f2bf(O[0][4 * g + k] * a4[k]); op[32] = (bf16_t)f2bf(O[1][4 * g + k] * a4[k]); } }
}

struct BandDesc { const bf16_t* Kb; const bf16_t* Vb; size_t kstride; int L, jstart; const bf16_t* qrow; int qi0, tlo, thi; float m0, l0; bf16_t* out; size_t ostride; float* lse; size_t lstride; };
template <int NTL, int HALFW, bool LSE_OUT, class F>
ADI void band_stream(LAS unsigned char* lds, int nunits, const F& get, int tid, int lane, int wave) {
    const int r = lane & 31, hh = lane >> 5;
    const unsigned lbase = (unsigned)(uintptr_t)lds;
    const int srow = 8 * wave + (lane >> 3), kchs = ((lane & 7) ^ ((srow >> 1) & 7)) * 8, vchs = ((lane & 7) ^ (((srow >> 1) & 1) << 2)) * 8;
    const int xs = (r >> 1) & 7;
    const int kro = r * 128 + ((hh ^ (xs & 1)) << 4), kx6 = (xs & 6) << 4;
    const int blk = (lane >> 4) & 1, qq = (lane & 15) >> 2, pp = lane & 3;
    const int vro = 8192 + (4 * hh + qq) * 128 + ((2 * blk + (pp >> 1)) << 4) + 8 * (pp & 1), vq6 = ((qq >> 1) & 1) << 6;
    LAS float* scr = (LAS float*)(lds + 132096 + wave * 256);
    const int total = nunits * NTL;
#define BAND_TILE_DMA(sp) do { const int sp_ = (sp) < total ? (sp) : total - 1; const int k_ = sp_ / NTL, t_ = sp_ % NTL; const BandDesc D_ = get(k_); \
        int j_ = D_.jstart + 64 * t_ + srow; j_ = j_ < 0 ? 0 : (j_ > D_.L - 1 ? D_.L - 1 : j_); const unsigned st_ = lbase + ((sp) & 3) * 16384 + wave * 1024; \
        ATT_GLDS(D_.Kb + (size_t)j_ * D_.kstride + kchs, st_); ATT_GLDS(D_.Vb + (size_t)j_ * D_.kstride + vchs, st_ + 8192); } while (0)
#define BAND_Q_DMA(ku, d0) do { const int ku_ = (ku) < nunits ? (ku) : nunits - 1; const BandDesc D_ = get(ku_); \
        ATT_GLDS(D_.qrow + 16 * (d0) + 8 * hh, lbase + 65536 + ((ku) & 1) * 32768 + wave * 4096 + (d0) * 1024); } while (0)
    BAND_Q_DMA(0, 0); BAND_Q_DMA(0, 1); BAND_Q_DMA(0, 2); BAND_Q_DMA(0, 3);
    BAND_TILE_DMA(0); BAND_TILE_DMA(1);
    asm volatile("s_waitcnt vmcnt(2)\n\ts_barrier" ::: "memory");
    bf16x8 q[4]; f32x16 O[2]; float m = 0.f, l = 0.f;
    O[0] = f32x16{}; O[1] = f32x16{};
#pragma unroll
    for (int d0 = 0; d0 < 4; ++d0) q[d0] = bf16x8{};
    int k = 0, t = 0;
    for (int s = 0; s < total; ++s) {
        BAND_TILE_DMA(s + 2); BAND_Q_DMA(k + 1, (t < 4 ? t : 3));
        const BandDesc D = get(k);
        if (t == 0) {
            const LAS unsigned char* qs = lds + 65536 + (k & 1) * 32768 + wave * 4096 + lane * 16;
#pragma unroll
            for (int d0 = 0; d0 < 4; ++d0) q[d0] = *(const LAS bf16x8*)(qs + d0 * 1024);
            O[0] = f32x16{}; O[1] = f32x16{}; m = D.m0; l = D.l0;
        }
        const LAS unsigned char* st = lds + (s & 3) * 16384;
        if (t >= D.tlo && t <= D.thi) {
            f32x16 s0, s1;
            qk_tile(s0, s1, st, q, kro, kx6);
            const int ts = D.jstart + 64 * t;
            if (!(ts >= D.qi0 + 31 - HALFW && ts + 63 <= D.qi0 + HALFW && ts >= 0 && ts + 63 < D.L)) {
                const int jb = ts + 4 * hh, qi = D.qi0 + r;
#pragma unroll
                for (int i = 0; i < 16; ++i) {
                    const int j0 = jb + (i & 3) + 8 * (i >> 2), j1 = j0 + 32;
                    if (!(((unsigned)j0 < (unsigned)D.L) && ((unsigned)(j0 - qi + HALFW) <= (unsigned)(2 * HALFW)))) s0[i] = -INFINITY;
                    if (!(((unsigned)j1 < (unsigned)D.L) && ((unsigned)(j1 - qi + HALFW) <= (unsigned)(2 * HALFW)))) s1[i] = -INFINITY;
                }
            }
            softmax_tile<2>(s0, s1, m, l, O, scr, r, hh);
            bf16x8 P[4]; P[0] = pack8<0>(s0); P[1] = pack8<1>(s0); P[2] = pack8<0>(s1); P[3] = pack8<1>(s1);
#pragma unroll
            for (int c = 0; c < 2; ++c)
#pragma unroll
                for (int kc = 0; kc < 4; ++kc) {
                    const LAS unsigned char* vp = st + vro + (vq6 ^ (c << 6)) + kc * 2048;
                    const bf16x8 vf = cat8(vtr(vp), vtr(vp + 1024));
                    O[c] = MFMA32(P[kc], vf, O[c]);
                }
        }
        if (t == NTL - 1 && D.tlo <= D.thi) {
            const float lt = hsum(l);
            if (hh == 0) scr[r] = 1.0f / lt;
            if (LSE_OUT) { if (hh == 0) D.lse[(size_t)(D.qi0 + r) * D.lstride] = m + log2f(lt); }
#pragma unroll
            for (int g = 0; g < 4; ++g) { const f32x4 a4 = *(const LAS f32x4*)(scr + 8 * g + 4 * hh);
#pragma unroll
                for (int kk = 0; kk < 4; ++kk) { bf16_t* op = D.out + (size_t)(D.qi0 + 8 * g + 4 * hh + kk) * D.ostride + r;
                    op[0] = (bf16_t)f2bf(O[0][4 * g + kk] * a4[kk]); op[32] = (bf16_t)f2bf(O[1][4 * g + kk] * a4[kk]); } }
        }
        asm volatile("s_waitcnt vmcnt(3) lgkmcnt(0)\n\ts_barrier" ::: "memory");
        if (++t == NTL) { t = 0; ++k; }
    }
    asm volatile("s_waitcnt vmcnt(0)\n\ts_barrier" ::: "memory");
#undef BAND_TILE_DMA
#undef BAND_Q_DMA
}

template <int NB>
ADI void softmax_tile8(f32x16& s0, f32x16& s1, float& m, float& l, f32x16 (&O)[NB], LAS float* scr, int r, int hh) {
    float mxa = max3f(s0[0], s0[1], s1[0]), mxb = max3f(s0[2], s0[3], s1[1]); mxa = max3f(mxa, s1[2], s1[3]);
#pragma unroll
    for (int i = 4; i < 16; i += 4) { mxa = max3f(mxa, s0[i], s0[i + 1]); mxb = max3f(mxb, s0[i + 2], s0[i + 3]); mxa = max3f(mxa, s1[i], s1[i + 1]); mxb = max3f(mxb, s1[i + 2], s1[i + 3]); }
    float mx = hmax(max3f(mxa, mxb, mxb));
    if (__any(mx > m + 4.0f)) {
        const float mn = fmaxf(m, mx), al = fexp2(m - mn); l *= al; m = mn;
        if (hh == 0) scr[r] = al;
#pragma unroll
        for (int g = 0; g < 4; ++g) { const f32x4 a4 = *(const LAS f32x4*)(scr + 8 * g + 4 * hh);
#pragma unroll
            for (int c = 0; c < NB; ++c) { O[c][4 * g] *= a4[0]; O[c][4 * g + 1] *= a4[1]; O[c][4 * g + 2] *= a4[2]; O[c][4 * g + 3] *= a4[3]; } }
    }
    const float m4 = m - 4.0f;
    float sa = 0.f, sb = 0.f, sc = 0.f, sd = 0.f;
#pragma unroll
    for (int i = 0; i < 16; i += 2) { s0[i] = fexp2(s0[i] - m4); s1[i] = fexp2(s1[i] - m4); s0[i + 1] = fexp2(s0[i + 1] - m4); s1[i + 1] = fexp2(s1[i + 1] - m4); sa += s0[i]; sb += s1[i]; sc += s0[i + 1]; sd += s1[i + 1]; }
    l += ((sa + sb) + (sc + sd)) * 0.0625f;
}

struct BandDesc8 { const unsigned char* Kb; const unsigned char* Vb; size_t kstride; int L, jstart; const unsigned char* qrow; int qi0, tlo, thi; float m0, l0; bf16_t* out; size_t ostride; float* lse; size_t lstride; };
template <int NTL, int HALFW, class F, bool OUT8 = false>
ADI void band_stream8(LAS unsigned char* lds, int nunits, const F& get, int tid, int lane, int wave) {
    static_assert(2 * NTL * 8192 + 32768 <= 132096, "LDS");
    const int r = lane & 31, hh = lane >> 5;
    const unsigned lbase = (unsigned)(uintptr_t)lds;
    const bool isV = wave >= 4;
    const int srow = 16 * (wave & 3) + (lane >> 2);
    const int soff = isV ? (((((lane >> 1) & 1) ^ ((srow >> 3) & 1)) << 5) + ((lane & 1) << 4)) : (((lane & 3) ^ ((srow >> 2) & 3)) << 4);
    const int kx = (r >> 2) & 3;
    const int kro0 = r * 64 + (((2 * hh) ^ kx) << 4), kro1 = r * 64 + (((2 * hh + 1) ^ kx) << 4);
    const int ts_ = lane & 15, tblk = (lane >> 4) & 1, te = ts_ >> 1, tcol = ts_ & 1;
    const int tkey = (te & 3) + 8 * (te >> 2) + 4 * hh, tfx = (te >> 2) & 1;
    const int vro = 4096 + tkey * 64 + 16 * tblk + 8 * tcol;
    LAS float* scr = (LAS float*)(lds + 132096 + wave * 256);
    const int sK = 0x7f7f7f7f, sQ = 0x7b7b7b7b, sP = 0x7b7b7b7b, sV = 0x7f7f7f7f;
#define B8_UNIT_DMA(ku) do { if ((ku) < nunits) { const BandDesc8 D_ = get(ku); \
        _Pragma("unroll") for (int ti_ = 0; ti_ < NTL; ++ti_) { int j_ = D_.jstart + 64 * ti_ + srow; j_ = j_ < 0 ? 0 : (j_ > D_.L - 1 ? D_.L - 1 : j_); \
            ATT_GLDS((isV ? D_.Vb : D_.Kb) + (size_t)j_ * D_.kstride + soff, lbase + ((ku) & 1) * (NTL * 8192) + ti_ * 8192 + wave * 1024); } \
        ATT_GLDS(D_.qrow + 32 * hh, lbase + 2 * NTL * 8192 + ((ku) & 1) * 16384 + wave * 2048); \
        ATT_GLDS(D_.qrow + 32 * hh + 16, lbase + 2 * NTL * 8192 + ((ku) & 1) * 16384 + wave * 2048 + 1024); } } while (0)
    B8_UNIT_DMA(0);
    asm volatile("s_waitcnt vmcnt(0)\n\ts_barrier" ::: "memory");
    for (int k = 0; k < nunits; ++k) {
        B8_UNIT_DMA(k + 1);
        const BandDesc8 D = get(k);
        const int tlo = __builtin_amdgcn_readfirstlane(D.tlo), thi = __builtin_amdgcn_readfirstlane(D.thi);
        if (tlo <= thi) {
            v8i_a q8; f32x16 O[2]; float m = D.m0, l = D.l0;
            {
                const LAS unsigned char* qs = lds + 2 * NTL * 8192 + (k & 1) * 16384 + wave * 2048 + lane * 16;
                const v4i_a qa = *(const LAS v4i_a*)qs, qb = *(const LAS v4i_a*)(qs + 1024);
                q8 = __builtin_shufflevector(qa, qb, 0, 1, 2, 3, 4, 5, 6, 7);
            }
            O[0] = f32x16{}; O[1] = f32x16{};
#pragma unroll 1
            for (int t = tlo; t <= thi; ++t) {
                const LAS unsigned char* st = lds + (k & 1) * (NTL * 8192) + t * 8192;
                f32x16 s0, s1;
                {
                    const v4i_a a0 = *(const LAS v4i_a*)(st + kro0), a1 = *(const LAS v4i_a*)(st + kro1), b0 = *(const LAS v4i_a*)(st + 2048 + kro0), b1 = *(const LAS v4i_a*)(st + 2048 + kro1);
                    const v8i_a k0 = __builtin_shufflevector(a0, a1, 0, 1, 2, 3, 4, 5, 6, 7), k1 = __builtin_shufflevector(b0, b1, 0, 1, 2, 3, 4, 5, 6, 7);
                    asm volatile("v_mfma_scale_f32_32x32x64_f8f6f4 %0, %2, %4, 0, %5, %6 op_sel_hi:[0,0,0]\n\tv_mfma_scale_f32_32x32x64_f8f6f4 %1, %3, %4, 0, %5, %6 op_sel_hi:[0,0,0]\n\ts_nop 15\n\ts_nop 7"
                                 : "=&v"(s0), "=&v"(s1) : "v"(k0), "v"(k1), "v"(q8), "v"(sK), "v"(sQ));
                }
                const int ts = D.jstart + 64 * t;
                if (!(ts >= D.qi0 + 31 - HALFW && ts + 63 <= D.qi0 + HALFW && ts >= 0 && ts + 63 < D.L)) {
                    const int jb = ts + 4 * hh, qi = D.qi0 + r;
#pragma unroll
                    for (int i = 0; i < 16; ++i) {
                        const int j0 = jb + (i & 3) + 8 * (i >> 2), j1 = j0 + 32;
                        if (!(((unsigned)j0 < (unsigned)D.L) && ((unsigned)(j0 - qi + HALFW) <= (unsigned)(2 * HALFW)))) s0[i] = -INFINITY;
                        if (!(((unsigned)j1 < (unsigned)D.L) && ((unsigned)(j1 - qi + HALFW) <= (unsigned)(2 * HALFW)))) s1[i] = -INFINITY;
                    }
                }
                softmax_tile8<2>(s0, s1, m, l, O, scr, r, hh);
                v8i_a P8;
#pragma unroll
                for (int g = 0; g < 4; ++g) { P8[g] = (int)pk_fp8x4_nc(s0[4 * g], s0[4 * g + 1], s0[4 * g + 2], s0[4 * g + 3]); P8[4 + g] = (int)pk_fp8x4_nc(s1[4 * g], s1[4 * g + 1], s1[4 * g + 2], s1[4 * g + 3]); }
#pragma unroll
                for (int c = 0; c < 2; ++c) {
                    const LAS unsigned char* vp = st + vro + ((c ^ tfx) << 5);
                    const v2i_a t0 = __builtin_amdgcn_ds_read_tr8_b64_v2i32((LAS v2i_a*)(vp)), t1 = __builtin_amdgcn_ds_read_tr8_b64_v2i32((LAS v2i_a*)(vp + 16 * 64));
                    const v2i_a t2 = __builtin_amdgcn_ds_read_tr8_b64_v2i32((LAS v2i_a*)(vp + 32 * 64)), t3 = __builtin_amdgcn_ds_read_tr8_b64_v2i32((LAS v2i_a*)(vp + 48 * 64));
                    const v8i_a V8 = (v8i_a){t0[0], t0[1], t1[0], t1[1], t2[0], t2[1], t3[0], t3[1]};
                    asm volatile("s_nop 3\n\tv_mfma_scale_f32_32x32x64_f8f6f4 %0, %1, %2, %0, %3, %4 op_sel_hi:[0,0,0]" : "+v"(O[c]) : "v"(P8), "v"(V8), "v"(sP), "v"(sV));
                }
            }
            asm volatile("s_nop 15\n\ts_nop 15" ::: "memory");
            const float lt = hsum(l);
            if (hh == 0) scr[r] = 1.0f / lt;
            asm volatile("s_waitcnt vmcnt(0)" ::: "memory");
            if (hh == 0 && D.lse != nullptr) D.lse[(size_t)(D.qi0 + r) * D.lstride] = m + log2f(lt);
#pragma unroll
            for (int g = 0; g < 4; ++g) { const f32x4 a4 = *(const LAS f32x4*)(scr + 8 * g + 4 * hh);
#pragma unroll
                for (int kk = 0; kk < 4; ++kk) {
                    if constexpr (OUT8) { unsigned char* op = (unsigned char*)D.out + (size_t)(D.qi0 + 8 * g + 4 * hh + kk) * D.ostride + r;
                        op[0] = fp8_byte(O[0][4 * g + kk] * a4[kk]); op[32] = fp8_byte(O[1][4 * g + kk] * a4[kk]); }
                    else { bf16_t* op = D.out + (size_t)(D.qi0 + 8 * g + 4 * hh + kk) * D.ostride + r;
                    op[0] = (bf16_t)f2bf(O[0][4 * g + kk] * a4[kk]); op[32] = (bf16_t)f2bf(O[1][4 * g + kk] * a4[kk]); } } }
        } else {
            asm volatile("s_waitcnt vmcnt(0)" ::: "memory");
        }
        asm volatile("s_waitcnt lgkmcnt(0)\n\ts_barrier" ::: "memory");
    }
    asm volatile("s_waitcnt vmcnt(0)\n\ts_barrier" ::: "memory");
#undef B8_UNIT_DMA
}
}

__device__ __forceinline__ void attn_B(const Ctx& C) {
    const bf16_t* QKV = WSP(bf16_t, WS_BIG + BIG_QKV); bf16_t* O = WSP(bf16_t, WS_O); const float* subln = IN_F(15);
    const float lam = diff_lambda(C);
    const int vcu = (C.G % 8 == 0) ? (C.bid % 8) * (C.G / 8) + C.bid / 8 : C.bid;
    for (int u = vcu; u < 1024; u += C.G) {
        const int k = u / C.G, v = u % C.G; int bh, qb;
        if (C.G == 256) { bh = v >> 4; qb = (v & 15) * 4 + k; } else { bh = u >> 6; qb = u & 63; }
        att::diff_unit(C.lds, (const unsigned char*)QKV, O, subln, lam, bh >> 3, bh & 7, qb, C.tid, C.lane, C.wave);
    }
}

struct GetA {
    const bf16_t* QKV; bf16_t* OG; float* LSE; int vcu, G, wave, r;
    __device__ __forceinline__ att::BandDesc operator()(int k) const {
        const int U = vcu + k * G; att::BandDesc D;
        const bool ok = U < 3072; const int Uc = ok ? U : 0;
        const int v = Uc & 31, t3 = Uc >> 5, gi = t3 % 3, bh = t3 / 3, b = bh >> 4, h = bh & 15;
        const int sh = 2 * gi, dil = 1 << sh, Lg = SEQ >> sh, nqb = 32 >> sh, res = v >> (5 - sh), i0 = (v & (nqb - 1)) << 8;
        const size_t tok0 = (size_t)b * SEQ + res;
        const bf16_t* base = QKV + tok0 * NQKV_A + gi * 3072 + h * 64;
        D.Kb = base + 1024; D.Vb = base + 2048; D.kstride = (size_t)dil * NQKV_A; D.L = Lg; D.jstart = i0 - 64;
        D.qi0 = i0 + 32 * wave; D.tlo = ok ? (wave >> 1) : 1; D.thi = ok ? ((32 * wave + 159) >> 6) : 0; D.m0 = -1e30f; D.l0 = 0.f;
        D.qrow = base + (size_t)(D.qi0 + r) * dil * NQKV_A;
        D.out = OG + ((size_t)gi * NTOK + tok0) * DM + h * 64; D.ostride = (size_t)dil * DM;
        D.lse = LSE + ((size_t)gi * NTOK + tok0) * 16 + h; D.lstride = (size_t)dil * 16;
        return D;
    }
};
struct GetA8 {
    const unsigned char* QKV8; bf16_t* OG; float* LSE; int vcu, G, wave, r;
    __device__ __forceinline__ att::BandDesc8 operator()(int k) const {
        const int U = vcu + k * G; att::BandDesc8 D;
        const bool ok = U < 3072; const int Uc = ok ? U : 0;
        const int v = Uc & 31, t3 = Uc >> 5, gi = t3 % 3, bh = t3 / 3, b = bh >> 4, h = bh & 15;
        const int sh = 2 * gi, dil = 1 << sh, Lg = SEQ >> sh, nqb = 32 >> sh, res = v >> (5 - sh), i0 = (v & (nqb - 1)) << 8;
        const size_t tok0 = (size_t)b * SEQ + res;
        const unsigned char* base = QKV8 + (size_t)(3 * gi) * ((size_t)NTOK * 1024) + (size_t)((b * 16 + h) * SEQ + res * Lg) * 64;
        D.Kb = base + (size_t)NTOK * 1024; D.Vb = base + (size_t)2 * NTOK * 1024; D.kstride = 64; D.L = Lg; D.jstart = i0 - 64;
        D.qi0 = i0 + 32 * wave; D.tlo = ok ? (wave >> 1) : 1; D.thi = ok ? ((32 * wave + 159) >> 6) : 0; D.m0 = -1e30f; D.l0 = 0.f;
        D.qrow = base + (size_t)(D.qi0 + r) * 64;
        D.out = OG + ((size_t)gi * NTOK + tok0) * DM + h * 64; D.ostride = (size_t)dil * DM;
        D.lse = LSE + ((size_t)gi * NTOK + tok0) * 16 + h; D.lstride = (size_t)dil * 16;
        return D;
    }
};
__device__ __forceinline__ void attn_A8(const Ctx& C) {
    GetA8 g; g.QKV8 = WSP(unsigned char, WS_BIG + BIG_QKV); g.OG = WSP(bf16_t, WS_BIG + BIG_OG); g.LSE = WSP(float, WS_LSE);
    g.vcu = (C.G % 8 == 0) ? (C.bid % 8) * (C.G / 8) + C.bid / 8 : C.bid; g.G = C.G; g.wave = C.wave; g.r = C.lane & 31;
    att::band_stream8<6, 64, GetA8>(C.lds, (3072 + C.G - 1) / C.G, g, C.tid, C.lane, C.wave);
}
__device__ __forceinline__ void attn_A(const Ctx& C) {
    GetA g; g.QKV = WSP(bf16_t, WS_BIG + BIG_QKV); g.OG = WSP(bf16_t, WS_BIG + BIG_OG); g.LSE = WSP(float, WS_LSE);
    g.vcu = (C.G % 8 == 0) ? (C.bid % 8) * (C.G / 8) + C.bid / 8 : C.bid; g.G = C.G; g.wave = C.wave; g.r = C.lane & 31;
    att::band_stream<6, 64, true, GetA>(C.lds, (3072 + C.G - 1) / C.G, g, C.tid, C.lane, C.wave);
}
struct GetC {
    const bf16_t* QKV; bf16_t* O; float sk0, sk1; int vcu, G, wave, r, hh;
    __device__ __forceinline__ att::BandDesc operator()(int k) const {
        const int U = vcu + k * G; att::BandDesc D;
        const bool ok = U < 1024; const int Uc = ok ? U : 0;
        const int qblk = Uc & 255, bg = Uc >> 8, b = bg >> 1, g = bg & 1, i0 = qblk * 32, head = 8 * g + wave;
        const bf16_t* base = QKV + (size_t)b * SEQ * NQKV_C;
        D.Kb = base + 1024 + g * 64; D.Vb = base + 1152 + g * 64; D.kstride = (size_t)NQKV_C; D.L = SEQ; D.jstart = i0 - 128;
        D.qi0 = i0; D.tlo = ok ? 0 : 1; D.thi = ok ? 4 : 0; D.m0 = (g ? sk1 : sk0) * LOG2E; D.l0 = hh == 0 ? 1.f : 0.f;
        D.qrow = base + (size_t)(i0 + r) * NQKV_C + head * 64;
        D.out = O + (size_t)b * SEQ * DM + head * 64; D.ostride = DM; D.lse = nullptr; D.lstride = 0;
        return D;
    }
};
struct GetC8 {
    const unsigned char* QKV8; bf16_t* O; float sk0, sk1; int vcu, G, wave, r, hh;
    __device__ __forceinline__ att::BandDesc8 operator()(int k) const {
        const int U = vcu + k * G; att::BandDesc8 D;
        const bool ok = U < 1024; const int Uc = ok ? U : 0;
        const int qblk = Uc & 255, bg = Uc >> 8, b = bg >> 1, g = bg & 1, i0 = qblk * 32, head = 8 * g + wave;
        const unsigned char* base = QKV8 + (size_t)b * SEQ * NQKV_C;
        D.Kb = base + 1024 + g * 64; D.Vb = base + 1152 + g * 64; D.kstride = (size_t)NQKV_C; D.L = SEQ; D.jstart = i0 - 128;
        D.qi0 = i0; D.tlo = ok ? 0 : 1; D.thi = ok ? 4 : 0; D.m0 = (g ? sk1 : sk0) * LOG2E; D.l0 = hh == 0 ? 1.f : 0.f;
        D.qrow = base + (size_t)(i0 + r) * NQKV_C + head * 64;
        D.out = (bf16_t*)((unsigned char*)O + (size_t)b * SEQ * DM + head * 64); D.ostride = DM; D.lse = nullptr; D.lstride = 0;
        return D;
    }
};
__device__ __forceinline__ void attn_C8(const Ctx& C) {
    GetC8 g; g.QKV8 = WSP(unsigned char, WS_BIG + BIG_QKV); g.O = WSP(bf16_t, WS_O); g.sk0 = IN_F(24)[C.wave]; g.sk1 = IN_F(24)[8 + C.wave];
    g.vcu = (C.G % 8 == 0) ? (C.bid % 8) * (C.G / 8) + C.bid / 8 : C.bid; g.G = C.G; g.wave = C.wave; g.r = C.lane & 31; g.hh = C.lane >> 5;
    asm volatile("s_waitcnt vmcnt(0)" ::: "memory");
    att::band_stream8<5, 128, GetC8, true>(C.lds, (1024 + C.G - 1) / C.G, g, C.tid, C.lane, C.wave);
}
__device__ __forceinline__ void attn_C(const Ctx& C) {
    GetC g; g.QKV = WSP(bf16_t, WS_BIG + BIG_QKV); g.O = WSP(bf16_t, WS_O); g.sk0 = IN_F(24)[C.wave]; g.sk1 = IN_F(24)[8 + C.wave];
    g.vcu = (C.G % 8 == 0) ? (C.bid % 8) * (C.G / 8) + C.bid / 8 : C.bid; g.G = C.G; g.wave = C.wave; g.r = C.lane & 31; g.hh = C.lane >> 5;
    asm volatile("s_waitcnt vmcnt(0)" ::: "memory");
    att::band_stream<5, 128, false, GetC>(C.lds, (1024 + C.G - 1) / C.G, g, C.tid, C.lane, C.wave);
}

__device__ __forceinline__ void combine_A(const Ctx& C) {
    const bf16_t* OG = WSP(bf16_t, WS_BIG + BIG_OG); const float* LSE = WSP(float, WS_LSE); bf16_t* O = WSP(bf16_t, WS_O);
    const int gw = C.bid * 8 + C.wave, NGW = C.G * 8, lane = C.lane, h = lane >> 2;
    for (int tok = gw; tok < NTOK; tok += NGW) {
        const float L0 = LSE[((size_t)0 * NTOK + tok) * 16 + h], L1 = LSE[((size_t)1 * NTOK + tok) * 16 + h], L2 = LSE[((size_t)2 * NTOK + tok) * 16 + h];
        const float M = fmaxf(L0, fmaxf(L1, L2));
        float w0 = exp2f(L0 - M), w1 = exp2f(L1 - M), w2 = exp2f(L2 - M); const float inv = 1.0f / (w0 + w1 + w2); w0 *= inv; w1 *= inv; w2 *= inv;
        u32x4 o8;
#pragma unroll
        for (int c = 0; c < 2; ++c) {
            const size_t off = (size_t)tok * DM + lane * 16 + c * 8;
            const u32x4 a = *(const u32x4*)(OG + off), b = *(const u32x4*)(OG + (size_t)NTOK * DM + off), d = *(const u32x4*)(OG + (size_t)2 * NTOK * DM + off);
            float f[8];
#pragma unroll
            for (int i = 0; i < 4; ++i) { f[2 * i] = w0 * bflo(a[i]) + w1 * bflo(b[i]) + w2 * bflo(d[i]); f[2 * i + 1] = w0 * bfhi(a[i]) + w1 * bfhi(b[i]) + w2 * bfhi(d[i]); }
            o8[2 * c] = pk_fp8x4(f[0], f[1], f[2], f[3]); o8[2 * c + 1] = pk_fp8x4(f[4], f[5], f[6], f[7]);
        }
        *(u32x4*)((unsigned char*)O + (size_t)tok * DM + lane * 16) = o8;
    }
}

template <int N, int MASK>
__device__ __forceinline__ void halve_step(float (&v)[64], int lane) {
    const bool up = (lane & MASK) != 0;
#pragma unroll
    for (int i = 0; i < N / 2; ++i) { const float keep = up ? v[i + N / 2] : v[i], send = up ? v[i] : v[i + N / 2]; v[i] = keep + __shfl_xor(send, MASK); }
}
__device__ __forceinline__ void moe_router(const Ctx& C, const float* gain, const float* router) {
    const bf16_t* X = WSP(bf16_t, WS_XB);
    LAS float* grt = (LAS float*)C.lds;
    LAS int* tE = (LAS int*)(C.lds + 32768); LAS float* tG0 = (LAS float*)(C.lds + 32768 + 256); LAS float* tG1 = (LAS float*)(C.lds + 32768 + 512);
    for (int i = C.tid; i < 8192; i += 512) { const int k = i >> 3, e = i & 7; grt[e * 1024 + k] = gain[k] * router[i]; }
    __syncthreads();
    int* gE = WSP(int, WS_TOK + TOK_E); float* gG0 = WSP(float, WS_TOK + TOK_G0); float* gG1 = WSP(float, WS_TOK + TOK_G1); int* gR = WSP(int, WS_TOK + TOK_RANK); int* hist = WSP(int, WS_TOK + TOK_HIST);
    const int lane = C.lane;
    for (int chunk = C.bid; chunk < NTOK / 64; chunk += C.G) {
        float v[64]; float sv[64];
        u32x2 raw[8][4];
#pragma unroll
        for (int j = 0; j < 8; ++j) { const u32x2* xr = (const u32x2*)(X + (size_t)(chunk * 64 + C.wave * 8 + j) * DM) + lane;
#pragma unroll
            for (int jj = 0; jj < 4; ++jj) raw[j][jj] = xr[64 * jj]; }
        asm volatile("" ::: "memory");
#pragma unroll
        for (int j = 0; j < 8; ++j) {
            f32x4 x[4]; float ss = 0.f;
#pragma unroll
            for (int jj = 0; jj < 4; ++jj) { const u32x2 w = raw[j][jj]; x[jj] = (f32x4){bflo(w.x), bfhi(w.x), bflo(w.y), bfhi(w.y)}; ss += (x[jj][0] * x[jj][0] + x[jj][1] * x[jj][1]) + (x[jj][2] * x[jj][2] + x[jj][3] * x[jj][3]); }
            sv[j] = ss;
#pragma unroll
            for (int e = 0; e < 8; ++e) { float a = 0.f;
#pragma unroll
                for (int jj = 0; jj < 4; ++jj) { const f32x4 w = *(const LAS f32x4*)(grt + e * 1024 + (64 * jj + lane) * 4); a += x[jj][0] * w[0]; a += x[jj][1] * w[1]; a += x[jj][2] * w[2]; a += x[jj][3] * w[3]; }
                v[j * 8 + e] = a; }
        }
        halve_step<64, 32>(v, lane); halve_step<32, 16>(v, lane); halve_step<16, 8>(v, lane); halve_step<8, 4>(v, lane); halve_step<4, 2>(v, lane); halve_step<2, 1>(v, lane);
        halve_step<8, 32>(sv, lane); halve_step<4, 16>(sv, lane); halve_step<2, 8>(sv, lane);
        float ss = sv[0]; ss += __shfl_xor(ss, 1); ss += __shfl_xor(ss, 2); ss += __shfl_xor(ss, 4);
        const float rstd = 1.0f / sqrtf(ss * (1.0f / 1024.0f) + NORM_EPS);
        const float val = v[0]; const int idx = lane & 7;
        float v0 = val; int e0 = idx;
#pragma unroll
        for (int o = 1; o < 8; o <<= 1) { const float ov = __shfl_xor(v0, o); const int oi = __shfl_xor(e0, o); if (ov > v0 || (ov == v0 && oi < e0)) { v0 = ov; e0 = oi; } }
        float v1 = (idx == e0) ? -INFINITY : val; int e1 = idx;
#pragma unroll
        for (int o = 1; o < 8; o <<= 1) { const float ov = __shfl_xor(v1, o); const int oi = __shfl_xor(e1, o); if (ov > v1 || (ov == v1 && oi < e1)) { v1 = ov; e1 = oi; } }
        const float ex = expf((v1 - v0) * rstd), g0 = 1.0f / (1.0f + ex), g1 = ex / (1.0f + ex);
        if (idx == 0) { const int tl = C.wave * 8 + (lane >> 3); tE[tl] = e0 | (e1 << 8); tG0[tl] = g0; tG1[tl] = g1; }
        __syncthreads();
        if (C.wave == 0) {
            const int ee = tE[C.lane], f0 = ee & 255, f1 = ee >> 8; int r0 = 0, r1 = 0;
            const unsigned long long lt = (1ull << C.lane) - 1ull;
#pragma unroll
            for (int e = 0; e < 8; ++e) {
                const unsigned long long b0 = __ballot(f0 == e), b1 = __ballot(f1 == e);
                const int before = __popcll(b0 & lt) + __popcll(b1 & lt);
                if (f0 == e) r0 = before; if (f1 == e) r1 = before;
                if (C.lane == 0) hist[chunk * 8 + e] = __popcll(b0) + __popcll(b1);
            }
            const int tok = chunk * 64 + C.lane;
            gE[tok] = ee; gG0[tok] = tG0[C.lane]; gG1[tok] = tG1[C.lane]; gR[tok] = r0 | (r1 << 16);
        }
        __syncthreads();
    }
}
__device__ __forceinline__ void moe_gather(const Ctx& C) {
    const bf16_t* X = WSP(bf16_t, WS_XB); unsigned char* XBUF = WSP(unsigned char, WS_BIG + BIG_XBUF);
    const int* gE = WSP(int, WS_TOK + TOK_E); const int* gR = WSP(int, WS_TOK + TOK_RANK); const int* hist = WSP(int, WS_TOK + TOK_HIST);
    int* gD0 = WSP(int, WS_TOK + TOK_D0); int* gD1 = WSP(int, WS_TOK + TOK_D1); int* pendg = WSP(int, WS_TOK + TOK_PEND);
    LAS int* pre = (LAS int*)C.lds;
    LAS int* tot = (LAS int*)(C.lds + 8192);
    {
        const int e = C.wave; int h4[4]; int s = 0;
#pragma unroll
        for (int i = 0; i < 4; ++i) { h4[i] = hist[(4 * C.lane + i) * 8 + e]; s += h4[i]; }
        int inc = s;
#pragma unroll
        for (int o = 1; o < 64; o <<= 1) { const int t = __shfl_up(inc, o); if (C.lane >= o) inc += t; }
        int ex = inc - s;
#pragma unroll
        for (int i = 0; i < 4; ++i) { pre[(4 * C.lane + i) * 8 + e] = ex; ex += h4[i]; }
        if (C.lane == 63) tot[e] = inc;
    }
    __syncthreads();
    if (C.tid == 0) { int p = 0; for (int e = 0; e < 8; ++e) { tot[8 + e] = p; p += ((tot[e] + 255) >> 8) << 8; tot[16 + e] = p; } }
    __syncthreads();
    if (C.bid == 0 && C.tid < 8) pendg[C.tid] = tot[16 + C.tid];
    if (C.bid == 0 && C.tid == 8) pendg[8] = tot[23] >> 8;
    for (int chunk = C.bid; chunk < NTOK / 64; chunk += C.G) {
        for (int tl = C.wave * 8; tl < C.wave * 8 + 8; ++tl) {
            const int tok = chunk * 64 + tl;
            const int ee = gE[tok], e0 = ee & 255, e1 = ee >> 8, rr = gR[tok];
            const int d0 = tot[8 + e0] + pre[chunk * 8 + e0] + (rr & 0xffff), d1 = tot[8 + e1] + pre[chunk * 8 + e1] + (rr >> 16);
            if (C.lane == 0) { gD0[tok] = d0; gD1[tok] = d1; }
            const u32x2* xr = (const u32x2*)(X + (size_t)tok * DM) + C.lane;
            f32x4 v[4]; float ss = 0.f;
#pragma unroll
            for (int j = 0; j < 4; ++j) { const u32x2 w = xr[64 * j]; v[j] = (f32x4){bflo(w.x), bfhi(w.x), bflo(w.y), bfhi(w.y)}; ss += (v[j][0] * v[j][0] + v[j][1] * v[j][1]) + (v[j][2] * v[j][2] + v[j][3] * v[j][3]); }
            const float rstd = 1.0f / sqrtf(wave_sum(ss) * (1.0f / 1024.0f) + NORM_EPS);
            unsigned* o0 = (unsigned*)(XBUF + (size_t)d0 * DM) + C.lane; unsigned* o1 = (unsigned*)(XBUF + (size_t)d1 * DM) + C.lane;
#pragma unroll
            for (int j = 0; j < 4; ++j) { const unsigned w = pk_fp8x4(v[j][0] * rstd, v[j][1] * rstd, v[j][2] * rstd, v[j][3] * rstd); o0[64 * j] = w; o1[64 * j] = w; }
        }
    }
    if (C.bid < 8) {
        const int e = C.bid, r0 = tot[8 + e] + tot[e], r1 = tot[16 + e];
        for (int i = C.tid; i < (r1 - r0) * 64; i += 512) *((u32x4*)(XBUF + (size_t)r0 * DM) + i) = (u32x4){0u, 0u, 0u, 0u};
    }
}
template <bool FINAL>
__device__ __forceinline__ void moe_combine(const Ctx& C, const float* gfinal) {
    bf16_t* XB = WSP(bf16_t, WS_XB); float* ssq = WSP(float, WS_SSQ); const bf16_t* Y = WSP(bf16_t, WS_BIG + BIG_YBUF);
    const float* gG0 = WSP(float, WS_TOK + TOK_G0); const float* gG1 = WSP(float, WS_TOK + TOK_G1); const int* gD0 = WSP(int, WS_TOK + TOK_D0); const int* gD1 = WSP(int, WS_TOK + TOK_D1);
    const int gw = C.bid * 8 + C.wave, NGW = C.G * 8;
    for (int tok = gw; tok < NTOK; tok += NGW) {
        const float g0 = gG0[tok], g1 = gG1[tok]; const int d0 = gD0[tok], d1 = gD1[tok];
        const u32x2* xr = (const u32x2*)(XB + (size_t)tok * DM) + C.lane;
        const u32x2* y0 = (const u32x2*)(Y + (size_t)d0 * DM) + C.lane; const u32x2* y1 = (const u32x2*)(Y + (size_t)d1 * DM) + C.lane;
        f32x4 v[4]; float ss = 0.f;
#pragma unroll
        for (int j = 0; j < 4; ++j) { const u32x2 xw = xr[64 * j]; const f32x4 x = (f32x4){bflo(xw.x), bfhi(xw.x), bflo(xw.y), bfhi(xw.y)}; const u32x2 a = y0[64 * j], b = y1[64 * j];
            v[j][0] = x[0] + g0 * bflo(a.x) + g1 * bflo(b.x); v[j][1] = x[1] + g0 * bfhi(a.x) + g1 * bfhi(b.x);
            v[j][2] = x[2] + g0 * bflo(a.y) + g1 * bflo(b.y); v[j][3] = x[3] + g0 * bfhi(a.y) + g1 * bfhi(b.y);
            ss += (v[j][0] * v[j][0] + v[j][1] * v[j][1]) + (v[j][2] * v[j][2] + v[j][3] * v[j][3]); }
        const float tot = wave_sum(ss);
        if (FINAL) {
            const float rstd = 1.0f / sqrtf(tot * (1.0f / 1024.0f) + NORM_EPS);
            f32x4* o = (f32x4*)(C.out + (size_t)tok * DM) + C.lane; const f32x4* gf = (const f32x4*)gfinal + C.lane;
#pragma unroll
            for (int j = 0; j < 4; ++j) { const f32x4 g = gf[64 * j]; o[64 * j] = v[j] * rstd * g; }
        } else {
            u32x2* bo = (u32x2*)(XB + (size_t)tok * DM) + C.lane; unsigned* b8 = (unsigned*)(WSP(unsigned char, WS_X8) + (size_t)tok * DM) + C.lane;
#pragma unroll
            for (int j = 0; j < 4; ++j) { u32x2 w; w.x = pk2(v[j][0], v[j][1]); w.y = pk2(v[j][2], v[j][3]); bo[64 * j] = w; b8[64 * j] = pk_fp8x4(v[j][0], v[j][1], v[j][2], v[j][3]); }
            write_ssq_row(ssq, tok, tot, C.lane);
        }
    }
}

constexpr int RTAB_OFF = 134144, RTAB_UNITS = 13;
template <class Epi, bool FP8 = false>
__device__ __forceinline__ void dense_gemm(const Ctx& C, const bf16_t* A, const bf16_t* Bt, int M, int N, int K, const Epi& E, const float* ssq = nullptr, int sx = SC_ONE) {
    pg8::Gemm g{A, Bt, M, N, FP8 ? K / 2 : K, 0, SC_W8, sx}; pg8::StaticOrder S; S.init(M, N, C.G, C.bid);
    if (ssq) {
        LAS float* tab = (LAS float*)(C.lds + RTAB_OFF); pg8::Unit u;
        for (int i = C.tid >> 8; i < RTAB_UNITS && S.next(i, u); i += 2) tab[i * 256 + (C.tid & 255)] = pg8::row_rstd(ssq, u.pm * 256 + (C.tid & 255));
        __syncthreads();
    }
    pg8::gemm_phase<Epi, pg8::StaticOrder, FP8>(C.lds, g, S, E);
}
template <class Epi>
__device__ __forceinline__ void moe_gemm(const Ctx& C, const bf16_t* A, const bf16_t* Bt, int NC, int K, const Epi& E) {
    const int* pendg = WSP(int, WS_TOK + TOK_PEND);
    pg8::GroupedOrder S; S.NC = NC; S.G = C.G; S.c = C.bid;
#pragma unroll
    for (int e = 0; e < 8; ++e) S.pend[e] = __builtin_amdgcn_readfirstlane(pendg[e]);
    S.RT = __builtin_amdgcn_readfirstlane(pendg[8]);
    pg8::Gemm g{A, Bt, S.RT * 256, NC * 256, K / 2, 0, SC_W8, SC_ONE};
    pg8::gemm_phase<Epi, pg8::GroupedOrder, true>(C.lds, g, S, E);
}

constexpr int DOWN_NSL = 7, DOWN_SNT = 4;
__device__ __forceinline__ void moe_gemm_down(const Ctx& C, const bf16_t* A, const bf16_t* Bt, bf16_t* Y, float* part) {
    const int* pendg = WSP(int, WS_TOK + TOK_PEND);
    pg8::GroupedOrderK S; S.NC = 4; S.G = C.G; S.c = C.bid; S.NSL = DOWN_NSL; S.SNT = DOWN_SNT;
#pragma unroll
    for (int e = 0; e < 8; ++e) S.pend[e] = __builtin_amdgcn_readfirstlane(pendg[e]);
    S.RT = __builtin_amdgcn_readfirstlane(pendg[8]);
    const int full = 2 * C.G / 4, rtf = S.RT < full ? S.RT : full;
    pg8::Gemm g{A, Bt, S.RT * 256, 1024, FFE / 2, 0, SC_W8, SC_H8};
    pg8::EpiPlainK E{Y, DM, part, rtf, DOWN_NSL};
    pg8::gemm_phase<pg8::EpiPlainK, pg8::GroupedOrderK, true>(C.lds, g, S, E);
}
__device__ __forceinline__ void moe_down_reduce(const Ctx& C, bf16_t* Y, const float* part) {
    const int* pendg = WSP(int, WS_TOK + TOK_PEND);
    const int RT = pendg[8], full = 2 * C.G / 4, rtf = RT < full ? RT : full;
    const int nitems = (RT - rtf) * 256 * 128;
    for (int it = C.bid * 512 + C.tid; it < nitems; it += C.G * 512) {
        const int cg = it & 127, row = it >> 7, trel = row >> 8, lr = row & 255, ct = cg >> 5, lc = (cg & 31) * 8;
        const float* p = part + (size_t)((trel * 4 + ct) * DOWN_NSL) * 65536 + (size_t)lr * 256 + lc;
        f32x4 a = (f32x4){0.f, 0.f, 0.f, 0.f}, b = a;
#pragma unroll
        for (int ks = 0; ks < DOWN_NSL; ++ks) { a += *(const f32x4*)(p + (size_t)ks * 65536); b += *(const f32x4*)(p + (size_t)ks * 65536 + 4); }
        u32x4 w; w.x = pk2(a[0], a[1]); w.y = pk2(a[2], a[3]); w.z = pk2(b[0], b[1]); w.w = pk2(b[2], b[3]);
        *(u32x4*)(Y + (size_t)((rtf + trel) * 256 + lr) * DM + ct * 256 + lc) = w;
    }
}

constexpr int N_PHASES = 29;
struct Args { const void* in[39]; float* out; unsigned char* ws; int ph_lo, ph_hi; };

__global__ void __launch_bounds__(512, 2) fwd_kernel(Args args) {
    extern __shared__ __attribute__((aligned(16))) unsigned char lds_raw[];
    Ctx C0;
    C0.lds = (LAS unsigned char*)lds_raw; C0.ws = args.ws; C0.in = args.in; C0.out = args.out;
    C0.tid = threadIdx.x; C0.lane = C0.tid & 63; C0.wave = __builtin_amdgcn_readfirstlane(C0.tid >> 6); C0.G = gridDim.x; C0.bid = blockIdx.x;
    const Ctx& C = C0;
    volatile LAS unsigned* MISC = (volatile LAS unsigned*)(C.lds + MISC_OFF);
    for (int u = C.tid; u < (LDS_BYTES - RING_BYTES) / 4; u += 512) ((LAS unsigned*)(C.lds + RING_BYTES))[u] = 0u;
    __syncthreads();
    XcdBarrier bar; bar.bar = WSP(unsigned, WS_CTL) + CW_BAR; bar.x = 0; bar.st = nullptr;
    if (MK_SINGLE) bar = xcd_barrier_post(WSP(unsigned, WS_CTL) + CW_BAR, MISC + 8);
    const int lo = args.ph_lo, hi = args.ph_hi;
#define IN(k) (lo <= (k) && (k) < hi)
#define SEAM(k) do { if (IN(k) && IN((k) + 1)) xcd_barrier(bar); else __syncthreads(); } while (0)
#define PHASE(k, ...) if (IN(k)) { Ctx C = C0; { int t_ = (int)threadIdx.x; asm volatile("" : "+v"(t_)); C.tid = t_; C.lane = t_ & 63; } { __VA_ARGS__ } if (PROBE_PHASE == (k)) { xcd_barrier(bar); { __VA_ARGS__ } } } SEAM(k);

    const LAS float* const RTAB = (const LAS float*)(C.lds + RTAB_OFF);
    bf16_t* const XB = WSP(bf16_t, WS_XB); float* const SSQ = WSP(float, WS_SSQ); const float* const ROPE = WSP(float, WS_ROPE);
    bf16_t* const QKV = WSP(bf16_t, WS_BIG + BIG_QKV); bf16_t* const OB = WSP(bf16_t, WS_O); bf16_t* const HB = WSP(bf16_t, WS_BIG + BIG_H);
    bf16_t* const XBUF = WSP(bf16_t, WS_BIG + BIG_XBUF); bf16_t* const YBUF = WSP(bf16_t, WS_BIG + BIG_YBUF); bf16_t* const HBUF = WSP(bf16_t, WS_BIG + BIG_HBUF);

    PHASE(0, convert_weights_first(C); rope_table(C); x_to_bf16(C);)
    PHASE(1, pg8::EpiQKV E{QKV, NQKV_A, RTAB, ROPE, 3072, 2048, nullptr, (unsigned char*)QKV, 1}; dense_gemm<pg8::EpiQKV, true>(C, WSP(bf16_t, WS_X8), WSP(bf16_t, WS_WQKV0), NTOK, NQKV_A, DM, E, SSQ, SC_ONE);)
    PHASE(2, attn_A8(C);)
    PHASE(3, combine_A(C);)
    PHASE(4, pg8::EpiRes E{XB, SSQ, DM, nullptr}; dense_gemm<pg8::EpiRes, true>(C, OB, WSP(bf16_t, WS_WO0), NTOK, DM, DM, E, nullptr, SC_ONE);)
    PHASE(5, pg8::EpiSwiGLU E{HB, FF, RTAB}; dense_gemm(C, XB, WSP(bf16_t, WS_W13_0), NTOK, 2 * FF, DM, E, SSQ);)
    PHASE(6, pg8::EpiRes E{XB, SSQ, DM, nullptr}; dense_gemm(C, HB, WSP(bf16_t, WS_W2_0), NTOK, DM, FF, E);)
    PHASE(7, pg8::EpiQKV E{QKV, NQKV_B, RTAB, ROPE, 3072, 2048, nullptr, (unsigned char*)QKV}; dense_gemm(C, XB, WSP(bf16_t, WS_WQKV1), NTOK, NQKV_B, DM, E, SSQ);)
    PHASE(8, attn_B(C);)
    PHASE(9, pg8::EpiRes E{XB, SSQ, DM, nullptr}; dense_gemm(C, OB, WSP(bf16_t, WS_WO1), NTOK, DM, DM, E);)
    PHASE(10, moe_router(C, IN_F(17), IN_F(18));)
    PHASE(11, moe_gather(C);)
    PHASE(12, pg8::EpiSwiGLU8 E{(unsigned char*)HBUF, FFE}; moe_gemm(C, XBUF, WSP(bf16_t, WS_WM13), 2 * FFE / 256, DM, E);)
    PHASE(13, moe_gemm_down(C, HBUF, WSP(bf16_t, WS_WM2), YBUF, WSP(float, WS_BIG + BIG_XBUF));)
    PHASE(14, moe_down_reduce(C, YBUF, WSP(float, WS_BIG + BIG_XBUF)); xcd_barrier(bar); moe_combine<false>(C, nullptr); convert_weights_second(C);)
    PHASE(15, pg8::EpiQKV E{QKV, NQKV_C, RTAB, ROPE, 4096, 1152, nullptr, (unsigned char*)QKV}; dense_gemm<pg8::EpiQKV, true>(C, WSP(bf16_t, WS_X8), WSP(bf16_t, WS_WQKV2), NTOK, NQKV_C, DM, E, SSQ, SC_ONE);)
    PHASE(16, attn_C8(C);)
    PHASE(17, pg8::EpiRes E{XB, SSQ, DM, WSP(unsigned char, WS_X8)}; dense_gemm<pg8::EpiRes, true>(C, OB, WSP(bf16_t, WS_WO2), NTOK, DM, DM, E, nullptr, SC_ONE);)
    PHASE(18, pg8::EpiSwiGLU E{HB, FF, RTAB}; dense_gemm<pg8::EpiSwiGLU, true>(C, WSP(bf16_t, WS_X8), WSP(bf16_t, WS_W13_2), NTOK, 2 * FF, DM, E, SSQ, SC_ONE);)
    PHASE(19, pg8::EpiRes E{XB, SSQ, DM, WSP(unsigned char, WS_X8)}; dense_gemm(C, HB, WSP(bf16_t, WS_W2_2), NTOK, DM, FF, E);)
    PHASE(20, pg8::EpiQKV E{QKV, NQKV_A, RTAB, ROPE, 3072, 2048, nullptr, (unsigned char*)QKV, 1}; dense_gemm<pg8::EpiQKV, true>(C, WSP(bf16_t, WS_X8), WSP(bf16_t, WS_WQKV3), NTOK, NQKV_A, DM, E, SSQ, SC_ONE);)
    PHASE(21, attn_A8(C);)
    PHASE(22, combine_A(C);)
    PHASE(23, pg8::EpiRes E{XB, SSQ, DM, nullptr}; dense_gemm<pg8::EpiRes, true>(C, OB, WSP(bf16_t, WS_WO3), NTOK, DM, DM, E, nullptr, SC_ONE);)
    PHASE(24, moe_router(C, IN_F(33), IN_F(34));)
    PHASE(25, moe_gather(C);)
    PHASE(26, pg8::EpiSwiGLU8 E{(unsigned char*)HBUF, FFE}; moe_gemm(C, XBUF, WSP(bf16_t, WS_WM13), 2 * FFE / 256, DM, E);)
    PHASE(27, moe_gemm_down(C, HBUF, WSP(bf16_t, WS_WM2), YBUF, WSP(float, WS_BIG + BIG_XBUF));)
    if (IN(28)) { Ctx C = C0; { int t_ = (int)threadIdx.x; asm volatile("" : "+v"(t_)); C.tid = t_; C.lane = t_ & 63; } moe_down_reduce(C, YBUF, WSP(float, WS_BIG + BIG_XBUF)); xcd_barrier(bar); moe_combine<true>(C, IN_F(38)); }
#undef IN
#undef SEAM
#undef PHASE
}

extern "C" void kernel_launch(void* const* d_in, const int* in_sizes, int n_in, void* d_out, int out_size, void* d_ws, size_t ws_size, hipStream_t stream) {
    static int grid = 0;
    if (grid == 0) {
        if (n_in != 39 || out_size != NTOK * DM || ws_size < WS_END) { fprintf(stderr, "kernel_launch: unexpected shapes (n_in %d out %d ws %zu)\n", n_in, out_size, ws_size); grid = -1; return; }
        int dev = 0, cus = 0, per_cu = 0;
        if (hipGetDevice(&dev) != hipSuccess || hipDeviceGetAttribute(&cus, hipDeviceAttributeMultiprocessorCount, dev) != hipSuccess) { grid = -1; return; }
        if (hipFuncSetAttribute((const void*)fwd_kernel, hipFuncAttributeMaxDynamicSharedMemorySize, LDS_BYTES) != hipSuccess) { grid = -1; return; }
        if (hipOccupancyMaxActiveBlocksPerMultiprocessor(&per_cu, (const void*)fwd_kernel, 512, LDS_BYTES) != hipSuccess || per_cu < 1) { fprintf(stderr, "kernel_launch: occupancy query says %d\n", per_cu); }
        (void)hipGetLastError();
        grid = cus;
    }
    if (grid < 0) return;
    if (hipMemsetAsync((char*)d_ws + WS_CTL, 0, CTL_ZERO_BYTES, stream) != hipSuccess) return;
    Args a{};
    for (int i = 0; i < 39; ++i) a.in[i] = d_in[i];
    a.out = (float*)d_out; a.ws = (unsigned char*)d_ws;
#if MK_SINGLE
    a.ph_lo = 0; a.ph_hi = N_PHASES;
    hipLaunchKernelGGL(fwd_kernel, dim3(grid), dim3(512), LDS_BYTES, stream, a);
#else
    for (int p = 0; p < N_PHASES; ++p) { a.ph_lo = p; a.ph_hi = p + 1; hipLaunchKernelGGL(fwd_kernel, dim3(grid), dim3(512), LDS_BYTES, stream, a); }
#endif
}
```

```cpp
#include <hip/hip_runtime.h>
#include <cstdio>
#include <cstdint>
#include <cmath>

#ifndef MK_SINGLE
#define MK_SINGLE 1
#endif
#ifndef PROBE_PHASE
#define PROBE_PHASE -1
#endif

#define LAS __attribute__((address_space(3)))
#define GAS __attribute__((address_space(1)))
typedef unsigned short bf16_t;
typedef short bf16x8 __attribute__((ext_vector_type(8)));
typedef float f32x4 __attribute__((ext_vector_type(4)));
typedef float f32x2 __attribute__((ext_vector_type(2)));
typedef unsigned u32x4 __attribute__((ext_vector_type(4)));
typedef unsigned u32x2 __attribute__((ext_vector_type(2)));

constexpr int NTOK = 16384, SEQ = 8192, DM = 1024;
constexpr int NQKV_A = 9216, NQKV_B = 3072, NQKV_C = 1280;
constexpr int FF = 2816, FFE = 3584, NEXP = 8;
constexpr int MOE_ROWS = 32768 + 2048;
constexpr float LOG2E = 1.4426950408889634f;
constexpr float C2 = 0.125f * 1.4426950408889634f;
constexpr float NORM_EPS = 1e-6f, SUBLN_EPS = 1e-5f;
constexpr float LAMBDA_INIT = 0.35550906759096926f;

constexpr size_t MiB = 1u << 20;
constexpr size_t WS_CTL = 0, CTL_ZERO_BYTES = 1 * MiB;
constexpr size_t WS_ROPE = 1 * MiB;
constexpr size_t WS_SSQ = 2 * MiB;
constexpr size_t WS_TOK = 3 * MiB;
constexpr size_t WS_LSE = 4 * MiB;
constexpr size_t WS_WQKV0 = 8 * MiB, WS_WO0 = 26 * MiB, WS_W13_0 = 28 * MiB, WS_W2_0 = 39 * MiB;
constexpr size_t WS_WQKV1 = 45 * MiB, WS_WO1 = 51 * MiB;
constexpr size_t WS_WQKV2 = 53 * MiB, WS_WO2 = 56 * MiB, WS_W13_2 = 58 * MiB, WS_W2_2 = 69 * MiB;
constexpr size_t WS_WQKV3 = 75 * MiB, WS_WO3 = 93 * MiB;
constexpr size_t WS_WM13 = 96 * MiB, WS_WM2 = 208 * MiB;
constexpr size_t WS_X = 264 * MiB, WS_XB = 328 * MiB, WS_O = 360 * MiB, WS_BIG = 392 * MiB, WS_END = 776 * MiB;
constexpr size_t WS_VT8 = WS_X + 16 * MiB;
constexpr size_t WS_X8 = WS_X;
constexpr size_t BIG_QKV = 0, BIG_OG = 288 * MiB, BIG_H = 0, BIG_XBUF = 0, BIG_YBUF = 68 * MiB, BIG_HBUF = 136 * MiB;
constexpr size_t TOK_E = 0, TOK_G0 = 64 * 1024, TOK_G1 = 128 * 1024, TOK_RANK = 192 * 1024, TOK_D0 = 256 * 1024, TOK_D1 = 320 * 1024, TOK_HIST = 512 * 1024, TOK_PEND = 600 * 1024;
constexpr int CW_BAR = 4096;

constexpr int RING_BYTES = 131072;
constexpr int MISC_OFF = RING_BYTES + 320;
constexpr int LDS_BYTES = 147456;

__device__ __forceinline__ unsigned f2bf(float f) { unsigned u = __builtin_bit_cast(unsigned, f); return (u + 0x7fffu + ((u >> 16) & 1u)) >> 16; }
__device__ __forceinline__ unsigned pk2(float lo, float hi) { return f2bf(lo) | (f2bf(hi) << 16); }
__device__ __forceinline__ float bf2f(unsigned short b) { return __builtin_bit_cast(float, (unsigned)b << 16); }
__device__ __forceinline__ float bflo(unsigned w) { return __builtin_bit_cast(float, w << 16); }
__device__ __forceinline__ float bfhi(unsigned w) { return __builtin_bit_cast(float, w & 0xffff0000u); }
__device__ __forceinline__ float wave_sum(float v) {
#pragma unroll
    for (int o = 1; o < 64; o <<= 1) v += __shfl_xor(v, o);
    return v;
}
__device__ __forceinline__ float wave_max(float v) {
#pragma unroll
    for (int o = 1; o < 64; o <<= 1) v = fmaxf(v, __shfl_xor(v, o));
    return v;
}
#define LDS_WAIT() asm volatile("s_waitcnt lgkmcnt(0)" ::: "memory")
__device__ __forceinline__ unsigned pk_fp8x4(float a, float b, float c, float d) {
    a = fminf(fmaxf(a, -448.f), 448.f); b = fminf(fmaxf(b, -448.f), 448.f); c = fminf(fmaxf(c, -448.f), 448.f); d = fminf(fmaxf(d, -448.f), 448.f);
    int p = __builtin_bit_cast(int, a); p = __builtin_amdgcn_cvt_pk_fp8_f32(a, b, p, false); p = __builtin_amdgcn_cvt_pk_fp8_f32(c, d, p, true); return (unsigned)p;
}
__device__ __forceinline__ unsigned pk_fp8x4_nc(float a, float b, float c, float d) {
    int p; asm volatile("" : "=v"(p));
    p = __builtin_amdgcn_cvt_pk_fp8_f32(a, b, p, false); p = __builtin_amdgcn_cvt_pk_fp8_f32(c, d, p, true); return (unsigned)p;
}
__device__ __forceinline__ unsigned char fp8_byte(float x) { x = fminf(fmaxf(x, -448.f), 448.f); return (unsigned char)__builtin_amdgcn_cvt_pk_fp8_f32(x, x, 0, false); }
constexpr float W8_SCALE = 64.0f, H8_SCALE = 8.0f;
constexpr int SC_ONE = 0x7f7f7f7f, SC_W8 = 0x79797979, SC_H8 = 0x7c7c7c7c;

namespace pg8 {
#define PG8_LAS __attribute__((address_space(3)))
constexpr int BM = 256, BK = 64, HALF = 128, HTB = HALF * BK * 2, STAGE_BYTES = 8 * HTB, NXCD = 8, WGM = 8;

__host__ __device__ __forceinline__ int lds_byte(int r, int c) { const int st = (r >> 4) * 2 + (c >> 5), rr = r & 15, cc = c & 31, ob = rr * 64 + cc * 2; return st * 1024 + (ob ^ (((ob >> 9) & 1) << 5)); }
__host__ __device__ __forceinline__ void stage_rc(int b, int& R, int& C) { const int st = b / 1024, sb = b % 1024, swz = sb ^ (((sb >> 9) & 1) << 5); R = (st >> 1) * 16 + swz / 64; C = (st & 1) * 32 + (swz % 64) / 2; }
__host__ __device__ __forceinline__ int perm32(int rho) { const int n = rho >> 4, i = rho & 15; return 8 * (i >> 2) + 4 * n + (i & 3); }

__device__ __forceinline__ void glds16s(unsigned voff, unsigned long long sbase, unsigned lds_dst) { unsigned keep;
    asm volatile("s_mov_b32 %0, m0\n\ts_mov_b32 m0, %2\n\ts_nop 0\n\tglobal_load_lds_dwordx4 %1, %3\n\ts_mov_b32 m0, %0" : "=&s"(keep) : "v"(voff), "s"(lds_dst), "s"(sbase) : "memory"); }
struct Unit { int pm, pn, pc, koff, nt, mode; };
struct Gemm { const bf16_t* A; const bf16_t* Bt; int M, N, K, ld, sw, sx; };

struct StaticOrder {
    int nM, nN, nwg, G, c;
    __host__ __device__ void init(int M, int N, int G_, int c_) { nM = M / BM; nN = N / BM; nwg = nM * nN; G = G_; c = c_; }
    __host__ __device__ bool next(int i, Unit& u) const {
        const long L = (long)i * G + c; if (L >= nwg) return false;
        int wgid = (int)L; { const int q = nwg / NXCD, r = nwg % NXCD, xcd = wgid % NXCD, off = wgid / NXCD; wgid = (xcd < r ? xcd * (q + 1) : r * (q + 1) + (xcd - r) * q) + off; }
        const int nig = WGM * nN, gid = wgid / nig, fm = gid * WGM, gsz = (nM - fm) < WGM ? (nM - fm) : WGM;
        u.pm = fm + ((wgid % nig) % gsz); u.pn = (wgid % nig) / gsz; u.pc = u.pn; u.koff = 0; u.nt = 0; u.mode = 0; return true;
    }
};
struct GroupedOrder {
    int RT, NC, G, c; int pend[8];
    __device__ bool next(int i, Unit& u) const {
        const long L = (G % 8 == 0) ? ((long)(i * 8 + (c & 7)) * (G >> 3) + (c >> 3)) : ((long)i * G + c);
        if (L >= (long)RT * NC) return false;
        const int per = 8 * NC, blk = (int)(L / per), rem = (int)(L % per), rows = (RT - 8 * blk) < 8 ? (RT - 8 * blk) : 8;
        const int ct = rem / rows, rt = 8 * blk + rem % rows;
        int e = 0;
#pragma unroll
        for (int k = 0; k < 7; ++k) e += (rt * 256 >= pend[k]) ? 1 : 0;
        u.pm = rt; u.pn = e * NC + ct; u.pc = ct; u.koff = 0; u.nt = 0; u.mode = 0; return true;
    }
};
struct GroupedOrderK {
    int RT, NC, G, c, NSL, SNT; int pend[8];
    __device__ bool next(int i, Unit& u) const {
        const long L = (long)(i * 8 + (c & 7)) * (G >> 3) + (c >> 3);
        const int full = 2 * G / NC, RTF = RT < full ? RT : full;
        int rt, ct; u.koff = 0; u.nt = 0; u.mode = 0;
        if (L < (long)RTF * NC) {
            const int per = 8 * NC, blk = (int)(L / per), rem = (int)(L % per), rows = (RTF - 8 * blk) < 8 ? (RTF - 8 * blk) : 8;
            ct = rem / rows; rt = 8 * blk + rem % rows;
        } else {
            const long idx = L - (long)RTF * NC; if (idx >= (long)(RT - RTF) * NC * NSL) return false;
            const int su = (int)(idx / NSL), ks = (int)(idx % NSL);
            rt = RTF + su / NC; ct = su % NC; u.koff = ks * SNT * BK * 2; u.nt = SNT; u.mode = 1 + ks;
        }
        int e = 0;
#pragma unroll
        for (int k = 0; k < 7; ++k) e += (rt * 256 >= pend[k]) ? 1 : 0;
        u.pm = rt; u.pn = e * NC + ct; u.pc = ct; return true;
    }
};

typedef __bf16 bf16x2v __attribute__((ext_vector_type(2)));
__device__ __forceinline__ unsigned cvt_pk_bf16(float lo, float hi) { f32x2 v = {lo, hi}; bf16x2v b = __builtin_convertvector(v, bf16x2v); return __builtin_bit_cast(unsigned, b); }

__device__ __forceinline__ float row_rstd(const float* ssq, int row) {
    const f32x4* sp = (const f32x4*)(ssq + (size_t)row * 16);
    const f32x4 a = sp[0], b = sp[1], c = sp[2], d = sp[3];
    const float s = ((a[0] + a[1]) + (a[2] + a[3])) + ((b[0] + b[1]) + (b[2] + b[3])) + ((c[0] + c[1]) + (c[2] + c[3])) + ((d[0] + d[1]) + (d[2] + d[3]));
    return 1.0f / sqrtf(s * (1.0f / 1024.0f) + 1e-6f);
}
struct EpiQKV {
    static constexpr bool PERM = true;
    bf16_t* O; int ldc; const PG8_LAS float* rtab; const float* rope; int ropeMod, ropeLim; unsigned char* vt8; unsigned char* o8; int hm;
    __device__ __forceinline__ void operator()(const f32x4 (&acc)[2][2][4][2], const Unit& u, int ui, int wr, int wc, int fr, int fq) const {
        const int row0 = u.pm * BM + wr * 64 + fr;
        const int colh = wc * 32 + 8 * fq;
        const bool ropelane = ((wc & 1) == 0) && (fq < 2);
        const PG8_LAS float* rt = rtab + ui * 256 + wr * 64 + fr;
#pragma unroll
        for (int ai = 0; ai < 2; ++ai) {
            f32x4 cs[4], sn[4]; float rs[4];
#pragma unroll
            for (int m = 0; m < 4; ++m) {
                rs[m] = rt[ai * HALF + m * 16];
                cs[m] = (f32x4){1.f, 1.f, 1.f, 1.f}; sn[m] = (f32x4){0.f, 0.f, 0.f, 0.f};
                if (ropelane) { const float* rp = rope + (size_t)(row0 + ai * HALF + m * 16) * 16 + 4 * fq; cs[m] = *(const f32x4*)rp; sn[m] = *(const f32x4*)(rp + 8); }
            }
#pragma unroll
            for (int m = 0; m < 4; ++m) {
                const int row = row0 + ai * HALF + m * 16;
                const float r_ = rs[m]; const f32x4 c_ = cs[m], s_ = sn[m];
#pragma unroll
                for (int bj = 0; bj < 2; ++bj) {
                    const int colbase = u.pc * BM + bj * HALF;
                    f32x4 v0 = acc[ai][bj][m][0] * r_, v1 = acc[ai][bj][m][1] * r_;
                    if (ropelane && (colbase % ropeMod) < ropeLim) {
                        f32x4 w0, w1;
                        w0[0] = v0[0] * c_[0] - v0[1] * s_[0]; w0[1] = v0[1] * c_[0] + v0[0] * s_[0];
                        w0[2] = v0[2] * c_[1] - v0[3] * s_[1]; w0[3] = v0[3] * c_[1] + v0[2] * s_[1];
                        w1[0] = v1[0] * c_[2] - v1[1] * s_[2]; w1[1] = v1[1] * c_[2] + v1[0] * s_[2];
                        w1[2] = v1[2] * c_[3] - v1[3] * s_[3]; w1[3] = v1[3] * c_[3] + v1[2] * s_[3];
                        v0 = w0; v1 = w1;
                    }
                    if (o8) {
                        const float qs = ((colbase % 3072) < 1024) ? 16.0f : 1.0f;
                        u32x2 w8; w8.x = pk_fp8x4(v0[0] * qs, v0[1] * qs, v0[2] * qs, v0[3] * qs); w8.y = pk_fp8x4(v1[0] * qs, v1[1] * qs, v1[2] * qs, v1[3] * qs);
                        size_t off = (size_t)row * ldc + colbase + colh;
                        if (hm) { const int col = colbase + colh, blk = col >> 10, sh = 2 * ((blk * 11) >> 5), head = (col & 1023) >> 6, bb = row >> 13, t = row & (SEQ - 1);
                            off = (size_t)blk * ((size_t)NTOK * 1024) + (size_t)((bb * 16 + head) * SEQ + ((t & ((1 << sh) - 1)) << (13 - sh)) + (t >> sh)) * 64 + (col & 63); }
                        *(u32x2*)(o8 + off) = w8;
                    } else if (vt8 && colbase >= 2048) {
                        u32x2 w8; w8.x = pk_fp8x4(v0[0], v0[1], v0[2], v0[3]); w8.y = pk_fp8x4(v1[0], v1[1], v1[2], v1[3]);
                        *(u32x2*)(vt8 + (size_t)row * 1024 + (colbase - 2048) + colh) = w8;
                    } else {
                    u32x4 w; w.x = cvt_pk_bf16(v0[0], v0[1]); w.y = cvt_pk_bf16(v0[2], v0[3]); w.z = cvt_pk_bf16(v1[0], v1[1]); w.w = cvt_pk_bf16(v1[2], v1[3]);
                    *(u32x4*)(O + (size_t)row * ldc + colbase + colh) = w;
                    }
                }
            }
        }
    }
};
struct EpiSwiGLU {
    static constexpr bool PERM = true;
    bf16_t* O; int ldc; const PG8_LAS float* rtab;
    __device__ __forceinline__ void operator()(const f32x4 (&acc)[2][2][4][2], const Unit& u, int ui, int wr, int wc, int fr, int fq) const {
        const int row0 = u.pm * BM + wr * 64 + fr;
        const int col = u.pc * HALF + wc * 32 + 8 * fq;
#pragma unroll
        for (int ai = 0; ai < 2; ++ai)
#pragma unroll
            for (int m = 0; m < 4; ++m) {
                const int row = row0 + ai * HALF + m * 16;
                const float rs = rtab ? rtab[ui * 256 + wr * 64 + fr + ai * HALF + m * 16] : 1.0f;
                float h[8];
#pragma unroll
                for (int n = 0; n < 2; ++n)
#pragma unroll
                    for (int i = 0; i < 4; ++i) {
                        const float a = acc[ai][0][m][n][i] * rs, b = acc[ai][1][m][n][i] * rs;
                        h[n * 4 + i] = a * __builtin_amdgcn_rcpf(1.0f + __expf(-a)) * b;
                    }
                u32x4 w; w.x = cvt_pk_bf16(h[0], h[1]); w.y = cvt_pk_bf16(h[2], h[3]); w.z = cvt_pk_bf16(h[4], h[5]); w.w = cvt_pk_bf16(h[6], h[7]);
                *(u32x4*)(O + (size_t)row * ldc + col) = w;
            }
    }
};
struct EpiSwiGLU8 {
    static constexpr bool PERM = true;
    unsigned char* O; int ldc; const PG8_LAS float* rtab;
    __device__ __forceinline__ void operator()(const f32x4 (&acc)[2][2][4][2], const Unit& u, int ui, int wr, int wc, int fr, int fq) const {
        const int row0 = u.pm * BM + wr * 64 + fr;
        const int col = u.pc * HALF + wc * 32 + 8 * fq;
#pragma unroll
        for (int ai = 0; ai < 2; ++ai)
#pragma unroll
            for (int m = 0; m < 4; ++m) {
                const int row = row0 + ai * HALF + m * 16;
                const float rs = rtab ? rtab[ui * 256 + wr * 64 + fr + ai * HALF + m * 16] : 1.0f;
                float h[8];
#pragma unroll
                for (int n = 0; n < 2; ++n)
#pragma unroll
                    for (int i = 0; i < 4; ++i) { const float a = acc[ai][0][m][n][i] * rs, b = acc[ai][1][m][n][i] * rs; h[n * 4 + i] = a * __builtin_amdgcn_rcpf(1.0f + __expf(-a)) * b * H8_SCALE; }
                u32x2 w; w.x = pk_fp8x4(h[0], h[1], h[2], h[3]); w.y = pk_fp8x4(h[4], h[5], h[6], h[7]);
                *(u32x2*)(O + (size_t)row * ldc + col) = w;
            }
    }
};
struct EpiRes {
    static constexpr bool PERM = false;
    bf16_t* XB; float* ssq; int ldc; unsigned char* X8;
    __device__ __forceinline__ void operator()(const f32x4 (&acc)[2][2][4][2], const Unit& u, int ui, int wr, int wc, int fr, int fq) const {
        const int row0 = u.pm * BM + wr * 64 + fr;
        const int col0 = u.pc * BM + wc * 32 + 4 * fq;
#pragma unroll
        for (int ai = 0; ai < 2; ++ai) {
            u32x2 rv[4][2][2];
#pragma unroll
            for (int m = 0; m < 4; ++m)
#pragma unroll
                for (int bj = 0; bj < 2; ++bj)
#pragma unroll
                    for (int n = 0; n < 2; ++n) rv[m][bj][n] = *(const u32x2*)(XB + (size_t)(row0 + ai * HALF + m * 16) * ldc + col0 + bj * HALF + n * 16);
#pragma unroll
            for (int m = 0; m < 4; ++m) {
                const int row = row0 + ai * HALF + m * 16;
                float q = 0.f;
#pragma unroll
                for (int bj = 0; bj < 2; ++bj)
#pragma unroll
                    for (int n = 0; n < 2; ++n) {
                        const size_t off = (size_t)row * ldc + col0 + bj * HALF + n * 16;
                        const u32x2 rr = rv[m][bj][n]; const f32x4 a = acc[ai][bj][m][n];
                        const float v0 = bflo(rr.x) + a[0], v1 = bfhi(rr.x) + a[1], v2 = bflo(rr.y) + a[2], v3 = bfhi(rr.y) + a[3];
                        q += (v0 * v0 + v1 * v1) + (v2 * v2 + v3 * v3);
                        u32x2 w; w.x = cvt_pk_bf16(v0, v1); w.y = cvt_pk_bf16(v2, v3); *(u32x2*)(XB + off) = w;
                        if (X8) *(unsigned*)(X8 + off) = pk_fp8x4(v0, v1, v2, v3);
                    }
                q += __shfl_xor(q, 16); q += __shfl_xor(q, 32);
                if (fq == 0) ssq[(size_t)row * 16 + u.pc * 4 + wc] = q;
            }
        }
    }
};
struct EpiPlain {
    static constexpr bool PERM = true;
    bf16_t* O; int ldc;
    __device__ __forceinline__ void operator()(const f32x4 (&acc)[2][2][4][2], const Unit& u, int ui, int wr, int wc, int fr, int fq) const {
        const int row0 = u.pm * BM + wr * 64 + fr;
        const int col0 = u.pc * BM + wc * 32 + 8 * fq;
#pragma unroll
        for (int ai = 0; ai < 2; ++ai)
#pragma unroll
            for (int m = 0; m < 4; ++m) {
                bf16_t* rowp = O + (size_t)(row0 + ai * HALF + m * 16) * ldc + col0;
#pragma unroll
                for (int bj = 0; bj < 2; ++bj) {
                    const f32x4 v0 = acc[ai][bj][m][0], v1 = acc[ai][bj][m][1];
                    u32x4 w; w.x = cvt_pk_bf16(v0[0], v0[1]); w.y = cvt_pk_bf16(v0[2], v0[3]); w.z = cvt_pk_bf16(v1[0], v1[1]); w.w = cvt_pk_bf16(v1[2], v1[3]);
                    *(u32x4*)(rowp + bj * HALF) = w;
                }
            }
    }
};

struct EpiPlainK {
    static constexpr bool PERM = true;
    bf16_t* O; int ldc; float* part; int rtf, nsl;
    __device__ __forceinline__ void operator()(const f32x4 (&acc)[2][2][4][2], const Unit& u, int ui, int wr, int wc, int fr, int fq) const {
        if (u.mode == 0) {
            const int row0 = u.pm * BM + wr * 64 + fr; const int col0 = u.pc * BM + wc * 32 + 8 * fq;
#pragma unroll
            for (int ai = 0; ai < 2; ++ai)
#pragma unroll
                for (int m = 0; m < 4; ++m) {
                    bf16_t* rowp = O + (size_t)(row0 + ai * HALF + m * 16) * ldc + col0;
#pragma unroll
                    for (int bj = 0; bj < 2; ++bj) {
                        const f32x4 v0 = acc[ai][bj][m][0], v1 = acc[ai][bj][m][1];
                        u32x4 w; w.x = cvt_pk_bf16(v0[0], v0[1]); w.y = cvt_pk_bf16(v0[2], v0[3]); w.z = cvt_pk_bf16(v1[0], v1[1]); w.w = cvt_pk_bf16(v1[2], v1[3]);
                        *(u32x4*)(rowp + bj * HALF) = w;
                    }
                }
        } else {
            float* pb = part + (size_t)(((u.pm - rtf) * 4 + u.pc) * nsl + (u.mode - 1)) * 65536 + (size_t)(wr * 64 + fr) * 256 + wc * 32 + 8 * fq;
#pragma unroll
            for (int ai = 0; ai < 2; ++ai)
#pragma unroll
                for (int m = 0; m < 4; ++m)
#pragma unroll
                    for (int bj = 0; bj < 2; ++bj) { float* p = pb + (size_t)(ai * HALF + m * 16) * 256 + bj * HALF; *(f32x4*)p = acc[ai][bj][m][0]; *(f32x4*)(p + 4) = acc[ai][bj][m][1]; }
        }
    }
};

typedef int v8i_t __attribute__((ext_vector_type(8)));
typedef int v4i_t __attribute__((ext_vector_type(4)));
__device__ __forceinline__ v8i_t cat32(bf16x8 lo, bf16x8 hi) { const v4i_t a = __builtin_bit_cast(v4i_t, lo), b = __builtin_bit_cast(v4i_t, hi); return __builtin_shufflevector(a, b, 0, 1, 2, 3, 4, 5, 6, 7); }
template <class Epi, class Sched, bool FP8 = false>
__device__ __forceinline__ void gemm_phase(PG8_LAS unsigned char* lds, const Gemm g, const Sched& S, const Epi& E) {
    const int tid = threadIdx.x, wid = __builtin_amdgcn_readfirstlane(tid >> 6), lane = tid & 63, wr = wid >> 2, wc = wid & 3, fr = lane & 15, fq = lane >> 4;
    const int sw_ = g.sw, sx_ = g.sx;
    const int K = g.ld ? g.ld : g.K, ntd = g.K / BK;
    unsigned voffA[2], voffB[2];
#pragma unroll
    for (int i = 0; i < 2; ++i) { int R, C; stage_rc(tid * 16 + i * 8192, R, C); const int Rb = Epi::PERM ? ((R & ~31) + perm32(R & 31)) : R;
        voffA[i] = (unsigned)(R * K + C) * 2u; voffB[i] = (unsigned)(Rb * K + C) * 2u; }
    const size_t kstep = (size_t)(BK * 2);
    const size_t hstep = (size_t)HALF * K * 2;
    const size_t tstep = 2 * hstep;
    const unsigned ldsw = (unsigned)wid * 1024u; const unsigned ldsb = (unsigned)(uintptr_t)lds;
    const int aoff = lds_byte(wr * 64 + fr, fq * 8), boff = lds_byte(wc * 32 + fr, fq * 8);
#define PG8_SA(b, h) (((b) * 2 + (h)) * HTB)
#define PG8_SB(b, h) ((4 + (b) * 2 + (h)) * HTB)
#define PG8_STAGE(bufoff, gbase, voff) do { _Pragma("unroll") for (int _i = 0; _i < 2; ++_i) { \
        if constexpr (FP8) glds16s((voff)[_i], (unsigned long long)(gbase), (unsigned)__builtin_amdgcn_readfirstlane((int)(ldsb + (bufoff) + ldsw + _i * 8192))); \
        else __builtin_amdgcn_global_load_lds((const unsigned*)((const char*)(gbase) + (voff)[_i]), (PG8_LAS unsigned*)(lds + (bufoff) + ldsw + _i * 8192), 16, 0, 0); } } while (0)
#define PG8_LDA(dst, b, h) do { if constexpr (FP8) { _Pragma("unroll") for (int m = 0; m < 4; ++m) dst##8[m] = __builtin_shufflevector(*(const PG8_LAS v4i_t*)(lds + PG8_SA(b, h) + aoff + m * 2048), *(const PG8_LAS v4i_t*)(lds + PG8_SA(b, h) + aoff + m * 2048 + 1024), 0, 1, 2, 3, 4, 5, 6, 7); } \
        else { _Pragma("unroll") for (int m = 0; m < 4; ++m) _Pragma("unroll") for (int k = 0; k < 2; ++k) dst[m][k] = *(const PG8_LAS bf16x8*)(lds + PG8_SA(b, h) + aoff + m * 2048 + k * 1024); } } while (0)
#define PG8_LDB(dst, b, h) do { if constexpr (FP8) { _Pragma("unroll") for (int n = 0; n < 2; ++n) dst##8[n] = __builtin_shufflevector(*(const PG8_LAS v4i_t*)(lds + PG8_SB(b, h) + boff + n * 2048), *(const PG8_LAS v4i_t*)(lds + PG8_SB(b, h) + boff + n * 2048 + 1024), 0, 1, 2, 3, 4, 5, 6, 7); } \
        else { _Pragma("unroll") for (int n = 0; n < 2; ++n) _Pragma("unroll") for (int k = 0; k < 2; ++k) dst[n][k] = *(const PG8_LAS bf16x8*)(lds + PG8_SB(b, h) + boff + n * 2048 + k * 1024); } } while (0)
#define PG8_MMA(ai, bj, At, Bt) do { __builtin_amdgcn_s_setprio(1); \
        if constexpr (FP8) { _Pragma("unroll") for (int m = 0; m < 4; ++m) _Pragma("unroll") for (int n = 0; n < 2; ++n) \
            asm volatile("v_mfma_scale_f32_16x16x128_f8f6f4 %0, %1, %2, %0, %3, %4 op_sel_hi:[0,0,0]" : "+v"(acc[ai][bj][m][n]) : "v"(Bt##8[n]), "v"(At##8[m]), "v"(sw_), "v"(sx_)); } \
        else { _Pragma("unroll") for (int m = 0; m < 4; ++m) _Pragma("unroll") for (int n = 0; n < 2; ++n) _Pragma("unroll") for (int k = 0; k < 2; ++k) acc[ai][bj][m][n] = __builtin_amdgcn_mfma_f32_16x16x32_bf16(Bt[n][k], At[m][k], acc[ai][bj][m][n], 0, 0, 0); } \
        __builtin_amdgcn_s_setprio(0); } while (0)
#define PG8_WAIT_V(n) asm volatile("s_waitcnt vmcnt(" #n ")" ::: "memory")
#define PG8_WAIT_L(n) asm volatile("s_waitcnt lgkmcnt(" #n ")" ::: "memory")
#define PG8_BAR __builtin_amdgcn_s_barrier()
#define PG8_SCHED __builtin_amdgcn_sched_barrier(0)
    Unit cur, nxt; int ui = 0;
    if (!S.next(0, cur)) return;
    f32x4 acc[2][2][4][2];
#pragma unroll
    for (int a = 0; a < 2; ++a)
#pragma unroll
        for (int b = 0; b < 2; ++b)
#pragma unroll
            for (int m = 0; m < 4; ++m)
#pragma unroll
                for (int n = 0; n < 2; ++n) acc[a][b][m][n] = (f32x4){0.f, 0.f, 0.f, 0.f};
    bf16x8 At[4][2], B0[2][2], B1[2][2]; v8i_t At8[4], B08[2], B18[2];
    const char* cA = (const char*)g.A + (size_t)cur.pm * tstep + cur.koff; const char* cB = (const char*)g.Bt + (size_t)cur.pn * tstep + cur.koff;
    PG8_STAGE(PG8_SB(0, 0), cB, voffB); PG8_STAGE(PG8_SB(0, 1), cB + hstep, voffB); PG8_STAGE(PG8_SA(0, 0), cA, voffA); PG8_STAGE(PG8_SA(0, 1), cA + hstep, voffA);
    if (wr == 1) PG8_BAR;
    PG8_WAIT_V(2); PG8_BAR;
    PG8_STAGE(PG8_SB(1, 0), cB + kstep, voffB); PG8_STAGE(PG8_SA(1, 0), cA + kstep, voffA); PG8_STAGE(PG8_SB(1, 1), cB + hstep + kstep, voffB);
    PG8_WAIT_V(6); PG8_BAR;
    for (;;) {
        const bool has_next = S.next(ui + 1, nxt);
        const char* nA = has_next ? (const char*)g.A + (size_t)nxt.pm * tstep + nxt.koff : cA; const char* nB = has_next ? (const char*)g.Bt + (size_t)nxt.pn * tstep + nxt.koff : cB;
        const int nt = cur.nt ? cur.nt : ntd;
#pragma nounroll
        for (int t = 0; t < nt; t += 2) {
            const bool last = (t == nt - 2);
            const char* a1 = cA + (size_t)(t + 1) * kstep;
            const char* a2 = last ? nA : cA + (size_t)(t + 2) * kstep; const char* b2 = last ? nB : cB + (size_t)(t + 2) * kstep;
            const char* a3 = a2 + kstep; const char* b3 = b2 + kstep;
            PG8_LDB(B0, 0, 0); PG8_LDB(B1, 0, 1); PG8_SCHED; PG8_LDA(At, 0, 0); PG8_STAGE(PG8_SA(1, 1), a1 + hstep, voffA);
            PG8_WAIT_V(8); PG8_WAIT_L(0); PG8_BAR; PG8_MMA(0, 0, At, B0); PG8_MMA(0, 1, At, B1); PG8_BAR; PG8_SCHED;
            PG8_LDA(At, 0, 1); PG8_STAGE(PG8_SB(0, 0), b2, voffB); PG8_STAGE(PG8_SB(0, 1), b2 + hstep, voffB); PG8_STAGE(PG8_SA(0, 0), a2, voffA);
            PG8_WAIT_V(8); PG8_WAIT_L(0); PG8_BAR; PG8_MMA(1, 0, At, B0); PG8_MMA(1, 1, At, B1); PG8_BAR; PG8_SCHED;
            PG8_LDB(B0, 1, 0); PG8_LDB(B1, 1, 1); PG8_SCHED; PG8_LDA(At, 1, 0); PG8_STAGE(PG8_SA(0, 1), a2 + hstep, voffA);
            PG8_WAIT_V(8); PG8_WAIT_L(0); PG8_BAR; PG8_MMA(0, 0, At, B0); PG8_MMA(0, 1, At, B1); PG8_BAR; PG8_SCHED;
            PG8_LDA(At, 1, 1); PG8_STAGE(PG8_SB(1, 0), b3, voffB); PG8_STAGE(PG8_SB(1, 1), b3 + hstep, voffB); PG8_STAGE(PG8_SA(1, 0), a3, voffA);
            PG8_WAIT_V(8); PG8_WAIT_L(0); PG8_BAR; PG8_MMA(1, 0, At, B0); PG8_MMA(1, 1, At, B1); PG8_BAR; PG8_SCHED;
        }
        if (wr == 0) PG8_BAR;
        if constexpr (FP8) asm volatile("s_nop 15\n\ts_nop 15" ::: "memory");
        { int le_ = lane; asm volatile("" : "+v"(le_)); E(acc, cur, ui, wr, wc, le_ & 15, le_ >> 4); }
        if (!has_next) break;
#pragma unroll
        for (int a = 0; a < 2; ++a)
#pragma unroll
            for (int b = 0; b < 2; ++b)
#pragma unroll
                for (int m = 0; m < 4; ++m)
#pragma unroll
                    for (int n = 0; n < 2; ++n) acc[a][b][m][n] = (f32x4){0.f, 0.f, 0.f, 0.f};
        cur = nxt; cA = nA; cB = nB; ++ui;
        if (wr == 1) PG8_BAR;
    }
    PG8_WAIT_V(0);
    PG8_BAR;
#undef PG8_SA
#undef PG8_SB
#undef PG8_STAGE
#undef PG8_LDA
#undef PG8_LDB
#undef PG8_MMA
#undef PG8_WAIT_V
#undef PG8_WAIT_L
#undef PG8_BAR
#undef PG8_SCHED
}
}

#define XB_TMO      128
#define XB_XCNT(j)  (256  + 64 * (j))
#define XB_XSUB(j)  (1280 + 64 * (j))
#define XB_XGEN(j)  (2304 + 64 * (j))
#define XB_TOP      3328
#define XB_TOPGEN   3392
#define XCD_BAR_WORDS 3456
#define XB_SPIN_CAP (1u << 24)

__device__ __forceinline__ unsigned xb_ld(unsigned* p)              { return __hip_atomic_load(p, __ATOMIC_RELAXED, __HIP_MEMORY_SCOPE_AGENT); }
__device__ __forceinline__ unsigned xb_add(unsigned* p, unsigned v) { return __hip_atomic_fetch_add(p, v, __ATOMIC_RELAXED, __HIP_MEMORY_SCOPE_AGENT); }
__device__ __forceinline__ unsigned xb_xcc_id() { return (unsigned)__builtin_amdgcn_s_getreg((3 << 11) | 20) & 0xFu; }
#define XB_SPIN(cond, bar) do { unsigned _sp = 0; while (cond) { __builtin_amdgcn_s_sleep(1); \
    if ((++_sp & 255u) == 0u) { if (xb_ld(&(bar)[XB_TMO])) break; if (_sp > XB_SPIN_CAP) { atomicAdd(&(bar)[XB_TMO], 1u); break; } } } } while (0)

struct XcdBarrier { unsigned* bar; unsigned x; volatile LAS unsigned* st; };

__device__ __forceinline__ XcdBarrier xcd_barrier_post(unsigned* bar, volatile LAS unsigned* st) {
    XcdBarrier b; b.bar = bar; b.x = xb_xcc_id(); b.st = st;
    if (threadIdx.x == 0) (void)xb_add(&bar[XB_XCNT(b.x)], 1u);
    return b;
}
__device__ __forceinline__ void xcd_barrier_complete(unsigned* bar, unsigned x, unsigned& nloc, unsigned& nx) {
    const unsigned G = gridDim.x * gridDim.y * gridDim.z;
    unsigned sum, cnt, mine, sp = 0u;
    for (;;) {
        sum = 0u; cnt = 0u; mine = 0u;
#pragma unroll
        for (unsigned j = 0; j < 16; ++j) { const unsigned c = xb_ld(&bar[XB_XCNT(j)]); sum += c; cnt += (c > 0u) ? 1u : 0u; mine = (j == x) ? c : mine; }
        if (sum == G) break;
        __builtin_amdgcn_s_sleep(1);
        if ((++sp & 255u) == 0u) { if (xb_ld(&bar[XB_TMO])) break; if (sp > XB_SPIN_CAP) { atomicAdd(&bar[XB_TMO], 1u); break; } }
    }
    nloc = mine > 0u ? mine : 1u; nx = cnt > 0u ? cnt : 1u;
}
__device__ __forceinline__ void xcd_barrier(const XcdBarrier& b) {
    asm volatile("s_waitcnt vmcnt(0)" ::: "memory");
    __syncthreads();
    if (threadIdx.x == 0) {
        unsigned* bar = b.bar;
        __builtin_amdgcn_s_waitcnt(0);
        unsigned nloc = b.st[0], nx = b.st[1];
        if (nloc == 0u) { xcd_barrier_complete(bar, b.x, nloc, nx); b.st[0] = nloc; b.st[1] = nx; }
        const unsigned old = xb_add(&bar[XB_XSUB(b.x)], 1u);
        const unsigned gen = old / nloc;
        if (old + 1u == (gen + 1u) * nloc) {
            __builtin_amdgcn_fence(__ATOMIC_RELEASE, "agent");
            asm volatile("s_waitcnt vmcnt(0)" ::: "memory");
            const unsigned og = xb_add(&bar[XB_TOP], 1u);
            const unsigned tg = og / nx;
            if (og + 1u == (tg + 1u) * nx) xb_add(&bar[XB_TOPGEN], 1u);
            else XB_SPIN(xb_ld(&bar[XB_TOPGEN]) == tg, bar);
            __builtin_amdgcn_fence(__ATOMIC_ACQUIRE, "agent");
            xb_add(&bar[XB_XGEN(b.x)], 1u);
            asm volatile("s_waitcnt vmcnt(0)" ::: "memory");
        } else {
            XB_SPIN(xb_ld(&bar[XB_XGEN(b.x)]) == gen, bar);
            __builtin_amdgcn_fence(__ATOMIC_ACQUIRE, "agent");
            asm volatile("s_waitcnt vmcnt(0)" ::: "memory");
        }
    }
    __syncthreads();
}

struct Ctx {
    LAS unsigned char* lds;
    unsigned char* ws;
    const void* const* in;
    float* out;
    int tid, lane, wave, G, bid;
};
#define IN_F(i) ((const float*)C.in[i])
#define WSP(T, off) ((T*)(C.ws + (off)))

struct WJob { const float* W0; const float* W1; bf16_t* WT; const float* gain; int K, ldw, Nout, kind, nE, fp8; size_t sW, sWT; };
__device__ __forceinline__ int permsrc(int j) { return j < 16 ? ((j >> 1) + 8 * (j & 1)) : j; }
__device__ __forceinline__ void map_col(int kind, int np, int& src, int& which, float& scale) {
    which = 0; scale = 1.f; src = np;
    if (kind == 1) { const int blk = (np >> 10) % 3; const int hd = np & 63; if (blk < 2) src = np - hd + permsrc(hd); if (blk == 0) scale = C2; }
    else if (kind == 3) { const int hd = np & 63; if (np < 1152) src = np - hd + permsrc(hd); if (np < 1024) scale = C2; }
    else if (kind == 4) { const int tile = np >> 8, w = np & 255; src = tile * 128 + (w & 127); which = w >> 7; }
}
struct TItem { const float* src; float scale; int e, k0, n0; };
__device__ __forceinline__ TItem titem(const WJob& J, int item, int lane) {
    TItem T; const int nblk = J.Nout / 32, per = (J.K / 64) * nblk;
    T.e = item / per; const int r = item % per, kb = r / nblk, nb = r % nblk; T.k0 = 64 * kb; T.n0 = 32 * nb;
    int src, which; map_col(J.kind, T.n0 + (lane & 31), src, which, T.scale);
    const unsigned long long a0_ = (unsigned long long)J.W0, a1_ = (unsigned long long)(J.W1 ? J.W1 : J.W0);
    T.src = (const float*)(a0_ + (a1_ - a0_) * (unsigned long long)which) + (size_t)T.e * J.sW + (size_t)(T.k0 + (lane >> 5)) * J.ldw + src;
    return T;
}
__device__ __forceinline__ void tload(const WJob& J, const TItem& T, float (&v)[32]) {
#pragma unroll
    for (int i = 0; i < 32; ++i) v[i] = __builtin_nontemporal_load(T.src + (size_t)(2 * i) * J.ldw);
}
__device__ __forceinline__ void tstore(const WJob& J, const TItem& T, const float (&v)[32], LAS float* scr, int lane) {
#pragma unroll
    for (int i = 0; i < 32; ++i) scr[(2 * i + (lane >> 5)) * 33 + (lane & 31)] = v[i] * T.scale;
    LDS_WAIT(); asm volatile("" ::: "memory");
    const int c = lane & 7;
    f32x4 g0 = (f32x4){1.f, 1.f, 1.f, 1.f}, g1 = g0;
    if (J.gain) { g0 = *(const f32x4*)(J.gain + T.k0 + 8 * c); g1 = *(const f32x4*)(J.gain + T.k0 + 8 * c + 4); }
    if (J.fp8) {
        unsigned char* WT8 = (unsigned char*)J.WT + (size_t)T.e * J.sWT;
        g0 = g0 * W8_SCALE; g1 = g1 * W8_SCALE;
#pragma unroll
        for (int j = 0; j < 4; ++j) { const int n = (lane >> 3) + 8 * j; const LAS float* s = scr + (8 * c) * 33 + n;
            u32x2 o; o.x = pk_fp8x4(s[0 * 33] * g0[0], s[1 * 33] * g0[1], s[2 * 33] * g0[2], s[3 * 33] * g0[3]); o.y = pk_fp8x4(s[4 * 33] * g1[0], s[5 * 33] * g1[1], s[6 * 33] * g1[2], s[7 * 33] * g1[3]);
            *(u32x2*)(WT8 + (size_t)(T.n0 + n) * J.K + T.k0 + 8 * c) = o; }
    } else {
    bf16_t* WT = J.WT + (size_t)T.e * J.sWT;
#pragma unroll
    for (int j = 0; j < 4; ++j) { const int n = (lane >> 3) + 8 * j; const LAS float* s = scr + (8 * c) * 33 + n;
        u32x4 o; o.x = pk2(s[0 * 33] * g0[0], s[1 * 33] * g0[1]); o.y = pk2(s[2 * 33] * g0[2], s[3 * 33] * g0[3]); o.z = pk2(s[4 * 33] * g1[0], s[5 * 33] * g1[1]); o.w = pk2(s[6 * 33] * g1[2], s[7 * 33] * g1[3]);
        *(u32x4*)(WT + (size_t)(T.n0 + n) * J.K + T.k0 + 8 * c) = o; }
    }
    LDS_WAIT(); asm volatile("" ::: "memory");
}
__device__ __forceinline__ WJob make_job(const Ctx& C, int j) {
    WJob J; J.W1 = nullptr; J.gain = nullptr; J.nE = 1; J.sW = 0; J.sWT = 0; J.kind = 0; J.fp8 = (j == 0 || j == 12 || j == 6 || j == 7 || j >= 14 || j == 1 || j == 9 || j == 13 || j == 10 || j == 8 || j == 11) ? 1 : 0;
    switch (j) {
    case 0:  J.W0 = IN_F(3);  J.WT = WSP(bf16_t, WS_WQKV0); J.gain = IN_F(2);  J.K = 1024; J.ldw = 9216; J.Nout = 9216; J.kind = 1; break;
    case 1:  J.W0 = IN_F(4);  J.WT = WSP(bf16_t, WS_WO0);   J.K = 1024; J.ldw = 1024; J.Nout = 1024; break;
    case 2:  J.W0 = IN_F(6);  J.W1 = IN_F(7); J.WT = WSP(bf16_t, WS_W13_0); J.gain = IN_F(5); J.K = 1024; J.ldw = FF; J.Nout = 2 * FF; J.kind = 4; break;
    case 3:  J.W0 = IN_F(8);  J.WT = WSP(bf16_t, WS_W2_0);  J.K = FF; J.ldw = 1024; J.Nout = 1024; break;
    case 4:  J.W0 = IN_F(10); J.WT = WSP(bf16_t, WS_WQKV1); J.gain = IN_F(9);  J.K = 1024; J.ldw = 3072; J.Nout = 3072; J.kind = 1; break;
    case 5:  J.W0 = IN_F(16); J.WT = WSP(bf16_t, WS_WO1);   J.K = 1024; J.ldw = 1024; J.Nout = 1024; break;
    case 6:  J.W0 = IN_F(19); J.W1 = IN_F(20); J.WT = WSP(bf16_t, WS_WM13); J.gain = IN_F(17); J.K = 1024; J.ldw = FFE; J.Nout = 2 * FFE; J.kind = 4; J.nE = 8; J.sW = (size_t)1024 * FFE; J.sWT = (size_t)2 * FFE * 1024; break;
    case 7:  J.W0 = IN_F(21); J.WT = WSP(bf16_t, WS_WM2);   J.K = FFE; J.ldw = 1024; J.Nout = 1024; J.nE = 8; J.sW = (size_t)FFE * 1024; J.sWT = (size_t)1024 * FFE; break;
    case 8:  J.W0 = IN_F(23); J.WT = WSP(bf16_t, WS_WQKV2); J.gain = IN_F(22); J.K = 1024; J.ldw = 1280; J.Nout = 1280; J.kind = 3; break;
    case 9:  J.W0 = IN_F(25); J.WT = WSP(bf16_t, WS_WO2);   J.K = 1024; J.ldw = 1024; J.Nout = 1024; break;
    case 10: J.W0 = IN_F(27); J.W1 = IN_F(28); J.WT = WSP(bf16_t, WS_W13_2); J.gain = IN_F(26); J.K = 1024; J.ldw = FF; J.Nout = 2 * FF; J.kind = 4; break;
    case 11: J.W0 = IN_F(29); J.WT = WSP(bf16_t, WS_W2_2);  J.K = FF; J.ldw = 1024; J.Nout = 1024; break;
    case 12: J.W0 = IN_F(31); J.WT = WSP(bf16_t, WS_WQKV3); J.gain = IN_F(30); J.K = 1024; J.ldw = 9216; J.Nout = 9216; J.kind = 1; break;
    case 13: J.W0 = IN_F(32); J.WT = WSP(bf16_t, WS_WO3);   J.K = 1024; J.ldw = 1024; J.Nout = 1024; break;
    case 14: J.W0 = IN_F(35); J.W1 = IN_F(36); J.WT = WSP(bf16_t, WS_WM13); J.gain = IN_F(33); J.K = 1024; J.ldw = FFE; J.Nout = 2 * FFE; J.kind = 4; J.nE = 8; J.sW = (size_t)1024 * FFE; J.sWT = (size_t)2 * FFE * 1024; break;
    default: J.W0 = IN_F(37); J.WT = WSP(bf16_t, WS_WM2);   J.K = FFE; J.ldw = 1024; J.Nout = 1024; J.nE = 8; J.sW = (size_t)FFE * 1024; J.sWT = (size_t)1024 * FFE; break;
    }
    return J;
}
template <int j>
__device__ __forceinline__ void convert_one(const Ctx& C) {
    LAS float* scr = (LAS float*)(C.lds + C.wave * 16384);
    const int gw = C.bid * 8 + C.wave, NGW = C.G * 8;
    const WJob J = make_job(C, j);
    const int nitems = J.nE * (J.K / 64) * (J.Nout / 32);
    if (gw >= nitems) return;
    TItem T = titem(J, gw, C.lane); float v[32]; tload(J, T, v);
    for (int it = gw; it < nitems; it += NGW) {
        const int nx = it + NGW; TItem Tn = T; float w[32];
        if (nx < nitems) { Tn = titem(J, nx, C.lane); tload(J, Tn, w); }
        tstore(J, T, v, scr, C.lane);
        if (nx < nitems) { T = Tn;
#pragma unroll
            for (int i = 0; i < 32; ++i) v[i] = w[i]; }
    }
}
__device__ __forceinline__ void convert_weights_first(const Ctx& C) {
    convert_one<0>(C); convert_one<1>(C); convert_one<2>(C); convert_one<3>(C); convert_one<4>(C); convert_one<5>(C); convert_one<6>(C);
    convert_one<7>(C); convert_one<8>(C); convert_one<9>(C); convert_one<10>(C); convert_one<11>(C); convert_one<12>(C); convert_one<13>(C);
}
__device__ __forceinline__ void convert_weights_second(const Ctx& C) { convert_one<14>(C); convert_one<15>(C); }
__device__ __forceinline__ void rope_table(const Ctx& C) {
    const int* pos = (const int*)C.in[1];
    float* tab = WSP(float, WS_ROPE);
    for (int i = C.bid * 512 + C.tid; i < NTOK * 8; i += C.G * 512) {
        const int tok = i >> 3, f = i & 7;
        const float inv = powf(500000.0f, -(float)f * 0.125f);
        const float ang = (float)pos[tok] * inv;
        const double a = (double)ang;
        const double k = rint(a * 0.15915494309189535);
        const float r = (float)(a - k * 6.283185307179586);
        tab[(size_t)tok * 16 + f] = cosf(r); tab[(size_t)tok * 16 + 8 + f] = sinf(r);
    }
}
__device__ __forceinline__ void write_ssq_row(float* ssq, int row, float tot, int lane) { if (lane < 16) ssq[(size_t)row * 16 + lane] = (lane == 0) ? tot : 0.f; }
__device__ __forceinline__ void x_to_bf16(const Ctx& C) {
    const float* x = IN_F(0); bf16_t* xb = WSP(bf16_t, WS_XB); float* ssq = WSP(float, WS_SSQ); unsigned char* x8 = WSP(unsigned char, WS_X8);
    const int gw = C.bid * 8 + C.wave, NGW = C.G * 8;
    for (int m = gw; m < NTOK; m += NGW) {
        const f32x4* xr = (const f32x4*)(x + (size_t)m * DM) + C.lane; u32x2* o = (u32x2*)(xb + (size_t)m * DM) + C.lane; unsigned* o8 = (unsigned*)(x8 + (size_t)m * DM) + C.lane;
        float s = 0.f;
#pragma unroll
        for (int j = 0; j < 4; ++j) { const f32x4 v = xr[64 * j]; s += (v[0] * v[0] + v[1] * v[1]) + (v[2] * v[2] + v[3] * v[3]); u32x2 w; w.x = pk2(v[0], v[1]); w.y = pk2(v[2], v[3]); o[64 * j] = w; o8[64 * j] = pk_fp8x4(v[0], v[1], v[2], v[3]); }
        write_ssq_row(ssq, m, wave_sum(s), C.lane);
    }
}

__device__ __forceinline__ void load_q64(const bf16_t* qp, float (&q)[64]) {
#pragma unroll
    for (int c = 0; c < 8; ++c) { const u32x4 w = *(const u32x4*)(qp + 8 * c);
        q[8 * c + 0] = bflo(w.x); q[8 * c + 1] = bfhi(w.x); q[8 * c + 2] = bflo(w.y); q[8 * c + 3] = bfhi(w.y); q[8 * c + 4] = bflo(w.z); q[8 * c + 5] = bfhi(w.z); q[8 * c + 6] = bflo(w.w); q[8 * c + 7] = bfhi(w.w); }
}
__device__ __forceinline__ float dot64(const float (&q)[64], const bf16_t* kp) {
    float s = 0.f;
#pragma unroll
    for (int c = 0; c < 8; ++c) { const u32x4 w = *(const u32x4*)(kp + 8 * c);
        s += q[8 * c + 0] * bflo(w.x); s += q[8 * c + 1] * bfhi(w.x); s += q[8 * c + 2] * bflo(w.y); s += q[8 * c + 3] * bfhi(w.y);
        s += q[8 * c + 4] * bflo(w.z); s += q[8 * c + 5] * bfhi(w.z); s += q[8 * c + 6] * bflo(w.w); s += q[8 * c + 7] * bfhi(w.w); }
    return s;
}
__device__ __forceinline__ void naive_band(const bf16_t* qp, const bf16_t* K, const bf16_t* V, size_t kstride, int jlo, int jhi, float m0, float l0, int lane, float& o_out, float& m_out, float& l_out) {
    float q[64]; load_q64(qp, q);
    float m = m0, l = l0, o = 0.f;
    for (int j0 = jlo; j0 <= jhi; j0 += 64) {
        const int j = j0 + lane; const bool valid = j <= jhi; const int jj = valid ? j : jhi;
        float s = dot64(q, K + (size_t)jj * kstride); if (!valid) s = -INFINITY;
        const float mn = fmaxf(m, wave_max(s)); const float alpha = exp2f(m - mn); const float p = exp2f(s - mn);
        l = l * alpha + wave_sum(p); o *= alpha; m = mn;
        const int cnt = (jhi - j0 + 1) < 64 ? (jhi - j0 + 1) : 64;
        for (int t = 0; t < cnt; ++t) { const float pj = __shfl(p, t); o += pj * bf2f(V[(size_t)(j0 + t) * kstride + lane]); }
    }
    o_out = o; m_out = m; l_out = l;
}
__device__ __forceinline__ void naive_attn_A(const Ctx& C) {
    const bf16_t* QKV = WSP(bf16_t, WS_BIG + BIG_QKV); bf16_t* OG = WSP(bf16_t, WS_BIG + BIG_OG); float* LSE = WSP(float, WS_LSE);
    const int gw = C.bid * 8 + C.wave, NGW = C.G * 8;
    for (int it = gw; it < NTOK * 16 * 3; it += NGW) {
        const int gi = it % 3, h = (it / 3) % 16, tok = it / 48;
        const int dil = gi == 0 ? 1 : (gi == 1 ? 4 : 16);
        const int b = tok / SEQ, s = tok % SEQ, r = s % dil, i = s / dil, L = SEQ / dil;
        const int jlo = i - 64 < 0 ? 0 : i - 64, jhi = i + 64 > L - 1 ? L - 1 : i + 64;
        const bf16_t* base = QKV + (size_t)(b * SEQ + r) * NQKV_A + gi * 3072 + h * 64;
        float o, m, l;
        naive_band(QKV + (size_t)tok * NQKV_A + gi * 3072 + h * 64, base + 1024, base + 2048, (size_t)dil * NQKV_A, jlo, jhi, -1e30f, 0.f, C.lane, o, m, l);
        OG[((size_t)gi * NTOK + tok) * DM + h * 64 + C.lane] = (bf16_t)f2bf(o / l);
        if (C.lane == 0) LSE[((size_t)gi * NTOK + tok) * 16 + h] = m + log2f(l);
    }
}
__device__ __forceinline__ void naive_attn_C(const Ctx& C) {
    const bf16_t* QKV = WSP(bf16_t, WS_BIG + BIG_QKV); bf16_t* O = WSP(bf16_t, WS_O); const float* sink = IN_F(24);
    const int gw = C.bid * 8 + C.wave, NGW = C.G * 8;
    for (int it = gw; it < NTOK * 16; it += NGW) {
        const int h = it % 16, tok = it / 16, g = h / 8;
        const int b = tok / SEQ, s = tok % SEQ;
        const int jlo = s - 128 < 0 ? 0 : s - 128, jhi = s + 128 > SEQ - 1 ? SEQ - 1 : s + 128;
        const bf16_t* base = QKV + (size_t)(b * SEQ) * NQKV_C;
        float o, m, l;
        naive_band(QKV + (size_t)tok * NQKV_C + h * 64, base + 1024 + g * 64, base + 1152 + g * 64, (size_t)NQKV_C, jlo, jhi, sink[h] * LOG2E, 1.f, C.lane, o, m, l);
        O[(size_t)tok * DM + h * 64 + C.lane] = (bf16_t)f2bf(o / l);
    }
}
__device__ __forceinline__ float diff_lambda(const Ctx& C) {
    const float a = IN_F(11)[C.lane] * IN_F(12)[C.lane], b = IN_F(13)[C.lane] * IN_F(14)[C.lane];
    return expf(wave_sum(a)) - expf(wave_sum(b)) + LAMBDA_INIT;
}
__device__ __forceinline__ void naive_attn_B(const Ctx& C) {
    const bf16_t* QKV = WSP(bf16_t, WS_BIG + BIG_QKV); bf16_t* O = WSP(bf16_t, WS_O); const float* subln = IN_F(15);
    const float lam = diff_lambda(C);
    const int gw = C.bid * 8 + C.wave, NGW = C.G * 8, lane = C.lane;
    for (int it = gw; it < NTOK * 8; it += NGW) {
        const int h = it % 8, tok = it / 8, b = tok / SEQ;
        float q0[64], q1[64]; load_q64(QKV + (size_t)tok * NQKV_B + (2 * h) * 64, q0); load_q64(QKV + (size_t)tok * NQKV_B + (2 * h + 1) * 64, q1);
        const bf16_t* Kb = QKV + (size_t)(b * SEQ) * NQKV_B + 1024 + (2 * h) * 64; const bf16_t* Vb = QKV + (size_t)(b * SEQ) * NQKV_B + 2048 + h * 128;
        float m0 = -1e30f, l0 = 0.f, m1 = -1e30f, l1 = 0.f, oa0 = 0.f, ob0 = 0.f, oa1 = 0.f, ob1 = 0.f;
        for (int j0 = 0; j0 < SEQ; j0 += 64) {
            const bf16_t* kr = Kb + (size_t)(j0 + lane) * NQKV_B;
            const float s0 = dot64(q0, kr), s1 = dot64(q1, kr + 64);
            const float mn0 = fmaxf(m0, wave_max(s0)), mn1 = fmaxf(m1, wave_max(s1));
            const float a0 = exp2f(m0 - mn0), a1 = exp2f(m1 - mn1), p0 = exp2f(s0 - mn0), p1 = exp2f(s1 - mn1);
            l0 = l0 * a0 + wave_sum(p0); l1 = l1 * a1 + wave_sum(p1); oa0 *= a0; ob0 *= a0; oa1 *= a1; ob1 *= a1; m0 = mn0; m1 = mn1;
#pragma unroll 8
            for (int t = 0; t < 64; ++t) {
                const bf16_t* vr = Vb + (size_t)(j0 + t) * NQKV_B;
                const float va = bf2f(vr[lane]), vb = bf2f(vr[lane + 64]);
                const float pa = __shfl(p0, t), pb = __shfl(p1, t);
                oa0 += pa * va; ob0 += pa * vb; oa1 += pb * va; ob1 += pb * vb;
            }
        }
        const float f0 = 1.0f / l0, f1 = lam / l1;
        const float ya = oa0 * f0 - oa1 * f1, yb = ob0 * f0 - ob1 * f1;
        const float ms = wave_sum(ya * ya + yb * yb) * (1.0f / 128.0f);
        const float rs = (1.0f / sqrtf(ms + SUBLN_EPS)) * (1.0f - LAMBDA_INIT);
        O[(size_t)tok * DM + h * 128 + lane] = (bf16_t)f2bf(ya * rs * subln[lane]);
        O[(size_t)tok * DM + h * 128 + 64 + lane] = (bf16_t)f2bf(yb * rs * subln[lane + 64]);
    }
}

namespace att {
typedef float f32x16 __attribute__((ext_vector_type(16)));
typedef short s16x4 __attribute__((ext_vector_type(4)));
typedef short v4i16_t __attribute__((ext_vector_type(4)));
typedef __bf16 bf16x2_t __attribute__((ext_vector_type(2)));
#define ADI __device__ __forceinline__
#define MFMA32(a, b, c) __builtin_amdgcn_mfma_f32_32x32x16_bf16((a), (b), (c), 0, 0, 0)
ADI int crow(int i, int hh) { return (i & 3) + 8 * (i >> 2) + 4 * hh; }
ADI float hmax(float v) { auto rr = __builtin_amdgcn_permlane32_swap(__float_as_uint(v), __float_as_uint(v), false, false); return fmaxf(__uint_as_float(rr[0]), __uint_as_float(rr[1])); }
ADI float hsum(float v) { auto rr = __builtin_amdgcn_permlane32_swap(__float_as_uint(v), __float_as_uint(v), false, false); return __uint_as_float(rr[0]) + __uint_as_float(rr[1]); }
ADI unsigned cvtpk(float lo, float hi) { f32x2 v = {lo, hi}; bf16x2_t b = __builtin_convertvector(v, bf16x2_t); return __builtin_bit_cast(unsigned, b); }
template <int S> ADI bf16x8 pack8(const f32x16& x) { u32x4 p; p[0] = cvtpk(x[8 * S], x[8 * S + 1]); p[1] = cvtpk(x[8 * S + 2], x[8 * S + 3]); p[2] = cvtpk(x[8 * S + 4], x[8 * S + 5]); p[3] = cvtpk(x[8 * S + 6], x[8 * S + 7]); return __builtin_bit_cast(bf16x8, p); }
ADI s16x4 vtr(const LAS unsigned char* p) { return __builtin_bit_cast(s16x4, __builtin_amdgcn_ds_read_tr16_b64_v4i16((LAS v4i16_t*)p)); }
ADI bf16x8 cat8(s16x4 lo, s16x4 hi) { return (bf16x8){lo[0], lo[1], lo[2], lo[3], hi[0], hi[1], hi[2], hi[3]}; }
ADI float fexp2(float x) { return __builtin_amdgcn_exp2f(x); }
ADI float max3f(float a, float b, float c) { return __builtin_fmaxf(__builtin_fmaxf(a, b), c); }

ADI void qk_tile(f32x16& s0, f32x16& s1, const LAS unsigned char* kt, const bf16x8 (&q)[4], int kro, int kx6) {
    s0 = f32x16{}; s1 = f32x16{};
#pragma unroll
    for (int d0 = 0; d0 < 4; ++d0) {
        const int ko = kro + (kx6 ^ (d0 << 5));
        const bf16x8 a0 = *(const LAS bf16x8*)(kt + ko); const bf16x8 a1 = *(const LAS bf16x8*)(kt + 4096 + ko);
        s0 = MFMA32(a0, q[d0], s0); s1 = MFMA32(a1, q[d0], s1);
    }
}
ADI void qk_tile_init(f32x16& s0, f32x16& s1, const f32x16& init, const LAS unsigned char* kt, const bf16x8 (&q)[4], int kro, int kx6) {
    s0 = init; s1 = init;
#pragma unroll
    for (int d0 = 0; d0 < 4; ++d0) {
        const int ko = kro + (kx6 ^ (d0 << 5));
        const bf16x8 a0 = *(const LAS bf16x8*)(kt + ko); const bf16x8 a1 = *(const LAS bf16x8*)(kt + 4096 + ko);
        s0 = MFMA32(a0, q[d0], s0); s1 = MFMA32(a1, q[d0], s1);
    }
}
ADI void qk_tile_lq(f32x16& s0, f32x16& s1, const LAS unsigned char* kt, const LAS unsigned char* qf, int kro, int kx6) {
    s0 = f32x16{}; s1 = f32x16{};
#pragma unroll
    for (int d0 = 0; d0 < 4; ++d0) {
        const int ko = kro + (kx6 ^ (d0 << 5));
        const bf16x8 a0 = *(const LAS bf16x8*)(kt + ko); const bf16x8 a1 = *(const LAS bf16x8*)(kt + 4096 + ko);
        const bf16x8 qd = *(const LAS bf16x8*)(qf + d0 * 1024);
        s0 = MFMA32(a0, qd, s0); s1 = MFMA32(a1, qd, s1);
    }
}
template <int NB>
ADI void softmax_tile(f32x16& s0, f32x16& s1, float& m, float& l, f32x16 (&O)[NB], LAS float* scr, int r, int hh) {
    float mxa = max3f(s0[0], s0[1], s1[0]), mxb = max3f(s0[2], s0[3], s1[1]); mxa = max3f(mxa, s1[2], s1[3]);
#pragma unroll
    for (int i = 4; i < 16; i += 4) { mxa = max3f(mxa, s0[i], s0[i + 1]); mxb = max3f(mxb, s0[i + 2], s0[i + 3]); mxa = max3f(mxa, s1[i], s1[i + 1]); mxb = max3f(mxb, s1[i + 2], s1[i + 3]); }
    float mx = hmax(max3f(mxa, mxb, mxb));
    if (__any(mx > m + 8.0f)) {
        const float mn = fmaxf(m, mx), al = fexp2(m - mn); l *= al; m = mn;
        if (hh == 0) scr[r] = al;
#pragma unroll
        for (int g = 0; g < 4; ++g) { const f32x4 a4 = *(const LAS f32x4*)(scr + 8 * g + 4 * hh);
#pragma unroll
            for (int c = 0; c < NB; ++c) { O[c][4 * g] *= a4[0]; O[c][4 * g + 1] *= a4[1]; O[c][4 * g + 2] *= a4[2]; O[c][4 * g + 3] *= a4[3]; } }
    }
    float sa = 0.f, sb = 0.f, sc = 0.f, sd = 0.f;
#pragma unroll
    for (int i = 0; i < 16; i += 2) { s0[i] = fexp2(s0[i] - m); s1[i] = fexp2(s1[i] - m); s0[i + 1] = fexp2(s0[i + 1] - m); s1[i + 1] = fexp2(s1[i + 1] - m); sa += s0[i]; sb += s1[i]; sc += s0[i + 1]; sd += s1[i + 1]; }
    l += (sa + sb) + (sc + sd);
}

template <int NB>
ADI void softmax_max(const f32x16& s0, const f32x16& s1, float& m, float& l, f32x16 (&O)[NB], LAS float* scr, int r, int hh) {
    float mxa = max3f(s0[0], s0[1], s1[0]), mxb = max3f(s0[2], s0[3], s1[1]); mxa = max3f(mxa, s1[2], s1[3]);
#pragma unroll
    for (int i = 4; i < 16; i += 4) { mxa = max3f(mxa, s0[i], s0[i + 1]); mxb = max3f(mxb, s0[i + 2], s0[i + 3]); mxa = max3f(mxa, s1[i], s1[i + 1]); mxb = max3f(mxb, s1[i + 2], s1[i + 3]); }
    const float mx = hmax(max3f(mxa, mxb, mxb));
    if (__any(mx > m + 8.0f)) {
        const float mn = fmaxf(m, mx), al = fexp2(m - mn); l *= al; m = mn;
        if (hh == 0) scr[r] = al;
#pragma unroll
        for (int g = 0; g < 4; ++g) { const f32x4 a4 = *(const LAS f32x4*)(scr + 8 * g + 4 * hh);
#pragma unroll
            for (int c = 0; c < NB; ++c) { O[c][4 * g] *= a4[0]; O[c][4 * g + 1] *= a4[1]; O[c][4 * g + 2] *= a4[2]; O[c][4 * g + 3] *= a4[3]; } }
    }
}
template <int S> ADI bf16x8 exp_pack8(f32x16& x, float m, float& sa, float& sb) {
#pragma unroll
    for (int i = 0; i < 8; i += 2) { x[8 * S + i] = fexp2(x[8 * S + i] - m); x[8 * S + i + 1] = fexp2(x[8 * S + i + 1] - m); sa += x[8 * S + i]; sb += x[8 * S + i + 1]; }
    return pack8<S>(x);
}
ADI void glds16(const void* gsrc, unsigned lds_dst) { unsigned keep;
    asm volatile("s_mov_b32 %0, m0\n\ts_mov_b32 m0, %2\n\ts_nop 0\n\tglobal_load_lds_dwordx4 %1, off\n\ts_mov_b32 m0, %0" : "=&s"(keep) : "v"(gsrc), "s"(lds_dst) : "memory"); }
#define ATT_GLDS(gp, lp) glds16((gp), (unsigned)__builtin_amdgcn_readfirstlane((int)(lp)))
typedef int v8i_a __attribute__((ext_vector_type(8)));
typedef int v4i_a __attribute__((ext_vector_type(4)));
typedef int v2i_a __attribute__((ext_vector_type(2)));
ADI void diff_unit(LAS unsigned char* lds, const unsigned char* QKV8, bf16_t* Oout, const float* subln, float lam, int b, int h, int qb, int tid, int lane, int wave) {
    const int r = lane & 31, hh = lane >> 5, comp = wave & 1, qt = wave >> 1;
    const size_t rowbase = (size_t)b * SEQ;
    v8i_a q8;
    {
        const unsigned char* qrow = QKV8 + (rowbase + qb * 128 + qt * 32 + r) * NQKV_B + (2 * h + comp) * 64 + 32 * hh;
        const v4i_a qa = *(const v4i_a*)qrow, qb_ = *(const v4i_a*)(qrow + 16);
        q8 = __builtin_shufflevector(qa, qb_, 0, 1, 2, 3, 4, 5, 6, 7);
    }
    const bool isV = wave >= 4; const int w4 = wave & 3;
    const int srow = 16 * w4 + (lane >> 2);
    const int vkey = 16 * w4 + (lane >> 3), vf0 = (vkey >> 1) & 1;
    const unsigned char* src0 = isV ? QKV8 + (rowbase + vkey) * NQKV_B + 2048 + h * 128 + ((((lane >> 1) & 3) ^ vf0) << 5) + ((lane & 1) << 4)
                                    : QKV8 + (rowbase + srow) * NQKV_B + 1024 + (2 * h) * 64 + (((lane & 3) ^ ((srow >> 2) & 3)) << 4);
    const unsigned char* src1 = isV ? QKV8 + (rowbase + vkey + 8) * NQKV_B + 2048 + h * 128 + ((((lane >> 1) & 3) ^ (vf0 | 2)) << 5) + ((lane & 1) << 4)
                                    : src0 + 64;
    const unsigned lb = (unsigned)(uintptr_t)lds;
    const unsigned dk0 = lb + (isV ? 8192 + (2 * w4) * 1024 : w4 * 1024), dk1 = lb + (isV ? 8192 + (2 * w4 + 1) * 1024 : 4096 + w4 * 1024);
#define DIFF_DMA(tt) do { const unsigned so_ = ((tt) & 3) * 16384; const size_t go_ = (size_t)(tt) * 64 * NQKV_B; \
        ATT_GLDS(src0 + go_, dk0 + so_); ATT_GLDS(src1 + go_, dk1 + so_); } while (0)
    const int kx = (r >> 2) & 3;
    const int kro0 = comp * 4096 + r * 64 + (((2 * hh) ^ kx) << 4), kro1 = comp * 4096 + r * 64 + (((2 * hh + 1) ^ kx) << 4);
    const int ts_ = lane & 15, tblk = (lane >> 4) & 1;
    const int te = ts_ >> 1, tcol = ts_ & 1;
    const int tkey = (te & 3) + 8 * (te >> 2) + 4 * hh;
    const int tfx = (te >> 1) & 3;
    const int vro = 8192 + tkey * 128 + 16 * tblk + 8 * tcol;
    LAS float* scr = (LAS float*)(lds + 132096 + wave * 256);
    f32x16 O[4];
#pragma unroll
    for (int c = 0; c < 4; ++c) O[c] = f32x16{};
    float m4 = 0.f, l = 0.f;
    f32x16 negm = f32x16{};
    constexpr int NT = SEQ / 64;
    const int sP = 0x7b7b7b7b, sV = 0x7f7f7f7f, sK = 0x7f7f7f7f, sQ = 0x7b7b7b7b;
    DIFF_DMA(0); DIFF_DMA(1);
    asm volatile("s_waitcnt vmcnt(2)\n\ts_barrier" ::: "memory");
    if (wave >= 4) __builtin_amdgcn_s_setprio(1);
    for (int t = 0; t < NT; ++t) {
        if (t + 2 < NT) DIFF_DMA(t + 2);
        const LAS unsigned char* st = lds + (t & 3) * 16384;
        f32x16 s0, s1;
        {
            const v4i_a a0 = *(const LAS v4i_a*)(st + kro0), a1 = *(const LAS v4i_a*)(st + kro1), b0 = *(const LAS v4i_a*)(st + 2048 + kro0), b1 = *(const LAS v4i_a*)(st + 2048 + kro1);
            const v8i_a k0 = __builtin_shufflevector(a0, a1, 0, 1, 2, 3, 4, 5, 6, 7), k1 = __builtin_shufflevector(b0, b1, 0, 1, 2, 3, 4, 5, 6, 7);
            asm volatile("s_nop 3\n\tv_mfma_scale_f32_32x32x64_f8f6f4 %0, %2, %4, %5, %6, %7 op_sel_hi:[0,0,0]\n\tv_mfma_scale_f32_32x32x64_f8f6f4 %1, %3, %4, %5, %6, %7 op_sel_hi:[0,0,0]\n\ts_nop 15\n\ts_nop 7"
                         : "=&v"(s0), "=&v"(s1) : "v"(k0), "v"(k1), "v"(q8), "v"(negm), "v"(sK), "v"(sQ));
        }
        {
            float mxa = max3f(s0[0], s0[1], s1[0]), mxb = max3f(s0[2], s0[3], s1[1]); mxa = max3f(mxa, s1[2], s1[3]);
#pragma unroll
            for (int i = 4; i < 16; i += 4) { mxa = max3f(mxa, s0[i], s0[i + 1]); mxb = max3f(mxb, s0[i + 2], s0[i + 3]); mxa = max3f(mxa, s1[i], s1[i + 1]); mxb = max3f(mxb, s1[i + 2], s1[i + 3]); }
            const float mx = hmax(max3f(mxa, mxb, mxb));
            if (t == 0 || __any(mx > 8.0f)) {
                const float dl = (t == 0) ? (mx - 4.0f) : fmaxf(mx - 4.0f, 0.f);
                const float al = (t == 0) ? 0.f : fexp2(-dl); l *= al; m4 += dl;
#pragma unroll
                for (int i = 0; i < 16; ++i) { s0[i] -= dl; s1[i] -= dl; negm[i] = -m4; }
                if (hh == 0) scr[r] = al;
#pragma unroll
                for (int g = 0; g < 4; ++g) { const f32x4 a4 = *(const LAS f32x4*)(scr + 8 * g + 4 * hh);
#pragma unroll
                    for (int c = 0; c < 4; ++c) { O[c][4 * g] *= a4[0]; O[c][4 * g + 1] *= a4[1]; O[c][4 * g + 2] *= a4[2]; O[c][4 * g + 3] *= a4[3]; } }
            }
        }
        float sa = 0.f, sb = 0.f, sc = 0.f, sd = 0.f;
#pragma unroll
        for (int i = 0; i < 16; i += 2) { s0[i] = fexp2(s0[i]); s1[i] = fexp2(s1[i]); s0[i + 1] = fexp2(s0[i + 1]); s1[i + 1] = fexp2(s1[i + 1]); sa += s0[i]; sb += s1[i]; sc += s0[i + 1]; sd += s1[i + 1]; }
        l += ((sa + sb) + (sc + sd)) * 0.0625f;
        v8i_a P8;
#pragma unroll
        for (int g = 0; g < 4; ++g) { P8[g] = (int)pk_fp8x4_nc(s0[4 * g], s0[4 * g + 1], s0[4 * g + 2], s0[4 * g + 3]); P8[4 + g] = (int)pk_fp8x4_nc(s1[4 * g], s1[4 * g + 1], s1[4 * g + 2], s1[4 * g + 3]); }
#pragma unroll
        for (int c = 0; c < 4; ++c) {
            const LAS unsigned char* vp = st + vro + ((c ^ tfx) << 5);
            const v2i_a t0 = __builtin_amdgcn_ds_read_tr8_b64_v2i32((LAS v2i_a*)(vp)), t1 = __builtin_amdgcn_ds_read_tr8_b64_v2i32((LAS v2i_a*)(vp + 16 * 128));
            const v2i_a t2 = __builtin_amdgcn_ds_read_tr8_b64_v2i32((LAS v2i_a*)(vp + 32 * 128)), t3 = __builtin_amdgcn_ds_read_tr8_b64_v2i32((LAS v2i_a*)(vp + 48 * 128));
            const v8i_a V8 = (v8i_a){t0[0], t0[1], t1[0], t1[1], t2[0], t2[1], t3[0], t3[1]};
            asm volatile("s_nop 3\n\tv_mfma_scale_f32_32x32x64_f8f6f4 %0, %1, %2, %0, %3, %4 op_sel_hi:[0,0,0]" : "+v"(O[c]) : "v"(P8), "v"(V8), "v"(sP), "v"(sV));
        }
        if (t + 2 < NT) asm volatile("s_waitcnt vmcnt(2) lgkmcnt(0)\n\ts_barrier" ::: "memory"); else asm volatile("s_waitcnt vmcnt(0) lgkmcnt(0)\n\ts_barrier" ::: "memory");
    }
#undef DIFF_DMA
    __builtin_amdgcn_s_setprio(0);
    asm volatile("s_nop 15\n\ts_nop 15" ::: "memory");
    l = hsum(l);
    if (hh == 0) scr[r] = (comp == 0 ? 1.0f : lam) / l;
    LAS float* xch = (LAS float*)(lds + qt * 16384) + lane;
#pragma unroll
    for (int g = 0; g < 4; ++g) { const f32x4 a4 = *(const LAS f32x4*)(scr + 8 * g + 4 * hh);
#pragma unroll
        for (int c = 0; c < 4; ++c) { O[c][4 * g] *= a4[0]; O[c][4 * g + 1] *= a4[1]; O[c][4 * g + 2] *= a4[2]; O[c][4 * g + 3] *= a4[3]; } }
    if (comp == 1) {
#pragma unroll
        for (int c = 0; c < 4; ++c)
#pragma unroll
            for (int i = 0; i < 16; ++i) xch[(c * 16 + i) * 64] = O[c][i];
    }
    __syncthreads();
    if (comp == 0) {
        float sg[4];
#pragma unroll
        for (int c = 0; c < 4; ++c) sg[c] = subln[32 * c + r] * (1.0f - LAMBDA_INIT);
#pragma unroll
        for (int i = 0; i < 16; ++i) {
            float y[4]; float ss = 0.f;
#pragma unroll
            for (int c = 0; c < 4; ++c) { y[c] = O[c][i] - xch[(c * 16 + i) * 64]; ss += y[c] * y[c]; }
            ss += __shfl_xor(ss, 1); ss += __shfl_xor(ss, 2); ss += __shfl_xor(ss, 4); ss += __shfl_xor(ss, 8); ss += __shfl_xor(ss, 16);
            const float rs = 1.0f / sqrtf(ss * (1.0f / 128.0f) + SUBLN_EPS);
            bf16_t* op = Oout + (rowbase + qb * 128 + qt * 32 + crow(i, hh)) * DM + h * 128 + r;
#pragma unroll
            for (int c = 0; c < 4; ++c) op[32 * c] = (bf16_t)f2bf(y[c] * rs * sg[c]);
        }
    }
    __syncthreads();
}

struct BandW { const bf16_t* qrow; int qi0, tlo, thi; float m0, l0; bf16_t* out; size_t ostride; float* lse; size_t lstride; };
template <bool LSE_OUT>
ADI void band_unit(LAS unsigned char* lds, const bf16_t* Kb, const bf16_t* Vb, size_t kstride, int L, int jstart, int ntiles, int halfw, const BandW& W, int tid, int lane, int wave) {
    const int r = lane & 31, hh = lane >> 5;
    bf16x8 q[4];
#pragma unroll
    for (int d0 = 0; d0 < 4; ++d0) q[d0] = *(const bf16x8*)(W.qrow + 16 * d0 + 8 * hh);
    const int srow = tid >> 3, sch = tid & 7;
    const int kdst = srow * 128 + ((sch ^ ((srow >> 1) & 7)) << 4);
    const int vdst = 8192 + srow * 128 + ((sch ^ (((srow >> 1) & 1) << 2)) << 4);
    const int xs = (r >> 1) & 7;
    const int kro = r * 128 + ((hh ^ (xs & 1)) << 4), kx6 = (xs & 6) << 4;
    const int blk = (lane >> 4) & 1, qq = (lane & 15) >> 2, pp = lane & 3;
    const int vro = 8192 + (4 * hh + qq) * 128 + ((2 * blk + (pp >> 1)) << 4) + 8 * (pp & 1), vq6 = ((qq >> 1) & 1) << 6;
    LAS float* scr = (LAS float*)(lds + 132096 + wave * 256);
    f32x16 O[2]; O[0] = f32x16{}; O[1] = f32x16{};
    float m = W.m0, l = W.l0;
    const int qi = W.qi0 + r;
    {
        int j = jstart + srow; j = j < 0 ? 0 : (j > L - 1 ? L - 1 : j);
        const u32x4 ka = *(const u32x4*)(Kb + (size_t)j * kstride + sch * 8), va = *(const u32x4*)(Vb + (size_t)j * kstride + sch * 8);
        *(LAS u32x4*)(lds + kdst) = ka; *(LAS u32x4*)(lds + vdst) = va;
    }
    __syncthreads();
    for (int t = 0; t < ntiles; ++t) {
        const LAS unsigned char* st = lds + (t & 1) * 16384;
        const bool active = (t >= W.tlo) && (t <= W.thi);
        bf16x8 P[4];
        if (active) {
            f32x16 s0, s1;
            qk_tile(s0, s1, st, q, kro, kx6);
            const int jb = jstart + 64 * t + 4 * hh;
#pragma unroll
            for (int i = 0; i < 16; ++i) {
                const int j0 = jb + (i & 3) + 8 * (i >> 2), j1 = j0 + 32;
                if (!(((unsigned)j0 < (unsigned)L) && ((unsigned)(j0 - qi + halfw) <= (unsigned)(2 * halfw)))) s0[i] = -INFINITY;
                if (!(((unsigned)j1 < (unsigned)L) && ((unsigned)(j1 - qi + halfw) <= (unsigned)(2 * halfw)))) s1[i] = -INFINITY;
            }
            softmax_tile<2>(s0, s1, m, l, O, scr, r, hh);
            P[0] = pack8<0>(s0); P[1] = pack8<1>(s0); P[2] = pack8<0>(s1); P[3] = pack8<1>(s1);
        }
        int j = jstart + 64 * ((t + 1 < ntiles) ? t + 1 : t) + srow; j = j < 0 ? 0 : (j > L - 1 ? L - 1 : j);
        const u32x4 ka = *(const u32x4*)(Kb + (size_t)j * kstride + sch * 8), va = *(const u32x4*)(Vb + (size_t)j * kstride + sch * 8);
        if (active) {
#pragma unroll
            for (int c = 0; c < 2; ++c)
#pragma unroll
                for (int kc = 0; kc < 4; ++kc) {
                    const LAS unsigned char* vp = st + vro + (vq6 ^ (c << 6)) + kc * 2048;
                    const bf16x8 vf = cat8(vtr(vp), vtr(vp + 1024));
                    O[c] = MFMA32(P[kc], vf, O[c]);
                }
        }
        LAS unsigned char* sn = lds + ((t + 1) & 1) * 16384;
        *(LAS u32x4*)(sn + kdst) = ka; *(LAS u32x4*)(sn + vdst) = va;
        __syncthreads();
    }
    l = hsum(l);
    if (hh == 0) scr[r] = 1.0f / l;
    if (LSE_OUT) { if (hh == 0) W.lse[(size_t)(W.qi0 + r) * W.lstride] = m + log2f(l); }
#pragma unroll
    for (int g = 0; g < 4; ++g) { const f32x4 a4 = *(const LAS f32x4*)(scr + 8 * g + 4 * hh);
#pragma unroll
        for (int k = 0; k < 4; ++k) { bf16_t* op = W.out + (size_t)(W.qi0 + 8 * g + 4 * hh + k) * W.ostride + r;
            op[0] = (bf16_t)f2bf(O[0][4 * g + k] * a4[k]); op[32] = (bf16_t)f2bf(O[1][4 * g + k] * a4[k]); } }
}

struct BandDesc { const bf16_t* Kb; const bf16_t* Vb; size_t kstride; int L, jstart; const bf16_t* qrow; int qi0, tlo, thi; float m0, l0; bf16_t* out; size_t ostride; float* lse; size_t lstride; };
template <int NTL, int HALFW, bool LSE_OUT, class F>
ADI void band_stream(LAS unsigned char* lds, int nunits, const F& get, int tid, int lane, int wave) {
    const int r = lane & 31, hh = lane >> 5;
    const unsigned lbase = (unsigned)(uintptr_t)lds;
    const int srow = 8 * wave + (lane >> 3), kchs = ((lane & 7) ^ ((srow >> 1) & 7)) * 8, vchs = ((lane & 7) ^ (((srow >> 1) & 1) << 2)) * 8;
    const int xs = (r >> 1) & 7;
    const int kro = r * 128 + ((hh ^ (xs & 1)) << 4), kx6 = (xs & 6) << 4;
    const int blk = (lane >> 4) & 1, qq = (lane & 15) >> 2, pp = lane & 3;
    const int vro = 8192 + (4 * hh + qq) * 128 + ((2 * blk + (pp >> 1)) << 4) + 8 * (pp & 1), vq6 = ((qq >> 1) & 1) << 6;
    LAS float* scr = (LAS float*)(lds + 132096 + wave * 256);
    const int total = nunits * NTL;
#define BAND_TILE_DMA(sp) do { const int sp_ = (sp) < total ? (sp) : total - 1; const int k_ = sp_ / NTL, t_ = sp_ % NTL; const BandDesc D_ = get(k_); \
        int j_ = D_.jstart + 64 * t_ + srow; j_ = j_ < 0 ? 0 : (j_ > D_.L - 1 ? D_.L - 1 : j_); const unsigned st_ = lbase + ((sp) & 3) * 16384 + wave * 1024; \
        ATT_GLDS(D_.Kb + (size_t)j_ * D_.kstride + kchs, st_); ATT_GLDS(D_.Vb + (size_t)j_ * D_.kstride + vchs, st_ + 8192); } while (0)
#define BAND_Q_DMA(ku, d0) do { const int ku_ = (ku) < nunits ? (ku) : nunits - 1; const BandDesc D_ = get(ku_); \
        ATT_GLDS(D_.qrow + 16 * (d0) + 8 * hh, lbase + 65536 + ((ku) & 1) * 32768 + wave * 4096 + (d0) * 1024); } while (0)
    BAND_Q_DMA(0, 0); BAND_Q_DMA(0, 1); BAND_Q_DMA(0, 2); BAND_Q_DMA(0, 3);
    BAND_TILE_DMA(0); BAND_TILE_DMA(1);
    asm volatile("s_waitcnt vmcnt(2)\n\ts_barrier" ::: "memory");
    bf16x8 q[4]; f32x16 O[2]; float m = 0.f, l = 0.f;
    O[0] = f32x16{}; O[1] = f32x16{};
#pragma unroll
    for (int d0 = 0; d0 < 4; ++d0) q[d0] = bf16x8{};
    int k = 0, t = 0;
    for (int s = 0; s < total; ++s) {
        BAND_TILE_DMA(s + 2); BAND_Q_DMA(k + 1, (t < 4 ? t : 3));
        const BandDesc D = get(k);
        if (t == 0) {
            const LAS unsigned char* qs = lds + 65536 + (k & 1) * 32768 + wave * 4096 + lane * 16;
#pragma unroll
            for (int d0 = 0; d0 < 4; ++d0) q[d0] = *(const LAS bf16x8*)(qs + d0 * 1024);
            O[0] = f32x16{}; O[1] = f32x16{}; m = D.m0; l = D.l0;
        }
        const LAS unsigned char* st = lds + (s & 3) * 16384;
        if (t >= D.tlo && t <= D.thi) {
            f32x16 s0, s1;
            qk_tile(s0, s1, st, q, kro, kx6);
            const int ts = D.jstart + 64 * t;
            if (!(ts >= D.qi0 + 31 - HALFW && ts + 63 <= D.qi0 + HALFW && ts >= 0 && ts + 63 < D.L)) {
                const int jb = ts + 4 * hh, qi = D.qi0 + r;
#pragma unroll
                for (int i = 0; i < 16; ++i) {
                    const int j0 = jb + (i & 3) + 8 * (i >> 2), j1 = j0 + 32;
                    if (!(((unsigned)j0 < (unsigned)D.L) && ((unsigned)(j0 - qi + HALFW) <= (unsigned)(2 * HALFW)))) s0[i] = -INFINITY;
                    if (!(((unsigned)j1 < (unsigned)D.L) && ((unsigned)(j1 - qi + HALFW) <= (unsigned)(2 * HALFW)))) s1[i] = -INFINITY;
                }
            }
            softmax_tile<2>(s0, s1, m, l, O, scr, r, hh);
            bf16x8 P[4]; P[0] = pack8<0>(s0); P[1] = pack8<1>(s0); P[2] = pack8<0>(s1); P[3] = pack8<1>(s1);
#pragma unroll
            for (int c = 0; c < 2; ++c)
#pragma unroll
                for (int kc = 0; kc < 4; ++kc) {
                    const LAS unsigned char* vp = st + vro + (vq6 ^ (c << 6)) + kc * 2048;
                    const bf16x8 vf = cat8(vtr(vp), vtr(vp + 1024));
                    O[c] = MFMA32(P[kc], vf, O[c]);
                }
        }
        if (t == NTL - 1 && D.tlo <= D.thi) {
            const float lt = hsum(l);
            if (hh == 0) scr[r] = 1.0f / lt;
            if (LSE_OUT) { if (hh == 0) D.lse[(size_t)(D.qi0 + r) * D.lstride] = m + log2f(lt); }
#pragma unroll
            for (int g = 0; g < 4; ++g) { const f32x4 a4 = *(const LAS f32x4*)(scr + 8 * g + 4 * hh);
#pragma unroll
                for (int kk = 0; kk < 4; ++kk) { bf16_t* op = D.out + (size_t)(D.qi0 + 8 * g + 4 * hh + kk) * D.ostride + r;
                    op[0] = (bf16_t)f2bf(O[0][4 * g + kk] * a4[kk]); op[32] = (bf16_t)f2bf(O[1][4 * g + kk] * a4[kk]); } }
        }
        asm volatile("s_waitcnt vmcnt(3) lgkmcnt(0)\n\ts_barrier" ::: "memory");
        if (++t == NTL) { t = 0; ++k; }
    }
    asm volatile("s_waitcnt vmcnt(0)\n\ts_barrier" ::: "memory");
#undef BAND_TILE_DMA
#undef BAND_Q_DMA
}

template <int NB>
ADI void softmax_tile8(f32x16& s0, f32x16& s1, float& m, float& l, f32x16 (&O)[NB], LAS float* scr, int r, int hh) {
    float mxa = max3f(s0[0], s0[1], s1[0]), mxb = max3f(s0[2], s0[3], s1[1]); mxa = max3f(mxa, s1[2], s1[3]);
#pragma unroll
    for (int i = 4; i < 16; i += 4) { mxa = max3f(mxa, s0[i], s0[i + 1]); mxb = max3f(mxb, s0[i + 2], s0[i + 3]); mxa = max3f(mxa, s1[i], s1[i + 1]); mxb = max3f(mxb, s1[i + 2], s1[i + 3]); }
    float mx = hmax(max3f(mxa, mxb, mxb));
    if (__any(mx > m + 4.0f)) {
        const float mn = fmaxf(m, mx), al = fexp2(m - mn); l *= al; m = mn;
        if (hh == 0) scr[r] = al;
#pragma unroll
        for (int g = 0; g < 4; ++g) { const f32x4 a4 = *(const LAS f32x4*)(scr + 8 * g + 4 * hh);
#pragma unroll
            for (int c = 0; c < NB; ++c) { O[c][4 * g] *= a4[0]; O[c][4 * g + 1] *= a4[1]; O[c][4 * g + 2] *= a4[2]; O[c][4 * g + 3] *= a4[3]; } }
    }
    const float m4 = m - 4.0f;
    float sa = 0.f, sb = 0.f, sc = 0.f, sd = 0.f;
#pragma unroll
    for (int i = 0; i < 16; i += 2) { s0[i] = fexp2(s0[i] - m4); s1[i] = fexp2(s1[i] - m4); s0[i + 1] = fexp2(s0[i + 1] - m4); s1[i + 1] = fexp2(s1[i + 1] - m4); sa += s0[i]; sb += s1[i]; sc += s0[i + 1]; sd += s1[i + 1]; }
    l += ((sa + sb) + (sc + sd)) * 0.0625f;
}

struct BandDesc8 { const unsigned char* Kb; const unsigned char* Vb; size_t kstride; int L, jstart; const unsigned char* qrow; int qi0, tlo, thi; float m0, l0; bf16_t* out; size_t ostride; float* lse; size_t lstride; };
template <int NTL, int HALFW, class F, bool OUT8 = false>
ADI void band_stream8(LAS unsigned char* lds, int nunits, const F& get, int tid, int lane, int wave) {
    static_assert(2 * NTL * 8192 + 32768 <= 132096, "LDS");
    const int r = lane & 31, hh = lane >> 5;
    const unsigned lbase = (unsigned)(uintptr_t)lds;
    const bool isV = wave >= 4;
    const int srow = 16 * (wave & 3) + (lane >> 2);
    const int soff = isV ? (((((lane >> 1) & 1) ^ ((srow >> 3) & 1)) << 5) + ((lane & 1) << 4)) : (((lane & 3) ^ ((srow >> 2) & 3)) << 4);
    const int kx = (r >> 2) & 3;
    const int kro0 = r * 64 + (((2 * hh) ^ kx) << 4), kro1 = r * 64 + (((2 * hh + 1) ^ kx) << 4);
    const int ts_ = lane & 15, tblk = (lane >> 4) & 1, te = ts_ >> 1, tcol = ts_ & 1;
    const int tkey = (te & 3) + 8 * (te >> 2) + 4 * hh, tfx = (te >> 2) & 1;
    const int vro = 4096 + tkey * 64 + 16 * tblk + 8 * tcol;
    LAS float* scr = (LAS float*)(lds + 132096 + wave * 256);
    const int sK = 0x7f7f7f7f, sQ = 0x7b7b7b7b, sP = 0x7b7b7b7b, sV = 0x7f7f7f7f;
#define B8_UNIT_DMA(ku) do { if ((ku) < nunits) { const BandDesc8 D_ = get(ku); \
        _Pragma("unroll") for (int ti_ = 0; ti_ < NTL; ++ti_) { int j_ = D_.jstart + 64 * ti_ + srow; j_ = j_ < 0 ? 0 : (j_ > D_.L - 1 ? D_.L - 1 : j_); \
            ATT_GLDS((isV ? D_.Vb : D_.Kb) + (size_t)j_ * D_.kstride + soff, lbase + ((ku) & 1) * (NTL * 8192) + ti_ * 8192 + wave * 1024); } \
        ATT_GLDS(D_.qrow + 32 * hh, lbase + 2 * NTL * 8192 + ((ku) & 1) * 16384 + wave * 2048); \
        ATT_GLDS(D_.qrow + 32 * hh + 16, lbase + 2 * NTL * 8192 + ((ku) & 1) * 16384 + wave * 2048 + 1024); } } while (0)
    B8_UNIT_DMA(0);
    asm volatile("s_waitcnt vmcnt(0)\n\ts_barrier" ::: "memory");
    for (int k = 0; k < nunits; ++k) {
        B8_UNIT_DMA(k + 1);
        const BandDesc8 D = get(k);
        const int tlo = __builtin_amdgcn_readfirstlane(D.tlo), thi = __builtin_amdgcn_readfirstlane(D.thi);
        if (tlo <= thi) {
            v8i_a q8; f32x16 O[2]; float m = D.m0, l = D.l0;
            {
                const LAS unsigned char* qs = lds + 2 * NTL * 8192 + (k & 1) * 16384 + wave * 2048 + lane * 16;
                const v4i_a qa = *(const LAS v4i_a*)qs, qb = *(const LAS v4i_a*)(qs + 1024);
                q8 = __builtin_shufflevector(qa, qb, 0, 1, 2, 3, 4, 5, 6, 7);
            }
            O[0] = f32x16{}; O[1] = f32x16{};
#pragma unroll 1
            for (int t = tlo; t <= thi; ++t) {
                const LAS unsigned char* st = lds + (k & 1) * (NTL * 8192) + t * 8192;
                f32x16 s0, s1;
                {
                    const v4i_a a0 = *(const LAS v4i_a*)(st + kro0), a1 = *(const LAS v4i_a*)(st + kro1), b0 = *(const LAS v4i_a*)(st + 2048 + kro0), b1 = *(const LAS v4i_a*)(st + 2048 + kro1);
                    const v8i_a k0 = __builtin_shufflevector(a0, a1, 0, 1, 2, 3, 4, 5, 6, 7), k1 = __builtin_shufflevector(b0, b1, 0, 1, 2, 3, 4, 5, 6, 7);
                    asm volatile("v_mfma_scale_f32_32x32x64_f8f6f4 %0, %2, %4, 0, %5, %6 op_sel_hi:[0,0,0]\n\tv_mfma_scale_f32_32x32x64_f8f6f4 %1, %3, %4, 0, %5, %6 op_sel_hi:[0,0,0]\n\ts_nop 15\n\ts_nop 7"
                                 : "=&v"(s0), "=&v"(s1) : "v"(k0), "v"(k1), "v"(q8), "v"(sK), "v"(sQ));
                }
                const int ts = D.jstart + 64 * t;
                if (!(ts >= D.qi0 + 31 - HALFW && ts + 63 <= D.qi0 + HALFW && ts >= 0 && ts + 63 < D.L)) {
                    const int jb = ts + 4 * hh, qi = D.qi0 + r;
#pragma unroll
                    for (int i = 0; i < 16; ++i) {
                        const int j0 = jb + (i & 3) + 8 * (i >> 2), j1 = j0 + 32;
                        if (!(((unsigned)j0 < (unsigned)D.L) && ((unsigned)(j0 - qi + HALFW) <= (unsigned)(2 * HALFW)))) s0[i] = -INFINITY;
                        if (!(((unsigned)j1 < (unsigned)D.L) && ((unsigned)(j1 - qi + HALFW) <= (unsigned)(2 * HALFW)))) s1[i] = -INFINITY;
                    }
                }
                softmax_tile8<2>(s0, s1, m, l, O, scr, r, hh);
                v8i_a P8;
#pragma unroll
                for (int g = 0; g < 4; ++g) { P8[g] = (int)pk_fp8x4_nc(s0[4 * g], s0[4 * g + 1], s0[4 * g + 2], s0[4 * g + 3]); P8[4 + g] = (int)pk_fp8x4_nc(s1[4 * g], s1[4 * g + 1], s1[4 * g + 2], s1[4 * g + 3]); }
#pragma unroll
                for (int c = 0; c < 2; ++c) {
                    const LAS unsigned char* vp = st + vro + ((c ^ tfx) << 5);
                    const v2i_a t0 = __builtin_amdgcn_ds_read_tr8_b64_v2i32((LAS v2i_a*)(vp)), t1 = __builtin_amdgcn_ds_read_tr8_b64_v2i32((LAS v2i_a*)(vp + 16 * 64));
                    const v2i_a t2 = __builtin_amdgcn_ds_read_tr8_b64_v2i32((LAS v2i_a*)(vp + 32 * 64)), t3 = __builtin_amdgcn_ds_read_tr8_b64_v2i32((LAS v2i_a*)(vp + 48 * 64));
                    const v8i_a V8 = (v8i_a){t0[0], t0[1], t1[0], t1[1], t2[0], t2[1], t3[0], t3[1]};
                    asm volatile("s_nop 3\n\tv_mfma_scale_f32_32x32x64_f8f6f4 %0, %1, %2, %0, %3, %4 op_sel_hi:[0,0,0]" : "+v"(O[c]) : "v"(P8), "v"(V8), "v"(sP), "v"(sV));
                }
            }
            asm volatile("s_nop 15\n\ts_nop 15" ::: "memory");
            const float lt = hsum(l);
            if (hh == 0) scr[r] = 1.0f / lt;
            asm volatile("s_waitcnt vmcnt(0)" ::: "memory");
            if (hh == 0 && D.lse != nullptr) D.lse[(size_t)(D.qi0 + r) * D.lstride] = m + log2f(lt);
#pragma unroll
            for (int g = 0; g < 4; ++g) { const f32x4 a4 = *(const LAS f32x4*)(scr + 8 * g + 4 * hh);
#pragma unroll
                for (int kk = 0; kk < 4; ++kk) {
                    if constexpr (OUT8) { unsigned char* op = (unsigned char*)D.out + (size_t)(D.qi0 + 8 * g + 4 * hh + kk) * D.ostride + r;
                        op[0] = fp8_byte(O[0][4 * g + kk] * a4[kk]); op[32] = fp8_byte(O[1][4 * g + kk] * a4[kk]); }
                    else { bf16_t* op = D.out + (size_t)(D.qi0 + 8 * g + 4 * hh + kk) * D.ostride + r;
                    op[0] = (bf16_t)f2bf(O[0][4 * g + kk] * a4[kk]); op[32] = (bf16_t)f2bf(O[1][4 * g + kk] * a4[kk]); } } }
        } else {
            asm volatile("s_waitcnt vmcnt(0)" ::: "memory");
        }
        asm volatile("s_waitcnt lgkmcnt(0)\n\ts_barrier" ::: "memory");
    }
    asm volatile("s_waitcnt vmcnt(0)\n\ts_barrier" ::: "memory");
#undef B8_UNIT_DMA
}
}

__device__ __forceinline__ void attn_B(const Ctx& C) {
    const bf16_t* QKV = WSP(bf16_t, WS_BIG + BIG_QKV); bf16_t* O = WSP(bf16_t, WS_O); const float* subln = IN_F(15);
    const float lam = diff_lambda(C);
    const int vcu = (C.G % 8 == 0) ? (C.bid % 8) * (C.G / 8) + C.bid / 8 : C.bid;
    for (int u = vcu; u < 1024; u += C.G) {
        const int k = u / C.G, v = u % C.G; int bh, qb;
        if (C.G == 256) { bh = v >> 4; qb = (v & 15) * 4 + k; } else { bh = u >> 6; qb = u & 63; }
        att::diff_unit(C.lds, (const unsigned char*)QKV, O, subln, lam, bh >> 3, bh & 7, qb, C.tid, C.lane, C.wave);
    }
}

struct GetA {
    const bf16_t* QKV; bf16_t* OG; float* LSE; int vcu, G, wave, r;
    __device__ __forceinline__ att::BandDesc operator()(int k) const {
        const int U = vcu + k * G; att::BandDesc D;
        const bool ok = U < 3072; const int Uc = ok ? U : 0;
        const int v = Uc & 31, t3 = Uc >> 5, gi = t3 % 3, bh = t3 / 3, b = bh >> 4, h = bh & 15;
        const int sh = 2 * gi, dil = 1 << sh, Lg = SEQ >> sh, nqb = 32 >> sh, res = v >> (5 - sh), i0 = (v & (nqb - 1)) << 8;
        const size_t tok0 = (size_t)b * SEQ + res;
        const bf16_t* base = QKV + tok0 * NQKV_A + gi * 3072 + h * 64;
        D.Kb = base + 1024; D.Vb = base + 2048; D.kstride = (size_t)dil * NQKV_A; D.L = Lg; D.jstart = i0 - 64;
        D.qi0 = i0 + 32 * wave; D.tlo = ok ? (wave >> 1) : 1; D.thi = ok ? ((32 * wave + 159) >> 6) : 0; D.m0 = -1e30f; D.l0 = 0.f;
        D.qrow = base + (size_t)(D.qi0 + r) * dil * NQKV_A;
        D.out = OG + ((size_t)gi * NTOK + tok0) * DM + h * 64; D.ostride = (size_t)dil * DM;
        D.lse = LSE + ((size_t)gi * NTOK + tok0) * 16 + h; D.lstride = (size_t)dil * 16;
        return D;
    }
};
struct GetA8 {
    const unsigned char* QKV8; bf16_t* OG; float* LSE; int vcu, G, wave, r;
    __device__ __forceinline__ att::BandDesc8 operator()(int k) const {
        const int U = vcu + k * G; att::BandDesc8 D;
        const bool ok = U < 3072; const int Uc = ok ? U : 0;
        const int v = Uc & 31, t3 = Uc >> 5, gi = t3 % 3, bh = t3 / 3, b = bh >> 4, h = bh & 15;
        const int sh = 2 * gi, dil = 1 << sh, Lg = SEQ >> sh, nqb = 32 >> sh, res = v >> (5 - sh), i0 = (v & (nqb - 1)) << 8;
        const size_t tok0 = (size_t)b * SEQ + res;
        const unsigned char* base = QKV8 + (size_t)(3 * gi) * ((size_t)NTOK * 1024) + (size_t)((b * 16 + h) * SEQ + res * Lg) * 64;
        D.Kb = base + (size_t)NTOK * 1024; D.Vb = base + (size_t)2 * NTOK * 1024; D.kstride = 64; D.L = Lg; D.jstart = i0 - 64;
        D.qi0 = i0 + 32 * wave; D.tlo = ok ? (wave >> 1) : 1; D.thi = ok ? ((32 * wave + 159) >> 6) : 0; D.m0 = -1e30f; D.l0 = 0.f;
        D.qrow = base + (size_t)(D.qi0 + r) * 64;
        D.out = (bf16_t*)((unsigned char*)OG + ((size_t)gi * NTOK + tok0) * DM + h * 64); D.ostride = (size_t)dil * DM;
        D.lse = LSE + ((size_t)gi * NTOK + tok0) * 16 + h; D.lstride = (size_t)dil * 16;
        return D;
    }
};
__device__ __forceinline__ void attn_A8(const Ctx& C) {
    GetA8 g; g.QKV8 = WSP(unsigned char, WS_BIG + BIG_QKV); g.OG = WSP(bf16_t, WS_BIG + BIG_OG); g.LSE = WSP(float, WS_LSE);
    g.vcu = (C.G % 8 == 0) ? (C.bid % 8) * (C.G / 8) + C.bid / 8 : C.bid; g.G = C.G; g.wave = C.wave; g.r = C.lane & 31;
    att::band_stream8<6, 64, GetA8, true>(C.lds, (3072 + C.G - 1) / C.G, g, C.tid, C.lane, C.wave);
}
__device__ __forceinline__ void attn_A(const Ctx& C) {
    GetA g; g.QKV = WSP(bf16_t, WS_BIG + BIG_QKV); g.OG = WSP(bf16_t, WS_BIG + BIG_OG); g.LSE = WSP(float, WS_LSE);
    g.vcu = (C.G % 8 == 0) ? (C.bid % 8) * (C.G / 8) + C.bid / 8 : C.bid; g.G = C.G; g.wave = C.wave; g.r = C.lane & 31;
    att::band_stream<6, 64, true, GetA>(C.lds, (3072 + C.G - 1) / C.G, g, C.tid, C.lane, C.wave);
}
struct GetC {
    const bf16_t* QKV; bf16_t* O; float sk0, sk1; int vcu, G, wave, r, hh;
    __device__ __forceinline__ att::BandDesc operator()(int k) const {
        const int U = vcu + k * G; att::BandDesc D;
        const bool ok = U < 1024; const int Uc = ok ? U : 0;
        const int qblk = Uc & 255, bg = Uc >> 8, b = bg >> 1, g = bg & 1, i0 = qblk * 32, head = 8 * g + wave;
        const bf16_t* base = QKV + (size_t)b * SEQ * NQKV_C;
        D.Kb = base + 1024 + g * 64; D.Vb = base + 1152 + g * 64; D.kstride = (size_t)NQKV_C; D.L = SEQ; D.jstart = i0 - 128;
        D.qi0 = i0; D.tlo = ok ? 0 : 1; D.thi = ok ? 4 : 0; D.m0 = (g ? sk1 : sk0) * LOG2E; D.l0 = hh == 0 ? 1.f : 0.f;
        D.qrow = base + (size_t)(i0 + r) * NQKV_C + head * 64;
        D.out = O + (size_t)b * SEQ * DM + head * 64; D.ostride = DM; D.lse = nullptr; D.lstride = 0;
        return D;
    }
};
struct GetC8 {
    const unsigned char* QKV8; bf16_t* O; float sk0, sk1; int vcu, G, wave, r, hh;
    __device__ __forceinline__ att::BandDesc8 operator()(int k) const {
        const int U = vcu + k * G; att::BandDesc8 D;
        const bool ok = U < 1024; const int Uc = ok ? U : 0;
        const int qblk = Uc & 255, bg = Uc >> 8, b = bg >> 1, g = bg & 1, i0 = qblk * 32, head = 8 * g + wave;
        const unsigned char* base = QKV8 + (size_t)b * SEQ * NQKV_C;
        D.Kb = base + 1024 + g * 64; D.Vb = base + 1152 + g * 64; D.kstride = (size_t)NQKV_C; D.L = SEQ; D.jstart = i0 - 128;
        D.qi0 = i0; D.tlo = ok ? 0 : 1; D.thi = ok ? 4 : 0; D.m0 = (g ? sk1 : sk0) * LOG2E; D.l0 = hh == 0 ? 1.f : 0.f;
        D.qrow = base + (size_t)(i0 + r) * NQKV_C + head * 64;
        D.out = (bf16_t*)((unsigned char*)O + (size_t)b * SEQ * DM + head * 64); D.ostride = DM; D.lse = nullptr; D.lstride = 0;
        return D;
    }
};
__device__ __forceinline__ void attn_C8(const Ctx& C) {
    GetC8 g; g.QKV8 = WSP(unsigned char, WS_BIG + BIG_QKV); g.O = WSP(bf16_t, WS_O); g.sk0 = IN_F(24)[C.wave]; g.sk1 = IN_F(24)[8 + C.wave];
    g.vcu = (C.G % 8 == 0) ? (C.bid % 8) * (C.G / 8) + C.bid / 8 : C.bid; g.G = C.G; g.wave = C.wave; g.r = C.lane & 31; g.hh = C.lane >> 5;
    asm volatile("s_waitcnt vmcnt(0)" ::: "memory");
    att::band_stream8<5, 128, GetC8, true>(C.lds, (1024 + C.G - 1) / C.G, g, C.tid, C.lane, C.wave);
}
__device__ __forceinline__ void attn_C(const Ctx& C) {
    GetC g; g.QKV = WSP(bf16_t, WS_BIG + BIG_QKV); g.O = WSP(bf16_t, WS_O); g.sk0 = IN_F(24)[C.wave]; g.sk1 = IN_F(24)[8 + C.wave];
    g.vcu = (C.G % 8 == 0) ? (C.bid % 8) * (C.G / 8) + C.bid / 8 : C.bid; g.G = C.G; g.wave = C.wave; g.r = C.lane & 31; g.hh = C.lane >> 5;
    asm volatile("s_waitcnt vmcnt(0)" ::: "memory");
    att::band_stream<5, 128, false, GetC>(C.lds, (1024 + C.G - 1) / C.G, g, C.tid, C.lane, C.wave);
}

__device__ __forceinline__ void combine_A(const Ctx& C) {
    const bf16_t* OG = WSP(bf16_t, WS_BIG + BIG_OG); const float* LSE = WSP(float, WS_LSE); bf16_t* O = WSP(bf16_t, WS_O);
    const int gw = C.bid * 8 + C.wave, NGW = C.G * 8, lane = C.lane, h = lane >> 2;
    for (int tok = gw; tok < NTOK; tok += NGW) {
        const float L0 = LSE[((size_t)0 * NTOK + tok) * 16 + h], L1 = LSE[((size_t)1 * NTOK + tok) * 16 + h], L2 = LSE[((size_t)2 * NTOK + tok) * 16 + h];
        const float M = fmaxf(L0, fmaxf(L1, L2));
        float w0 = exp2f(L0 - M), w1 = exp2f(L1 - M), w2 = exp2f(L2 - M); const float inv = 1.0f / (w0 + w1 + w2); w0 *= inv; w1 *= inv; w2 *= inv;
        u32x4 o8;
        {
            const unsigned char* OG8 = (const unsigned char*)OG; const size_t off = (size_t)tok * DM + lane * 16;
            const u32x4 a = *(const u32x4*)(OG8 + off), b = *(const u32x4*)(OG8 + (size_t)NTOK * DM + off), d = *(const u32x4*)(OG8 + (size_t)2 * NTOK * DM + off);
#pragma unroll
            for (int i = 0; i < 4; ++i) {
                const f32x2 a0 = __builtin_amdgcn_cvt_pk_f32_fp8((int)a[i], false), a1 = __builtin_amdgcn_cvt_pk_f32_fp8((int)a[i], true);
                const f32x2 b0 = __builtin_amdgcn_cvt_pk_f32_fp8((int)b[i], false), b1 = __builtin_amdgcn_cvt_pk_f32_fp8((int)b[i], true);
                const f32x2 d0 = __builtin_amdgcn_cvt_pk_f32_fp8((int)d[i], false), d1 = __builtin_amdgcn_cvt_pk_f32_fp8((int)d[i], true);
                o8[i] = pk_fp8x4(w0 * a0[0] + w1 * b0[0] + w2 * d0[0], w0 * a0[1] + w1 * b0[1] + w2 * d0[1], w0 * a1[0] + w1 * b1[0] + w2 * d1[0], w0 * a1[1] + w1 * b1[1] + w2 * d1[1]);
            }
        }
        *(u32x4*)((unsigned char*)O + (size_t)tok * DM + lane * 16) = o8;
    }
}

template <int N, int MASK>
__device__ __forceinline__ void halve_step(float (&v)[64], int lane) {
    const bool up = (lane & MASK) != 0;
#pragma unroll
    for (int i = 0; i < N / 2; ++i) { const float keep = up ? v[i + N / 2] : v[i], send = up ? v[i] : v[i + N / 2]; v[i] = keep + __shfl_xor(send, MASK); }
}
__device__ __forceinline__ void moe_router(const Ctx& C, const float* gain, const float* router) {
    const bf16_t* X = WSP(bf16_t, WS_XB);
    LAS float* grt = (LAS float*)C.lds;
    LAS int* tE = (LAS int*)(C.lds + 32768); LAS float* tG0 = (LAS float*)(C.lds + 32768 + 256); LAS float* tG1 = (LAS float*)(C.lds + 32768 + 512);
    for (int i = C.tid; i < 8192; i += 512) { const int k = i >> 3, e = i & 7; grt[e * 1024 + k] = gain[k] * router[i]; }
    __syncthreads();
    int* gE = WSP(int, WS_TOK + TOK_E); float* gG0 = WSP(float, WS_TOK + TOK_G0); float* gG1 = WSP(float, WS_TOK + TOK_G1); int* gR = WSP(int, WS_TOK + TOK_RANK); int* hist = WSP(int, WS_TOK + TOK_HIST);
    const int lane = C.lane;
    for (int chunk = C.bid; chunk < NTOK / 64; chunk += C.G) {
        float v[64]; float sv[64];
        u32x2 raw[8][4];
#pragma unroll
        for (int j = 0; j < 8; ++j) { const u32x2* xr = (const u32x2*)(X + (size_t)(chunk * 64 + C.wave * 8 + j) * DM) + lane;
#pragma unroll
            for (int jj = 0; jj < 4; ++jj) raw[j][jj] = xr[64 * jj]; }
        asm volatile("" ::: "memory");
#pragma unroll
        for (int j = 0; j < 8; ++j) {
            f32x4 x[4]; float ss = 0.f;
#pragma unroll
            for (int jj = 0; jj < 4; ++jj) { const u32x2 w = raw[j][jj]; x[jj] = (f32x4){bflo(w.x), bfhi(w.x), bflo(w.y), bfhi(w.y)}; ss += (x[jj][0] * x[jj][0] + x[jj][1] * x[jj][1]) + (x[jj][2] * x[jj][2] + x[jj][3] * x[jj][3]); }
            sv[j] = ss;
#pragma unroll
            for (int e = 0; e < 8; ++e) { float a = 0.f;
#pragma unroll
                for (int jj = 0; jj < 4; ++jj) { const f32x4 w = *(const LAS f32x4*)(grt + e * 1024 + (64 * jj + lane) * 4); a += x[jj][0] * w[0]; a += x[jj][1] * w[1]; a += x[jj][2] * w[2]; a += x[jj][3] * w[3]; }
                v[j * 8 + e] = a; }
        }
        halve_step<64, 32>(v, lane); halve_step<32, 16>(v, lane); halve_step<16, 8>(v, lane); halve_step<8, 4>(v, lane); halve_step<4, 2>(v, lane); halve_step<2, 1>(v, lane);
        halve_step<8, 32>(sv, lane); halve_step<4, 16>(sv, lane); halve_step<2, 8>(sv, lane);
        float ss = sv[0]; ss += __shfl_xor(ss, 1); ss += __shfl_xor(ss, 2); ss += __shfl_xor(ss, 4);
        const float rstd = 1.0f / sqrtf(ss * (1.0f / 1024.0f) + NORM_EPS);
        const float val = v[0]; const int idx = lane & 7;
        float v0 = val; int e0 = idx;
#pragma unroll
        for (int o = 1; o < 8; o <<= 1) { const float ov = __shfl_xor(v0, o); const int oi = __shfl_xor(e0, o); if (ov > v0 || (ov == v0 && oi < e0)) { v0 = ov; e0 = oi; } }
        float v1 = (idx == e0) ? -INFINITY : val; int e1 = idx;
#pragma unroll
        for (int o = 1; o < 8; o <<= 1) { const float ov = __shfl_xor(v1, o); const int oi = __shfl_xor(e1, o); if (ov > v1 || (ov == v1 && oi < e1)) { v1 = ov; e1 = oi; } }
        const float ex = expf((v1 - v0) * rstd), g0 = 1.0f / (1.0f + ex), g1 = ex / (1.0f + ex);
        if (idx == 0) { const int tl = C.wave * 8 + (lane >> 3); tE[tl] = e0 | (e1 << 8); tG0[tl] = g0; tG1[tl] = g1; }
        __syncthreads();
        if (C.wave == 0) {
            const int ee = tE[C.lane], f0 = ee & 255, f1 = ee >> 8; int r0 = 0, r1 = 0;
            const unsigned long long lt = (1ull << C.lane) - 1ull;
#pragma unroll
            for (int e = 0; e < 8; ++e) {
                const unsigned long long b0 = __ballot(f0 == e), b1 = __ballot(f1 == e);
                const int before = __popcll(b0 & lt) + __popcll(b1 & lt);
                if (f0 == e) r0 = before; if (f1 == e) r1 = before;
                if (C.lane == 0) hist[chunk * 8 + e] = __popcll(b0) + __popcll(b1);
            }
            const int tok = chunk * 64 + C.lane;
            gE[tok] = ee; gG0[tok] = tG0[C.lane]; gG1[tok] = tG1[C.lane]; gR[tok] = r0 | (r1 << 16);
        }
        __syncthreads();
    }
}
__device__ __forceinline__ void moe_gather(const Ctx& C) {
    const bf16_t* X = WSP(bf16_t, WS_XB); unsigned char* XBUF = WSP(unsigned char, WS_BIG + BIG_XBUF);
    const int* gE = WSP(int, WS_TOK + TOK_E); const int* gR = WSP(int, WS_TOK + TOK_RANK); const int* hist = WSP(int, WS_TOK + TOK_HIST);
    int* gD0 = WSP(int, WS_TOK + TOK_D0); int* gD1 = WSP(int, WS_TOK + TOK_D1); int* pendg = WSP(int, WS_TOK + TOK_PEND);
    LAS int* pre = (LAS int*)C.lds;
    LAS int* tot = (LAS int*)(C.lds + 8192);
    {
        const int e = C.wave; int h4[4]; int s = 0;
#pragma unroll
        for (int i = 0; i < 4; ++i) { h4[i] = hist[(4 * C.lane + i) * 8 + e]; s += h4[i]; }
        int inc = s;
#pragma unroll
        for (int o = 1; o < 64; o <<= 1) { const int t = __shfl_up(inc, o); if (C.lane >= o) inc += t; }
        int ex = inc - s;
#pragma unroll
        for (int i = 0; i < 4; ++i) { pre[(4 * C.lane + i) * 8 + e] = ex; ex += h4[i]; }
        if (C.lane == 63) tot[e] = inc;
    }
    __syncthreads();
    if (C.tid == 0) { int p = 0; for (int e = 0; e < 8; ++e) { tot[8 + e] = p; p += ((tot[e] + 255) >> 8) << 8; tot[16 + e] = p; } }
    __syncthreads();
    if (C.bid == 0 && C.tid < 8) pendg[C.tid] = tot[16 + C.tid];
    if (C.bid == 0 && C.tid == 8) pendg[8] = tot[23] >> 8;
    for (int chunk = C.bid; chunk < NTOK / 64; chunk += C.G) {
        for (int tl = C.wave * 8; tl < C.wave * 8 + 8; ++tl) {
            const int tok = chunk * 64 + tl;
            const int ee = gE[tok], e0 = ee & 255, e1 = ee >> 8, rr = gR[tok];
            const int d0 = tot[8 + e0] + pre[chunk * 8 + e0] + (rr & 0xffff), d1 = tot[8 + e1] + pre[chunk * 8 + e1] + (rr >> 16);
            if (C.lane == 0) { gD0[tok] = d0; gD1[tok] = d1; }
            const u32x2* xr = (const u32x2*)(X + (size_t)tok * DM) + C.lane;
            f32x4 v[4]; float ss = 0.f;
#pragma unroll
            for (int j = 0; j < 4; ++j) { const u32x2 w = xr[64 * j]; v[j] = (f32x4){bflo(w.x), bfhi(w.x), bflo(w.y), bfhi(w.y)}; ss += (v[j][0] * v[j][0] + v[j][1] * v[j][1]) + (v[j][2] * v[j][2] + v[j][3] * v[j][3]); }
            const float rstd = 1.0f / sqrtf(wave_sum(ss) * (1.0f / 1024.0f) + NORM_EPS);
            unsigned* o0 = (unsigned*)(XBUF + (size_t)d0 * DM) + C.lane; unsigned* o1 = (unsigned*)(XBUF + (size_t)d1 * DM) + C.lane;
#pragma unroll
            for (int j = 0; j < 4; ++j) { const unsigned w = pk_fp8x4(v[j][0] * rstd, v[j][1] * rstd, v[j][2] * rstd, v[j][3] * rstd); o0[64 * j] = w; o1[64 * j] = w; }
        }
    }
    if (C.bid < 8) {
        const int e = C.bid, r0 = tot[8 + e] + tot[e], r1 = tot[16 + e];
        for (int i = C.tid; i < (r1 - r0) * 64; i += 512) *((u32x4*)(XBUF + (size_t)r0 * DM) + i) = (u32x4){0u, 0u, 0u, 0u};
    }
}
template <bool FINAL>
__device__ __forceinline__ void moe_combine(const Ctx& C, const float* gfinal) {
    bf16_t* XB = WSP(bf16_t, WS_XB); float* ssq = WSP(float, WS_SSQ); const bf16_t* Y = WSP(bf16_t, WS_BIG + BIG_YBUF);
    const float* gG0 = WSP(float, WS_TOK + TOK_G0); const float* gG1 = WSP(float, WS_TOK + TOK_G1); const int* gD0 = WSP(int, WS_TOK + TOK_D0); const int* gD1 = WSP(int, WS_TOK + TOK_D1);
    const int gw = C.bid * 8 + C.wave, NGW = C.G * 8;
    for (int tok = gw; tok < NTOK; tok += NGW) {
        const float g0 = gG0[tok], g1 = gG1[tok]; const int d0 = gD0[tok], d1 = gD1[tok];
        const u32x2* xr = (const u32x2*)(XB + (size_t)tok * DM) + C.lane;
        const u32x2* y0 = (const u32x2*)(Y + (size_t)d0 * DM) + C.lane; const u32x2* y1 = (const u32x2*)(Y + (size_t)d1 * DM) + C.lane;
        f32x4 v[4]; float ss = 0.f;
#pragma unroll
        for (int j = 0; j < 4; ++j) { const u32x2 xw = xr[64 * j]; const f32x4 x = (f32x4){bflo(xw.x), bfhi(xw.x), bflo(xw.y), bfhi(xw.y)}; const u32x2 a = y0[64 * j], b = y1[64 * j];
            v[j][0] = x[0] + g0 * bflo(a.x) + g1 * bflo(b.x); v[j][1] = x[1] + g0 * bfhi(a.x) + g1 * bfhi(b.x);
            v[j][2] = x[2] + g0 * bflo(a.y) + g1 * bflo(b.y); v[j][3] = x[3] + g0 * bfhi(a.y) + g1 * bfhi(b.y);
            ss += (v[j][0] * v[j][0] + v[j][1] * v[j][1]) + (v[j][2] * v[j][2] + v[j][3] * v[j][3]); }
        const float tot = wave_sum(ss);
        if (FINAL) {
            const float rstd = 1.0f / sqrtf(tot * (1.0f / 1024.0f) + NORM_EPS);
            f32x4* o = (f32x4*)(C.out + (size_t)tok * DM) + C.lane; const f32x4* gf = (const f32x4*)gfinal + C.lane;
#pragma unroll
            for (int j = 0; j < 4; ++j) { const f32x4 g = gf[64 * j]; o[64 * j] = v[j] * rstd * g; }
        } else {
            u32x2* bo = (u32x2*)(XB + (size_t)tok * DM) + C.lane; unsigned* b8 = (unsigned*)(WSP(unsigned char, WS_X8) + (size_t)tok * DM) + C.lane;
#pragma unroll
            for (int j = 0; j < 4; ++j) { u32x2 w; w.x = pk2(v[j][0], v[j][1]); w.y = pk2(v[j][2], v[j][3]); bo[64 * j] = w; b8[64 * j] = pk_fp8x4(v[j][0], v[j][1], v[j][2], v[j][3]); }
            write_ssq_row(ssq, tok, tot, C.lane);
        }
    }
}

constexpr int RTAB_OFF = 134144, RTAB_UNITS = 13;
template <class Epi, bool FP8 = false>
__device__ __forceinline__ void dense_gemm(const Ctx& C, const bf16_t* A, const bf16_t* Bt, int M, int N, int K, const Epi& E, const float* ssq = nullptr, int sx = SC_ONE) {
    pg8::Gemm g{A, Bt, M, N, FP8 ? K / 2 : K, 0, SC_W8, sx}; pg8::StaticOrder S; S.init(M, N, C.G, C.bid);
    if (ssq) {
        LAS float* tab = (LAS float*)(C.lds + RTAB_OFF); pg8::Unit u;
        for (int i = C.tid >> 8; i < RTAB_UNITS && S.next(i, u); i += 2) tab[i * 256 + (C.tid & 255)] = pg8::row_rstd(ssq, u.pm * 256 + (C.tid & 255));
        __syncthreads();
    }
    pg8::gemm_phase<Epi, pg8::StaticOrder, FP8>(C.lds, g, S, E);
}
template <class Epi>
__device__ __forceinline__ void moe_gemm(const Ctx& C, const bf16_t* A, const bf16_t* Bt, int NC, int K, const Epi& E) {
    const int* pendg = WSP(int, WS_TOK + TOK_PEND);
    pg8::GroupedOrder S; S.NC = NC; S.G = C.G; S.c = C.bid;
#pragma unroll
    for (int e = 0; e < 8; ++e) S.pend[e] = __builtin_amdgcn_readfirstlane(pendg[e]);
    S.RT = __builtin_amdgcn_readfirstlane(pendg[8]);
    pg8::Gemm g{A, Bt, S.RT * 256, NC * 256, K / 2, 0, SC_W8, SC_ONE};
    pg8::gemm_phase<Epi, pg8::GroupedOrder, true>(C.lds, g, S, E);
}

constexpr int DOWN_NSL = 7, DOWN_SNT = 4;
__device__ __forceinline__ void moe_gemm_down(const Ctx& C, const bf16_t* A, const bf16_t* Bt, bf16_t* Y, float* part) {
    const int* pendg = WSP(int, WS_TOK + TOK_PEND);
    pg8::GroupedOrderK S; S.NC = 4; S.G = C.G; S.c = C.bid; S.NSL = DOWN_NSL; S.SNT = DOWN_SNT;
#pragma unroll
    for (int e = 0; e < 8; ++e) S.pend[e] = __builtin_amdgcn_readfirstlane(pendg[e]);
    S.RT = __builtin_amdgcn_readfirstlane(pendg[8]);
    const int full = 2 * C.G / 4, rtf = S.RT < full ? S.RT : full;
    pg8::Gemm g{A, Bt, S.RT * 256, 1024, FFE / 2, 0, SC_W8, SC_H8};
    pg8::EpiPlainK E{Y, DM, part, rtf, DOWN_NSL};
    pg8::gemm_phase<pg8::EpiPlainK, pg8::GroupedOrderK, true>(C.lds, g, S, E);
}
__device__ __forceinline__ void moe_down_reduce(const Ctx& C, bf16_t* Y, const float* part) {
    const int* pendg = WSP(int, WS_TOK + TOK_PEND);
    const int RT = pendg[8], full = 2 * C.G / 4, rtf = RT < full ? RT : full;
    const int nitems = (RT - rtf) * 256 * 128;
    for (int it = C.bid * 512 + C.tid; it < nitems; it += C.G * 512) {
        const int cg = it & 127, row = it >> 7, trel = row >> 8, lr = row & 255, ct = cg >> 5, lc = (cg & 31) * 8;
        const float* p = part + (size_t)((trel * 4 + ct) * DOWN_NSL) * 65536 + (size_t)lr * 256 + lc;
        f32x4 a = (f32x4){0.f, 0.f, 0.f, 0.f}, b = a;
#pragma unroll
        for (int ks = 0; ks < DOWN_NSL; ++ks) { a += *(const f32x4*)(p + (size_t)ks * 65536); b += *(const f32x4*)(p + (size_t)ks * 65536 + 4); }
        u32x4 w; w.x = pk2(a[0], a[1]); w.y = pk2(a[2], a[3]); w.z = pk2(b[0], b[1]); w.w = pk2(b[2], b[3]);
        *(u32x4*)(Y + (size_t)((rtf + trel) * 256 + lr) * DM + ct * 256 + lc) = w;
    }
}

constexpr int N_PHASES = 29;
struct Args { const void* in[39]; float* out; unsigned char* ws; int ph_lo, ph_hi; };

__global__ void __launch_bounds__(512, 2) fwd_kernel(Args args) {
    extern __shared__ __attribute__((aligned(16))) unsigned char lds_raw[];
    Ctx C0;
    C0.lds = (LAS unsigned char*)lds_raw; C0.ws = args.ws; C0.in = args.in; C0.out = args.out;
    C0.tid = threadIdx.x; C0.lane = C0.tid & 63; C0.wave = __builtin_amdgcn_readfirstlane(C0.tid >> 6); C0.G = gridDim.x; C0.bid = blockIdx.x;
    const Ctx& C = C0;
    volatile LAS unsigned* MISC = (volatile LAS unsigned*)(C.lds + MISC_OFF);
    for (int u = C.tid; u < (LDS_BYTES - RING_BYTES) / 4; u += 512) ((LAS unsigned*)(C.lds + RING_BYTES))[u] = 0u;
    __syncthreads();
    XcdBarrier bar; bar.bar = WSP(unsigned, WS_CTL) + CW_BAR; bar.x = 0; bar.st = nullptr;
    if (MK_SINGLE) bar = xcd_barrier_post(WSP(unsigned, WS_CTL) + CW_BAR, MISC + 8);
    const int lo = args.ph_lo, hi = args.ph_hi;
#define IN(k) (lo <= (k) && (k) < hi)
#define SEAM(k) do { if (IN(k) && IN((k) + 1)) xcd_barrier(bar); else __syncthreads(); } while (0)
#define PHASE(k, ...) if (IN(k)) { Ctx C = C0; { int t_ = (int)threadIdx.x; asm volatile("" : "+v"(t_)); C.tid = t_; C.lane = t_ & 63; } { __VA_ARGS__ } if (PROBE_PHASE == (k)) { xcd_barrier(bar); { __VA_ARGS__ } } } SEAM(k);

    const LAS float* const RTAB = (const LAS float*)(C.lds + RTAB_OFF);
    bf16_t* const XB = WSP(bf16_t, WS_XB); float* const SSQ = WSP(float, WS_SSQ); const float* const ROPE = WSP(float, WS_ROPE);
    bf16_t* const QKV = WSP(bf16_t, WS_BIG + BIG_QKV); bf16_t* const OB = WSP(bf16_t, WS_O); bf16_t* const HB = WSP(bf16_t, WS_BIG + BIG_H);
    bf16_t* const XBUF = WSP(bf16_t, WS_BIG + BIG_XBUF); bf16_t* const YBUF = WSP(bf16_t, WS_BIG + BIG_YBUF); bf16_t* const HBUF = WSP(bf16_t, WS_BIG + BIG_HBUF);

    PHASE(0, convert_weights_first(C); rope_table(C); x_to_bf16(C);)
    PHASE(1, pg8::EpiQKV E{QKV, NQKV_A, RTAB, ROPE, 3072, 2048, nullptr, (unsigned char*)QKV, 1}; dense_gemm<pg8::EpiQKV, true>(C, WSP(bf16_t, WS_X8), WSP(bf16_t, WS_WQKV0), NTOK, NQKV_A, DM, E, SSQ, SC_ONE);)
    PHASE(2, attn_A8(C);)
    PHASE(3, combine_A(C);)
    PHASE(4, pg8::EpiRes E{XB, SSQ, DM, nullptr}; dense_gemm<pg8::EpiRes, true>(C, OB, WSP(bf16_t, WS_WO0), NTOK, DM, DM, E, nullptr, SC_ONE);)
    PHASE(5, pg8::EpiSwiGLU E{HB, FF, RTAB}; dense_gemm(C, XB, WSP(bf16_t, WS_W13_0), NTOK, 2 * FF, DM, E, SSQ);)
    PHASE(6, pg8::EpiRes E{XB, SSQ, DM, nullptr}; dense_gemm(C, HB, WSP(bf16_t, WS_W2_0), NTOK, DM, FF, E);)
    PHASE(7, pg8::EpiQKV E{QKV, NQKV_B, RTAB, ROPE, 3072, 2048, nullptr, (unsigned char*)QKV}; dense_gemm(C, XB, WSP(bf16_t, WS_WQKV1), NTOK, NQKV_B, DM, E, SSQ);)
    PHASE(8, attn_B(C);)
    PHASE(9, pg8::EpiRes E{XB, SSQ, DM, nullptr}; dense_gemm(C, OB, WSP(bf16_t, WS_WO1), NTOK, DM, DM, E);)
    PHASE(10, moe_router(C, IN_F(17), IN_F(18));)
    PHASE(11, moe_gather(C);)
    PHASE(12, pg8::EpiSwiGLU8 E{(unsigned char*)HBUF, FFE}; moe_gemm(C, XBUF, WSP(bf16_t, WS_WM13), 2 * FFE / 256, DM, E);)
    PHASE(13, moe_gemm_down(C, HBUF, WSP(bf16_t, WS_WM2), YBUF, WSP(float, WS_BIG + BIG_XBUF));)
    PHASE(14, moe_down_reduce(C, YBUF, WSP(float, WS_BIG + BIG_XBUF)); xcd_barrier(bar); moe_combine<false>(C, nullptr); convert_weights_second(C);)
    PHASE(15, pg8::EpiQKV E{QKV, NQKV_C, RTAB, ROPE, 4096, 1152, nullptr, (unsigned char*)QKV}; dense_gemm<pg8::EpiQKV, true>(C, WSP(bf16_t, WS_X8), WSP(bf16_t, WS_WQKV2), NTOK, NQKV_C, DM, E, SSQ, SC_ONE);)
    PHASE(16, attn_C8(C);)
    PHASE(17, pg8::EpiRes E{XB, SSQ, DM, WSP(unsigned char, WS_X8)}; dense_gemm<pg8::EpiRes, true>(C, OB, WSP(bf16_t, WS_WO2), NTOK, DM, DM, E, nullptr, SC_ONE);)
    PHASE(18, pg8::EpiSwiGLU8 E{(unsigned char*)HB, FF, RTAB}; dense_gemm<pg8::EpiSwiGLU8, true>(C, WSP(bf16_t, WS_X8), WSP(bf16_t, WS_W13_2), NTOK, 2 * FF, DM, E, SSQ, SC_ONE);)
    PHASE(19, pg8::EpiRes E{XB, SSQ, DM, WSP(unsigned char, WS_X8)}; dense_gemm<pg8::EpiRes, true>(C, HB, WSP(bf16_t, WS_W2_2), NTOK, DM, FF, E, nullptr, SC_H8);)
    PHASE(20, pg8::EpiQKV E{QKV, NQKV_A, RTAB, ROPE, 3072, 2048, nullptr, (unsigned char*)QKV, 1}; dense_gemm<pg8::EpiQKV, true>(C, WSP(bf16_t, WS_X8), WSP(bf16_t, WS_WQKV3), NTOK, NQKV_A, DM, E, SSQ, SC_ONE);)
    PHASE(21, attn_A8(C);)
    PHASE(22, combine_A(C);)
    PHASE(23, pg8::EpiRes E{XB, SSQ, DM, nullptr}; dense_gemm<pg8::EpiRes, true>(C, OB, WSP(bf16_t, WS_WO3), NTOK, DM, DM, E, nullptr, SC_ONE);)
    PHASE(24, moe_router(C, IN_F(33), IN_F(34));)
    PHASE(25, moe_gather(C);)
    PHASE(26, pg8::EpiSwiGLU8 E{(unsigned char*)HBUF, FFE}; moe_gemm(C, XBUF, WSP(bf16_t, WS_WM13), 2 * FFE / 256, DM, E);)
    PHASE(27, moe_gemm_down(C, HBUF, WSP(bf16_t, WS_WM2), YBUF, WSP(float, WS_BIG + BIG_XBUF));)
    if (IN(28)) { Ctx C = C0; { int t_ = (int)threadIdx.x; asm volatile("" : "+v"(t_)); C.tid = t_; C.lane = t_ & 63; } moe_down_reduce(C, YBUF, WSP(float, WS_BIG + BIG_XBUF)); xcd_barrier(bar); moe_combine<true>(C, IN_F(38)); }
#undef IN
#undef SEAM
#undef PHASE
}

extern "C" void kernel_launch(void* const* d_in, const int* in_sizes, int n_in, void* d_out, int out_size, void* d_ws, size_t ws_size, hipStream_t stream) {
    static int grid = 0;
    if (grid == 0) {
        if (n_in != 39 || out_size != NTOK * DM || ws_size < WS_END) { fprintf(stderr, "kernel_launch: unexpected shapes (n_in %d out %d ws %zu)\n", n_in, out_size, ws_size); grid = -1; return; }
        int dev = 0, cus = 0, per_cu = 0;
        if (hipGetDevice(&dev) != hipSuccess || hipDeviceGetAttribute(&cus, hipDeviceAttributeMultiprocessorCount, dev) != hipSuccess) { grid = -1; return; }
        if (hipFuncSetAttribute((const void*)fwd_kernel, hipFuncAttributeMaxDynamicSharedMemorySize, LDS_BYTES) != hipSuccess) { grid = -1; return; }
        if (hipOccupancyMaxActiveBlocksPerMultiprocessor(&per_cu, (const void*)fwd_kernel, 512, LDS_BYTES) != hipSuccess || per_cu < 1) { fprintf(stderr, "kernel_launch: occupancy query says %d\n", per_cu); }
        (void)hipGetLastError();
        grid = cus;
    }
    if (grid < 0) return;
    if (hipMemsetAsync((char*)d_ws + WS_CTL, 0, CTL_ZERO_BYTES, stream) != hipSuccess) return;
    Args a{};
    for (int i = 0; i < 39; ++i) a.in[i] = d_in[i];
    a.out = (float*)d_out; a.ws = (unsigned char*)d_ws;
#if MK_SINGLE
    a.ph_lo = 0; a.ph_hi = N_PHASES;
    hipLaunchKernelGGL(fwd_kernel, dim3(grid), dim3(512), LDS_BYTES, stream, a);
#else
    for (int p = 0; p < N_PHASES; ++p) { a.ph_lo = p; a.ph_hi = p + 1; hipLaunchKernelGGL(fwd_kernel, dim3(grid), dim3(512), LDS_BYTES, stream, a); }
#endif
}
```
